# Optimizing an MI355X kernel written in HIP

```python
import math
import jax, jax.numpy as jnp
from jax import lax
import numpy as np

D_MODEL = 1024
BATCH = 16
SEQ = 4096
DEPTH = 1

CHUNK = 64
Q_BLOCK = 128
MLA_HEADS = 8
Q_LORA = 384
KV_LORA = 256
NOPE_DIM = 64
ROPE_DIM = 32
V_DIM = 64
ROPE_THETA = 10000.0
POOL_WIDTH = 512
POOL_WINDOWS = (2, 4, 8, 16)
N_POOL_GROUPS = len(POOL_WINDOWS)
POOL_GROUP_DIM = POOL_WIDTH // N_POOL_GROUPS
MEM_LEN = 256
MEM_HEADS = 4
MEM_HEAD_DIM = D_MODEL // MEM_HEADS
N_GROUPS = 4
EXPERTS_PER_GROUP = 8
N_EXPERTS = N_GROUPS * EXPERTS_PER_GROUP
EXPERT_FF = 256
TOP_K = 2
EPS = 1e-6
IN_SPLITS = tuple(int(v) for v in np.cumsum([Q_LORA, KV_LORA, ROPE_DIM, POOL_WIDTH, D_MODEL]))
IN_COLS = Q_LORA + KV_LORA + ROPE_DIM + POOL_WIDTH + 2 * D_MODEL

kernel_name = "hybrid_mla_pool_memxattn_hmoe"


def rms_norm(x, g):
    xf = x.astype(jnp.float32)
    y = xf * lax.rsqrt(jnp.mean(xf * xf, axis=-1, keepdims=True) + EPS)
    return (y * g.astype(jnp.float32)).astype(x.dtype)


def rope_tables(positions):
    inv_freq = 1.0 / (ROPE_THETA ** (jnp.arange(0, ROPE_DIM, 2, dtype=jnp.float32) / ROPE_DIM))
    ang = positions.astype(jnp.float32)[..., None] * inv_freq
    return jnp.cos(ang), jnp.sin(ang)


def apply_rope(x, cos, sin):
    x1, x2 = jnp.split(x.astype(jnp.float32), 2, axis=-1)
    return jnp.concatenate([x1 * cos - x2 * sin, x2 * cos + x1 * sin], axis=-1).astype(x.dtype)


def mla_attention(q_nope, q_rope, k_nope, k_rope, v):
    S = q_nope.shape[1]
    scale = 1.0 / math.sqrt(NOPE_DIM + ROPE_DIM)
    outs = []
    for blk in range(S // Q_BLOCK):
        s0, s1 = blk * Q_BLOCK, (blk + 1) * Q_BLOCK
        sc = (jnp.einsum('bqhd,bkhd->bhqk', q_nope[:, s0:s1], k_nope[:, :s1])
              + jnp.einsum('bqhd,bkd->bhqk', q_rope[:, s0:s1], k_rope[:, :s1]))
        sc = sc.astype(jnp.float32) * scale
        q_chunk = (s0 + jnp.arange(Q_BLOCK)) // CHUNK
        k_chunk = jnp.arange(s1) // CHUNK
        mask = k_chunk[None, :] <= q_chunk[:, None]
        p = jax.nn.softmax(jnp.where(mask, sc, -jnp.inf), axis=-1).astype(v.dtype)
        outs.append(jnp.einsum('bhqk,bkhd->bqhd', p, v[:, :s1]))
    return jnp.concatenate(outs, axis=1)


def multiscale_pool(u, group_w, scale):
    B, S, C = u.shape
    uf = u.astype(jnp.float32)
    cs = jnp.concatenate([jnp.zeros((B, 1, C), jnp.float32), jnp.cumsum(uf, axis=1)], axis=1)
    t = jnp.arange(S)
    outs = []
    for g, w in enumerate(POOL_WINDOWS):
        c0, c1 = g * POOL_GROUP_DIM, (g + 1) * POOL_GROUP_DIM
        csg = cs[:, :, c0:c1]
        lower = jnp.concatenate([jnp.zeros((B, w - 1, POOL_GROUP_DIM), jnp.float32), csg[:, :S - w + 1]], axis=1)
        count = jnp.minimum(t + 1, w).astype(jnp.float32)[None, :, None]
        outs.append((csg[:, 1:] - lower) / count - uf[:, :, c0:c1])
    d = jnp.stack(outs, axis=2).astype(u.dtype)
    y = jnp.einsum('bsgc,gce->bsge', d, group_w).reshape(B, S, C)
    return y * scale


def memory_cross_attention(hn, memn, w_q, w_kv, w_o):
    B, S, _ = hn.shape
    q = (hn @ w_q).reshape(B, S, MEM_HEADS, MEM_HEAD_DIM)
    k, v = jnp.split(memn @ w_kv, 2, axis=-1)
    k = k.reshape(B, MEM_LEN, MEM_HEADS, MEM_HEAD_DIM)
    v = v.reshape(B, MEM_LEN, MEM_HEADS, MEM_HEAD_DIM)
    sc = jnp.einsum('bqhd,bmhd->bhqm', q, k).astype(jnp.float32) / math.sqrt(MEM_HEAD_DIM)
    p = jax.nn.softmax(sc, axis=-1).astype(v.dtype)
    o = jnp.einsum('bhqm,bmhd->bqhd', p, v).reshape(B, S, D_MODEL)
    return o @ w_o


def hierarchical_moe(xn, w_rg, b_rg, w_re, b_re, w_gate, w_up, w_down):
    B, S, _ = xn.shape
    group_prob = jax.nn.softmax((xn @ w_rg).astype(jnp.float32) + b_rg.astype(jnp.float32), axis=-1)
    g_w, g_idx = lax.top_k(group_prob, 1)
    e_logits = ((xn @ w_re).astype(jnp.float32) + b_re.astype(jnp.float32)).reshape(B, S, N_GROUPS, EXPERTS_PER_GROUP)
    sel = jnp.einsum('bsge,bsg->bse', e_logits, jax.nn.one_hot(g_idx[..., 0], N_GROUPS, dtype=jnp.float32))
    e_w, e_idx = lax.top_k(jax.nn.softmax(sel, axis=-1), TOP_K)
    e_w = e_w / jnp.sum(e_w, axis=-1, keepdims=True)
    weights = g_w * e_w
    global_idx = g_idx * EXPERTS_PER_GROUP + e_idx
    cw = jnp.einsum('bsk,bskn->bsn', weights, jax.nn.one_hot(global_idx, N_EXPERTS, dtype=jnp.float32)).astype(xn.dtype)
    out = jnp.zeros_like(xn)
    for e in range(N_EXPERTS):
        hid = jax.nn.silu(xn @ w_gate[e]) * (xn @ w_up[e])
        out = out + (hid * cw[..., e:e + 1]) @ w_down[e]
    return out


def setup_inputs(seed: int = 0) -> dict:
    key = jax.random.key(seed)
    ks = iter(jax.random.split(key, 40))
    f32 = jnp.float32

    def w(shape, fan_in):
        return jax.random.normal(next(ks), shape, f32) * (fan_in ** -0.5)

    def gain(shape):
        return 1.0 + 0.02 * jax.random.normal(next(ks), shape, f32)

    def bias(shape):
        return 0.01 * jax.random.normal(next(ks), shape, f32)

    L = DEPTH
    x = jax.random.normal(next(ks), (BATCH, SEQ, D_MODEL), f32)
    mem = jax.random.normal(next(ks), (BATCH, MEM_LEN, D_MODEL), f32)
    offsets = jax.random.randint(next(ks), (BATCH, 1), 0, 4096, dtype=jnp.int32)
    positions = (offsets + jnp.arange(SEQ, dtype=jnp.int32)[None, :]).astype(jnp.int32)
    return {
        "x": x,
        "mem": mem,
        "positions": positions,
        "mix_norm_g": gain((L, D_MODEL)),
        "w_in": w((L, D_MODEL, IN_COLS), D_MODEL),
        "q_norm_g": gain((L, Q_LORA)),
        "w_q_up": w((L, Q_LORA, MLA_HEADS * (NOPE_DIM + ROPE_DIM)), Q_LORA),
        "kv_norm_g": gain((L, KV_LORA)),
        "w_kv_up": w((L, KV_LORA, MLA_HEADS * (NOPE_DIM + V_DIM)), KV_LORA),
        "w_attn_branch": w((L, MLA_HEADS * V_DIM, D_MODEL), MLA_HEADS * V_DIM),
        "pool_w": w((L, N_POOL_GROUPS, POOL_GROUP_DIM, POOL_GROUP_DIM), POOL_GROUP_DIM),
        "pool_scale": 1.0 + 0.1 * jax.random.normal(next(ks), (L, POOL_WIDTH), f32),
        "w_pool_branch": w((L, POOL_WIDTH, D_MODEL), POOL_WIDTH),
        "w_mix_out": w((L, D_MODEL, D_MODEL), D_MODEL),
        "xattn_norm_g": gain((L, D_MODEL)),
        "mem_norm_g": gain((L, D_MODEL)),
        "w_xq": w((L, D_MODEL, D_MODEL), D_MODEL),
        "w_xkv": w((L, D_MODEL, 2 * D_MODEL), D_MODEL),
        "w_xo": w((L, D_MODEL, D_MODEL), D_MODEL),
        "ffn_norm_g": gain((L, D_MODEL)),
        "w_router_group": w((L, D_MODEL, N_GROUPS), D_MODEL),
        "b_router_group": bias((L, N_GROUPS)),
        "w_router_expert": w((L, D_MODEL, N_EXPERTS), D_MODEL),
        "b_router_expert": bias((L, N_EXPERTS)),
        "w_exp_gate": w((L, N_EXPERTS, D_MODEL, EXPERT_FF), D_MODEL),
        "w_exp_up": w((L, N_EXPERTS, D_MODEL, EXPERT_FF), D_MODEL),
        "w_exp_down": w((L, N_EXPERTS, EXPERT_FF, D_MODEL), EXPERT_FF),
        "final_norm_g": gain((D_MODEL,)),
    }


def reference(x, mem, positions, mix_norm_g, w_in, q_norm_g, w_q_up, kv_norm_g, w_kv_up,
              w_attn_branch, pool_w, pool_scale, w_pool_branch, w_mix_out,
              xattn_norm_g, mem_norm_g, w_xq, w_xkv, w_xo,
              ffn_norm_g, w_router_group, b_router_group, w_router_expert, b_router_expert,
              w_exp_gate, w_exp_up, w_exp_down, final_norm_g):
    B, S, _ = x.shape
    cos, sin = rope_tables(positions)
    h = x
    for l in range(DEPTH):
        hn = rms_norm(h, mix_norm_g[l])
        z = hn @ w_in[l]
        q_lat, kv_lat, k_rope, u_pool, gate_a, gate_b = jnp.split(z, IN_SPLITS, axis=-1)
        q = (rms_norm(q_lat, q_norm_g[l]) @ w_q_up[l]).reshape(B, S, MLA_HEADS, NOPE_DIM + ROPE_DIM)
        q_nope, q_rope = q[..., :NOPE_DIM], q[..., NOPE_DIM:]
        q_rope = apply_rope(q_rope, cos[:, :, None, :], sin[:, :, None, :])
        kv = (rms_norm(kv_lat, kv_norm_g[l]) @ w_kv_up[l]).reshape(B, S, MLA_HEADS, NOPE_DIM + V_DIM)
        k_nope, v = kv[..., :NOPE_DIM], kv[..., NOPE_DIM:]
        k_rope = apply_rope(k_rope, cos, sin)
        attn = mla_attention(q_nope, q_rope, k_nope, k_rope, v).reshape(B, S, MLA_HEADS * V_DIM)
        y_a = attn @ w_attn_branch[l]
        y_b = multiscale_pool(u_pool, pool_w[l], pool_scale[l]) @ w_pool_branch[l]
        g_a = jax.nn.sigmoid(gate_a.astype(jnp.float32)).astype(h.dtype)
        g_b = jax.nn.sigmoid(gate_b.astype(jnp.float32)).astype(h.dtype)
        h = h + (g_a * y_a + g_b * y_b) @ w_mix_out[l]
        h = h + memory_cross_attention(rms_norm(h, xattn_norm_g[l]), rms_norm(mem, mem_norm_g[l]),
                                       w_xq[l], w_xkv[l], w_xo[l])
        h = h + hierarchical_moe(rms_norm(h, ffn_norm_g[l]), w_router_group[l], b_router_group[l],
                                 w_router_expert[l], b_router_expert[l],
                                 w_exp_gate[l], w_exp_up[l], w_exp_down[l])
    return rms_norm(h, final_norm_g)
```

```cpp
#include <hip/hip_runtime.h>
#include <cstdio>
#include <cstdint>
#include <type_traits>
#include <utility>

#ifndef PG8_SP2
#define PG8_SP2 1
#endif
#ifndef PG8_ALIGN_EPI
#define PG8_ALIGN_EPI 1
#endif
#ifndef MK_N_LAUNCHES
#define MK_N_LAUNCHES 1
#endif

#define GAS __attribute__((address_space(1)))
#define LAS __attribute__((address_space(3)))
typedef unsigned short bf16_t;
typedef short bf16x8 __attribute__((ext_vector_type(8)));
typedef short s16x4 __attribute__((ext_vector_type(4)));
typedef float f32x2 __attribute__((ext_vector_type(2)));
typedef float f32x4 __attribute__((ext_vector_type(4)));
typedef float f32x16 __attribute__((ext_vector_type(16)));
typedef unsigned u32x4 __attribute__((ext_vector_type(4)));
typedef unsigned u32x2 __attribute__((ext_vector_type(2)));
typedef int v4i_t __attribute__((ext_vector_type(4)));
typedef int v8i_t __attribute__((ext_vector_type(8)));
typedef GAS unsigned gu32;
#define RLX_AGENT __ATOMIC_RELAXED, __HIP_MEMORY_SCOPE_AGENT
#define LDS_WAIT() asm volatile("s_waitcnt lgkmcnt(0)" ::: "memory")
#define VM_WAIT() asm volatile("s_waitcnt vmcnt(0)" ::: "memory")

constexpr int DM = 1024, NBATCH = 16, SEQ = 4096, NTOK = NBATCH * SEQ;
constexpr int QLORA = 384, KVLORA = 256, ROPE = 32, POOLW = 512, NHEAD = 8, QKD = 96, VD = 64;
constexpr int MEMLEN = 256, NMEM = NBATCH * MEMLEN;
constexpr int NEXP = 32, EFF = 256;
constexpr int IN_COLS = 3232, IN_PAD = 3328;
constexpr float EPS = 1e-6f;
constexpr float C2Q = 0.10206207261596577f * 1.4426950408889634f;
constexpr float C2X = 0.0625f * 1.4426950408889634f;

constexpr size_t MiB = 1u << 20;
constexpr size_t WS_CTL = 0, CTL_ZERO_BYTES = 64 * 1024;
constexpr size_t WS_SMALL = 1 * MiB;
constexpr size_t OFF_SSQQ = WS_SMALL, OFF_SSQKV = OFF_SSQQ + 524288, OFF_SSQ1 = OFF_SSQKV + 524288, OFF_SSQ2 = OFF_SSQ1 + 524288, OFF_CNT = OFF_SSQ2 + 524288;
constexpr size_t SMALL_ZERO_BYTES = 4 * 524288 + 4096;
constexpr size_t WS_COS = 4 * MiB, WS_SIN = 8 * MiB;
constexpr size_t WS_WIN = 12 * MiB;
constexpr size_t WS_WQ = 19 * MiB;
constexpr size_t WS_WKVU = 20 * MiB;
constexpr size_t WS_WA = 21 * MiB, WS_WPB = 22 * MiB;
constexpr size_t WS_WMO = 23 * MiB, WS_WXKV = 27 * MiB, WS_WXO = 31 * MiB;
constexpr size_t WS_WR = 33 * MiB;
constexpr size_t WS_WGU = 34 * MiB;
constexpr size_t WS_WD = 66 * MiB;
constexpr size_t WS_MEMN = 82 * MiB, WS_KVM = 90 * MiB;
constexpr size_t WS_WIN8 = 122 * MiB;
constexpr size_t WS_WXQN = 120 * MiB;
constexpr size_t WS_BQK = 960 * MiB, WS_BVO = 992 * MiB;
constexpr size_t WS_LG = 106 * MiB;
constexpr size_t WS_S0 = 128 * MiB;
constexpr size_t WS_S1 = 256 * MiB;
constexpr size_t WS_S2 = 384 * MiB;
constexpr size_t WS_S3 = 512 * MiB;
constexpr size_t WS_S4 = 640 * MiB;
constexpr size_t WS_S5 = 768 * MiB;
constexpr size_t WS_S6 = 896 * MiB;
constexpr size_t WS_END = 1024 * MiB;
constexpr size_t WS_QLB = WS_S3, WS_KVLB = WS_S3 + 48 * MiB, WS_KRB = WS_S3 + 80 * MiB;
constexpr size_t WS_U = WS_S4, WS_DP = WS_S4 + 64 * MiB;
constexpr size_t WS_HID = WS_S4, WS_LIST = WS_S4 + 80 * MiB, WS_WL = WS_S4 + 88 * MiB, WS_RSL = WS_S4 + 96 * MiB;
constexpr size_t WS_KN = WS_S5, WS_V = WS_S5 + 64 * MiB;
constexpr size_t WS_ATT = WS_S6;

constexpr int RING_BYTES = 131072;
constexpr int MISC_OFF = RING_BYTES;
constexpr int LDS_BYTES = RING_BYTES + 24576;
constexpr int MO_BAR = 0;
constexpr int MO_HIST = 64, MO_BASE = 64 + 128;
constexpr int MO_CNTL = 1024, MO_TBASE = 1024 + 128, MO_TILEE = 2048;
constexpr int MAX_TILES = 544;
constexpr int MO_PS = 8192;

typedef __bf16 bf16x2_t __attribute__((ext_vector_type(2)));
__device__ __forceinline__ unsigned cvt_pk_bf16(float lo, float hi) { const f32x2 v = {lo, hi}; const bf16x2_t b = __builtin_convertvector(v, bf16x2_t); return __builtin_bit_cast(unsigned, b); }
__device__ __forceinline__ float bf_lo(unsigned w) { return __uint_as_float(w << 16); }
__device__ __forceinline__ float bf_hi(unsigned w) { return __uint_as_float(w & 0xffff0000u); }
__device__ __forceinline__ int lane_mb() { int l; asm volatile("v_mbcnt_lo_u32_b32 %0, -1, 0\n\tv_mbcnt_hi_u32_b32 %0, -1, %0" : "=v"(l)); return l; }
#define RELANE int tidq_ = wave * 64 + lane_mb(); asm volatile("" : "+v"(tidq_)); const int tid = tidq_, lane = tid & 63; (void)lane;
__device__ __forceinline__ void store8(bf16_t* p, const f32x4 v0, const f32x4 v1) {
    u32x4 w; w.x = cvt_pk_bf16(v0[0], v0[1]); w.y = cvt_pk_bf16(v0[2], v0[3]); w.z = cvt_pk_bf16(v1[0], v1[1]); w.w = cvt_pk_bf16(v1[2], v1[3]);
    *(u32x4*)p = w; }
__device__ __forceinline__ unsigned cvt4_fp8(float a, float b, float c, float d) { unsigned w = __float_as_uint(a);      w = __builtin_amdgcn_cvt_pk_fp8_f32(a, b, w, false); w = __builtin_amdgcn_cvt_pk_fp8_f32(c, d, w, true); return w; }
__device__ __forceinline__ void store8_fp8(unsigned char* p, const f32x4 v0, const f32x4 v1) { u32x2 w; w.x = cvt4_fp8(v0[0], v0[1], v0[2], v0[3]); w.y = cvt4_fp8(v1[0], v1[1], v1[2], v1[3]); *(u32x2*)p = w; }
__device__ __forceinline__ void unpack8_fp8(const u32x2 w, f32x4& v0, f32x4& v1) { const f32x2 a = __builtin_amdgcn_cvt_pk_f32_fp8((int)w.x, false), b = __builtin_amdgcn_cvt_pk_f32_fp8((int)w.x, true), c = __builtin_amdgcn_cvt_pk_f32_fp8((int)w.y, false), d = __builtin_amdgcn_cvt_pk_f32_fp8((int)w.y, true);
    v0 = (f32x4){a.x, a.y, b.x, b.y}; v1 = (f32x4){c.x, c.y, d.x, d.y}; }
__device__ __forceinline__ void load8(const bf16_t* p, f32x4& v0, f32x4& v1) {
    const u32x4 w = *(const u32x4*)p; v0 = (f32x4){bf_lo(w.x), bf_hi(w.x), bf_lo(w.y), bf_hi(w.y)}; v1 = (f32x4){bf_lo(w.z), bf_hi(w.z), bf_lo(w.w), bf_hi(w.w)}; }
__device__ __forceinline__ float fast_exp2(float x) { return __builtin_amdgcn_exp2f(x); }
__device__ __forceinline__ float sigmoidf_(float x) { return __builtin_amdgcn_rcpf(1.0f + fast_exp2(-1.4426950408889634f * x)); }
__device__ __forceinline__ float wave_sum(float v) {
#pragma unroll
    for (int o = 1; o < 64; o <<= 1) v += __shfl_xor(v, o);
    return v;
}

namespace pg8 {
#ifndef PG8_WGM
#define PG8_WGM 8
#endif
constexpr int BM = 256, BK = 64, HALF = 128, HTB = HALF * BK * 2, NXCD = 8, WGM = PG8_WGM;
__host__ __device__ __forceinline__ int lds_byte(int r, int c) { const int st = (r >> 4) * 2 + (c >> 5), rr = r & 15, cc = c & 31, ob = rr * 64 + cc * 2; return st * 1024 + (ob ^ (((ob >> 9) & 1) << 5)); }
__host__ __device__ __forceinline__ void stage_rc(int b, int& R, int& C) { const int st = b / 1024, sb = b % 1024, swz = sb ^ (((sb >> 9) & 1) << 5); R = (st >> 1) * 16 + swz / 64; C = (st & 1) * 32 + (swz % 64) / 2; }
__host__ __device__ __forceinline__ int perm32(int rho) { const int n = rho >> 4, i = rho & 15; return 8 * (i >> 2) + 4 * n + (i & 3); }
struct Unit { int pm, pn; };
struct StaticOrder {
    int nM, nN, nwg, G, c;
    __host__ __device__ __forceinline__ void init(int M, int N, int G_, int c_) { nM = M / BM; nN = N / BM; nwg = nM * nN; G = G_; c = c_; }
    __host__ __device__ __forceinline__ bool next(int i, Unit& u) const { return at((long)i * G + c, u); }
    __host__ __device__ __forceinline__ bool at(const long L, Unit& u) const {
        if (L >= nwg) return false;
        int wgid = (int)L; { const int q = nwg / NXCD, r = nwg % NXCD, xcd = wgid % NXCD, off = wgid / NXCD; wgid = (xcd < r ? xcd * (q + 1) : r * (q + 1) + (xcd - r) * q) + off; }
        const int nig = WGM * nN, gid = wgid / nig, fm = gid * WGM, gsz = (nM - fm) < WGM ? (nM - fm) : WGM;
        u.pm = fm + ((wgid % nig) % gsz); u.pn = (wgid % nig) / gsz; return true;
    }
};
struct ListOrder {
    int pm, n;
    __device__ __forceinline__ bool next(int i, Unit& u) const { if (i >= n) return false; u.pm = pm; u.pn = i; return true; }
};
template <class T, class = void> struct HasBrow : std::false_type {};
template <class T> struct HasBrow<T, std::void_t<decltype(std::declval<const T&>().brow(0))>> : std::true_type {};
template <class Op, class Sched>
__device__ __forceinline__ void gemm_phase(LAS unsigned char* lds, const Op& op, const Sched& S, const int wv_) {
    int tid_ = wv_ * 64 + lane_mb(); asm volatile("" : "+v"(tid_));
    const int tid = tid_, wid = __builtin_amdgcn_readfirstlane(tid >> 6), lane = tid & 63, wr = wid >> 2, wc = wid & 3, fr = lane & 15, fq = lane >> 4;
    const int K = op.K, nt = K / BK;
    unsigned voffA0[2], voffA1[2], voffB[2];
#pragma unroll
    for (int i = 0; i < 2; ++i) { int R, C; stage_rc(tid * 16 + i * 8192, R, C); int Rb = Op::PERM ? ((R & ~31) + perm32(R & 31)) : R; if constexpr (HasBrow<Op>::value) Rb = op.brow(Rb);
        if constexpr (!Op::GATHER) { voffA0[i] = op.a_off(R, C); voffA1[i] = 0u; } voffB[i] = (unsigned)(Rb * op.ldb + C) * 2u; }
    const size_t kstep = (size_t)(BK * 2);
    const size_t hstepB = (size_t)HALF * op.ldb * 2;
    size_t hstepA = 0; if constexpr (!Op::GATHER) hstepA = (size_t)op.a_off(HALF, 0);
    const unsigned ldsw = (unsigned)wid * 1024u;
    const int aoff = lds_byte(wr * 64 + fr, fq * 8), boff = lds_byte(wc * 32 + fr, fq * 8);
#define PG8_SA(b, h) (((b) * 2 + (h)) * HTB)
#define PG8_SB(b, h) ((4 + (b) * 2 + (h)) * HTB)
#define PG8_STAGE(bufoff, gbase, voff) do { _Pragma("unroll") for (int _i = 0; _i < 2; ++_i) \
        __builtin_amdgcn_global_load_lds((const unsigned*)((const char*)(gbase) + (voff)[_i]), (LAS unsigned*)(lds + (bufoff) + ldsw + _i * 8192), 16, 0, 0); } while (0)
#define PG8_STAGE_A1(bufoff, gbase, vg) do { if constexpr (Op::GATHER) PG8_STAGE(bufoff, gbase, vg); else PG8_STAGE(bufoff, (gbase) + hstepA, voffA0); } while (0)
#define PG8_LDA(dst, b, h) do { if constexpr (Op::FP8) { _Pragma("unroll") for (int m = 0; m < 4; ++m) dst##8[m] = __builtin_shufflevector(*(const LAS v4i_t*)(lds + PG8_SA(b, h) + aoff + m * 2048), *(const LAS v4i_t*)(lds + PG8_SA(b, h) + aoff + m * 2048 + 1024), 0, 1, 2, 3, 4, 5, 6, 7); } \
        else { _Pragma("unroll") for (int m = 0; m < 4; ++m) _Pragma("unroll") for (int k = 0; k < 2; ++k) dst[m][k] = *(const LAS bf16x8*)(lds + PG8_SA(b, h) + aoff + m * 2048 + k * 1024); } } while (0)
#define PG8_LDB(dst, b, h) do { if constexpr (Op::FP8) { _Pragma("unroll") for (int n = 0; n < 2; ++n) dst##8[n] = __builtin_shufflevector(*(const LAS v4i_t*)(lds + PG8_SB(b, h) + boff + n * 2048), *(const LAS v4i_t*)(lds + PG8_SB(b, h) + boff + n * 2048 + 1024), 0, 1, 2, 3, 4, 5, 6, 7); } \
        else { _Pragma("unroll") for (int n = 0; n < 2; ++n) _Pragma("unroll") for (int k = 0; k < 2; ++k) dst[n][k] = *(const LAS bf16x8*)(lds + PG8_SB(b, h) + boff + n * 2048 + k * 1024); } } while (0)
#define PG8_MMA(ai, bj, At, Bt) do { __builtin_amdgcn_s_setprio(1); _Pragma("unroll") for (int m = 0; m < 4; ++m) _Pragma("unroll") for (int n = 0; n < 2; ++n) _Pragma("unroll") for (int k = 0; k < 2; ++k) \
        acc[ai][bj][m][n] = __builtin_amdgcn_mfma_f32_16x16x32_bf16(Bt[n][k], At[m][k], acc[ai][bj][m][n], 0, 0, 0); __builtin_amdgcn_s_setprio(0); } while (0)
#define PG8_MMA8(ai, bj, At, Bt) do { __builtin_amdgcn_s_setprio(1); _Pragma("unroll") for (int m = 0; m < 4; ++m) _Pragma("unroll") for (int n = 0; n < 2; ++n) \
        asm volatile("v_mfma_scale_f32_16x16x128_f8f6f4 %0, %1, %2, %0, %3, %4 op_sel_hi:[0,0,0]" : "+v"(acc[ai][bj][m][n]) : "v"(Bt##8[n]), "v"(At##8[m]), "v"(sclW), "v"(sclA)); \
        __builtin_amdgcn_s_setprio(0); } while (0)
#define PG8_MMAX(ai, bj, At, Bt) do { if constexpr (Op::FP8) PG8_MMA8(ai, bj, At, Bt); else PG8_MMA(ai, bj, At, Bt); } while (0)
#define PG8_WAIT_V(n) asm volatile("s_waitcnt vmcnt(" #n ")" ::: "memory")
#define PG8_WAIT_L(n) asm volatile("s_waitcnt lgkmcnt(" #n ")" ::: "memory")
#define PG8_BAR __builtin_amdgcn_s_barrier()
#define PG8_SCHED __builtin_amdgcn_sched_barrier(0)
    Unit cur, nxt; int ui = 0;
    if (!S.next(0, cur)) return;
    unsigned nvA0[2], nvA1[2];
    if constexpr (Op::GATHER) {
#pragma unroll
        for (int i = 0; i < 2; ++i) { int R, C; stage_rc(tid * 16 + i * 8192, R, C); voffA0[i] = op.a_off_u(cur, R, C); voffA1[i] = op.a_off_u(cur, R + HALF, C); nvA0[i] = voffA0[i]; nvA1[i] = voffA1[i]; } }
    f32x4 acc[2][2][4][2];
#pragma unroll
    for (int a = 0; a < 2; ++a)
#pragma unroll
        for (int b = 0; b < 2; ++b)
#pragma unroll
            for (int m = 0; m < 4; ++m)
#pragma unroll
                for (int n = 0; n < 2; ++n) acc[a][b][m][n] = (f32x4){0.f, 0.f, 0.f, 0.f};
    int sclW = 0x7A7A7A7A, sclA = 0x7F7F7F7F; (void)sclW; (void)sclA;
    bf16x8 At[4][2], B0[2][2], B1[2][2]; v8i_t At8[4], B08[2], B18[2];
    const char* cA = op.a_base(cur); const char* cB = op.b_base(cur);
    if (PG8_SP2) {
        PG8_STAGE(PG8_SB(0, 0), cB, voffB); PG8_STAGE(PG8_SB(0, 1), cB + hstepB, voffB); PG8_STAGE(PG8_SA(0, 0), cA, voffA0); PG8_STAGE_A1(PG8_SA(0, 1), cA, voffA1);
        if (wr == 1) PG8_BAR;
        PG8_WAIT_V(2); PG8_BAR;
        PG8_STAGE(PG8_SB(1, 0), cB + kstep, voffB); PG8_STAGE(PG8_SA(1, 0), cA + kstep, voffA0); PG8_STAGE(PG8_SB(1, 1), cB + hstepB + kstep, voffB);
        PG8_WAIT_V(6); PG8_BAR;
    } else {
    PG8_STAGE(PG8_SB(0, 0), cB, voffB); PG8_STAGE(PG8_SA(0, 0), cA, voffA0); PG8_STAGE(PG8_SB(0, 1), cB + hstepB, voffB); PG8_STAGE_A1(PG8_SA(0, 1), cA, voffA1);
    if (wr == 1) PG8_BAR;
    PG8_WAIT_V(4); PG8_BAR;
    PG8_STAGE(PG8_SB(1, 0), cB + kstep, voffB); PG8_STAGE(PG8_SA(1, 0), cA + kstep, voffA0); PG8_STAGE(PG8_SB(1, 1), cB + hstepB + kstep, voffB);
    PG8_WAIT_V(6); PG8_BAR;
    }
    for (;;) {
        const bool has_next = S.next(ui + 1, nxt);
        const char* nA = has_next ? op.a_base(nxt) : cA; const char* nB = has_next ? op.b_base(nxt) : cB;
        if constexpr (Op::GATHER) { if (has_next) {
#pragma unroll
            for (int i = 0; i < 2; ++i) { int R, C; stage_rc(tid * 16 + i * 8192, R, C); nvA0[i] = op.a_off_u(nxt, R, C); nvA1[i] = op.a_off_u(nxt, R + HALF, C); } } }
        for (int t = 0; t < nt; t += 2) {
            const bool last = (t == nt - 2);
            if constexpr (Op::GATHER) asm volatile("" : "+v"(voffA1[0]), "+v"(voffA1[1]));
            asm volatile("" : "+v"(voffA0[0]), "+v"(voffA0[1]), "+v"(voffB[0]), "+v"(voffB[1]));
            const char* a1 = cA + (size_t)(t + 1) * kstep;
            const char* a2 = last ? nA : cA + (size_t)(t + 2) * kstep; const char* b2 = last ? nB : cB + (size_t)(t + 2) * kstep;
            const char* a3 = a2 + kstep; const char* b3 = b2 + kstep;
            unsigned sA0[2], sA1[2];
#pragma unroll
            for (int i = 0; i < 2; ++i) { if constexpr (Op::GATHER) { sA0[i] = last ? nvA0[i] : voffA0[i]; sA1[i] = last ? nvA1[i] : voffA1[i]; } else { sA0[i] = voffA0[i]; sA1[i] = voffA1[i]; } }
            if (PG8_SP2) {
            const bool fresh = (t == 0) && (ui > 0);
            PG8_LDB(B0, 0, 0); PG8_LDB(B1, 0, 1); PG8_SCHED; PG8_LDA(At, 0, 0); if (!fresh) PG8_STAGE_A1(PG8_SA(1, 1), a1, voffA1);
            if (!fresh) PG8_WAIT_V(8); PG8_WAIT_L(0); PG8_BAR; PG8_MMAX(0, 0, At, B0); PG8_MMAX(0, 1, At, B1); PG8_BAR; PG8_SCHED;
            PG8_LDA(At, 0, 1); PG8_STAGE(PG8_SB(0, 0), b2, voffB); PG8_STAGE(PG8_SB(0, 1), b2 + hstepB, voffB); PG8_STAGE(PG8_SA(0, 0), a2, sA0);
            if (!fresh) PG8_WAIT_V(8); PG8_WAIT_L(0); PG8_BAR; PG8_MMAX(1, 0, At, B0); PG8_MMAX(1, 1, At, B1); PG8_BAR; PG8_SCHED;
            PG8_LDB(B0, 1, 0); PG8_LDB(B1, 1, 1); PG8_SCHED; PG8_LDA(At, 1, 0); PG8_STAGE_A1(PG8_SA(0, 1), a2, sA1);
            if (!fresh) PG8_WAIT_V(8); PG8_WAIT_L(0); PG8_BAR; PG8_MMAX(0, 0, At, B0); PG8_MMAX(0, 1, At, B1); PG8_BAR; PG8_SCHED;
            PG8_LDA(At, 1, 1); PG8_STAGE(PG8_SB(1, 0), b3, voffB); PG8_STAGE(PG8_SB(1, 1), b3 + hstepB, voffB); PG8_STAGE(PG8_SA(1, 0), a3, sA0);
            if (!fresh) PG8_WAIT_V(8); PG8_WAIT_L(0); PG8_BAR; PG8_MMAX(1, 0, At, B0); PG8_MMAX(1, 1, At, B1); PG8_BAR; PG8_SCHED;
            } else {
            PG8_LDB(B0, 0, 0); PG8_SCHED; PG8_LDA(At, 0, 0); PG8_STAGE_A1(PG8_SA(1, 1), a1, voffA1);
            PG8_WAIT_L(8); PG8_BAR; PG8_WAIT_L(0); PG8_MMAX(0, 0, At, B0); PG8_BAR; PG8_SCHED;
            PG8_LDB(B1, 0, 1); PG8_STAGE(PG8_SB(0, 0), b2, voffB);
            PG8_BAR; PG8_WAIT_L(0); PG8_MMAX(0, 1, At, B1); PG8_BAR;
            PG8_LDA(At, 0, 1); PG8_STAGE(PG8_SA(0, 0), a2, sA0);
            PG8_BAR; PG8_WAIT_L(0); PG8_MMAX(1, 0, At, B0); PG8_BAR; PG8_SCHED;
            PG8_STAGE(PG8_SB(0, 1), b2 + hstepB, voffB);
            PG8_WAIT_V(6); PG8_BAR; PG8_MMAX(1, 1, At, B1); PG8_BAR;
            PG8_LDB(B0, 1, 0); PG8_SCHED; PG8_LDA(At, 1, 0); PG8_STAGE_A1(PG8_SA(0, 1), a2, sA1);
            PG8_WAIT_L(8); PG8_BAR; PG8_WAIT_L(0); PG8_MMAX(0, 0, At, B0); PG8_BAR; PG8_SCHED;
            PG8_LDB(B1, 1, 1); PG8_STAGE(PG8_SB(1, 0), b3, voffB);
            PG8_BAR; PG8_WAIT_L(0); PG8_MMAX(0, 1, At, B1); PG8_BAR;
            PG8_LDA(At, 1, 1); PG8_STAGE(PG8_SA(1, 0), a3, sA0);
            PG8_BAR; PG8_WAIT_L(0); PG8_MMAX(1, 0, At, B0); PG8_BAR; PG8_SCHED;
            PG8_STAGE(PG8_SB(1, 1), b3 + hstepB, voffB);
            PG8_WAIT_V(6); PG8_BAR; PG8_MMAX(1, 1, At, B1); PG8_BAR;
            }
        }
        if constexpr (Op::FP8) asm volatile("s_nop 15\n\ts_nop 15" ::: "memory");
        if (PG8_ALIGN_EPI) { if (wr == 0) PG8_BAR; }
        if (PG8_SP2 && PG8_ALIGN_EPI && has_next) {
            if constexpr (Op::GATHER) { PG8_STAGE_A1(PG8_SA(1, 1), nA + kstep, nvA1); } else { PG8_STAGE_A1(PG8_SA(1, 1), nA + kstep, voffA1); } }
        {
          int lane_e = (int)__builtin_amdgcn_mbcnt_hi(~0u, __builtin_amdgcn_mbcnt_lo(~0u, 0u)); asm volatile("" : "+v"(lane_e));
          const int src_ = ((((lane_e & 3) << 4) | (lane_e >> 2)) << 2);
#pragma unroll
          for (int a = 0; a < 2; ++a)
#pragma unroll
              for (int b = 0; b < 2; ++b)
#pragma unroll
                  for (int m = 0; m < 4; ++m)
#pragma unroll
                      for (int n = 0; n < 2; ++n)
#pragma unroll
                          for (int j = 0; j < 4; ++j) acc[a][b][m][n][j] = __int_as_float(__builtin_amdgcn_ds_bpermute(src_, __float_as_int(acc[a][b][m][n][j])));
          if (PG8_SP2 && PG8_ALIGN_EPI) PG8_WAIT_V(0);
          op.epi(acc, cur, wr, wc, lane_e >> 2, lane_e & 3); }
        if (!has_next) break;
#pragma unroll
        for (int a = 0; a < 2; ++a)
#pragma unroll
            for (int b = 0; b < 2; ++b)
#pragma unroll
                for (int m = 0; m < 4; ++m)
#pragma unroll
                    for (int n = 0; n < 2; ++n) acc[a][b][m][n] = (f32x4){0.f, 0.f, 0.f, 0.f};
        cur = nxt; cA = nA; cB = nB; ++ui;
        if constexpr (Op::GATHER) {
#pragma unroll
            for (int i = 0; i < 2; ++i) { voffA0[i] = nvA0[i]; voffA1[i] = nvA1[i]; } }
        if (PG8_ALIGN_EPI) { if (wr == 1) PG8_BAR; }
    }
    PG8_WAIT_V(0);
    if (!PG8_ALIGN_EPI) { if (wr == 0) PG8_BAR; }
    PG8_BAR;
#undef PG8_SA
#undef PG8_SB
#undef PG8_STAGE
#undef PG8_LDA
#undef PG8_STAGE_A1
#undef PG8_LDB
#undef PG8_MMA
#undef PG8_MMA8
#undef PG8_MMAX
#undef PG8_WAIT_V
#undef PG8_WAIT_L
#undef PG8_BAR
#undef PG8_SCHED
}
}
using pg8::Unit;
typedef f32x4 Acc[2][2][4][2];

struct RopeCS { f32x4 c0, c1, s0, s1; };
__device__ __forceinline__ RopeCS rope_load(const float* cosT, const float* sinT, int row, int fq) { const int i0 = 8 * (fq & 1); RopeCS r;
    r.c0 = *(const f32x4*)(cosT + (size_t)row * 16 + i0); r.c1 = *(const f32x4*)(cosT + (size_t)row * 16 + i0 + 4); r.s0 = *(const f32x4*)(sinT + (size_t)row * 16 + i0); r.s1 = *(const f32x4*)(sinT + (size_t)row * 16 + i0 + 4); return r; }
__device__ __forceinline__ void rope_apply(f32x4& v0, f32x4& v1, const RopeCS& r, int fq) {
    f32x4 p0, p1;
#pragma unroll
    for (int j = 0; j < 4; ++j) { p0[j] = __shfl_xor(v0[j], 2); p1[j] = __shfl_xor(v1[j], 2); }
    if (fq < 2) { v0 = v0 * r.c0 - p0 * r.s0; v1 = v1 * r.c1 - p1 * r.s1; } else { v0 = v0 * r.c0 + p0 * r.s0; v1 = v1 * r.c1 + p1 * r.s1; }
}
__device__ __forceinline__ void rope8(f32x4& v0, f32x4& v1, const float* cosT, const float* sinT, int row, int fq) {
    f32x4 p0, p1;
#pragma unroll
    for (int j = 0; j < 4; ++j) { p0[j] = __shfl_xor(v0[j], 2); p1[j] = __shfl_xor(v1[j], 2); }
    const int i0 = 8 * (fq & 1);
    const f32x4 c0 = *(const f32x4*)(cosT + (size_t)row * 16 + i0), c1 = *(const f32x4*)(cosT + (size_t)row * 16 + i0 + 4);
    const f32x4 s0 = *(const f32x4*)(sinT + (size_t)row * 16 + i0), s1 = *(const f32x4*)(sinT + (size_t)row * 16 + i0 + 4);
    if (fq < 2) { v0 = v0 * c0 - p0 * s0; v1 = v1 * c1 - p1 * s1; }
    else        { v0 = v0 * c0 + p0 * s0; v1 = v1 * c1 + p1 * s1; }
}
__device__ __forceinline__ float ssq8(const f32x4 v0, const f32x4 v1) { return (v0[0] * v0[0] + v0[1] * v0[1]) + (v0[2] * v0[2] + v0[3] * v0[3]) + (v1[0] * v1[0] + v1[1] * v1[1]) + (v1[2] * v1[2] + v1[3] * v1[3]); }
typedef unsigned long long u64;
constexpr float FX_SCALE = 16777216.0f, FX_INV = 1.0f / 16777216.0f;
__device__ __forceinline__ void row_atomic_add(u64* p, float s, int fq) { s += __shfl_xor(s, 1); s += __shfl_xor(s, 2); if (fq == 0) __hip_atomic_fetch_add(p, (u64)(s * FX_SCALE + 0.5f), RLX_AGENT); }
__device__ __forceinline__ float fx_load(const u64* p) { return (float)(*p) * FX_INV; }

#ifndef EPI_FENCE
#define EPI_FENCE
#endif
#define RT_(ai, m) ((ai) * 128 + wr * 64 + (m) * 16 + fr)
#define FOR_AI _Pragma("unroll") for (int ai = 0; ai < 2; ++ai)
#define FOR_M _Pragma("unroll") for (int m = 0; m < 4; ++m)
#define FOR_BJ _Pragma("unroll") for (int bj = 0; bj < 2; ++bj)
__device__ __forceinline__ void unpack8(const u32x4 w, f32x4& v0, f32x4& v1) { v0 = (f32x4){bf_lo(w.x), bf_hi(w.x), bf_lo(w.y), bf_hi(w.y)}; v1 = (f32x4){bf_lo(w.z), bf_hi(w.z), bf_lo(w.w), bf_hi(w.w)}; }
#define EPI_ROWS(...) _Pragma("unroll") for (int ai = 0; ai < 2; ++ai) _Pragma("unroll") for (int m = 0; m < 4; ++m) { const int rt = ai * 128 + wr * 64 + m * 16 + fr; __VA_ARGS__ EPI_FENCE }

template <bool F8> struct OpInT {
    static constexpr bool PERM = true, GATHER = false, FP8 = F8;
    const bf16_t* A; const bf16_t* Bt; int K, lda, ldb;
    bf16_t *QLb, *KVLb, *KRb, *U, *GA, *GB; u64 *ssq_q, *ssq_kv; const float *cosT, *sinT;
    __device__ __forceinline__ unsigned a_off(int r, int c) const { return (unsigned)(r * lda + c) * 2u; }
    __device__ __forceinline__ const char* a_base(const Unit& u) const { return (const char*)(A + (size_t)u.pm * 256 * lda); }
    __device__ __forceinline__ const char* b_base(const Unit& u) const { return (const char*)(Bt + (size_t)u.pn * 256 * ldb); }
    __device__ __forceinline__ void epi(const Acc& acc, const Unit& u, int wr, int wc, int fr, int fq) const {
        const int row0 = u.pm * 256, col = 32 * wc + 8 * fq;
#pragma unroll
        for (int bj = 0; bj < 2; ++bj) {
            const int hc = u.pn * 2 + bj;
            if (hc < 5) {
                u64* ssq = hc < 3 ? ssq_q : ssq_kv;
                if constexpr (F8) {
                    unsigned char* dst = hc < 3 ? (unsigned char*)QLb + hc * 128 : (unsigned char*)KVLb + (hc - 3) * 128; const int pitch = hc < 3 ? 512 : 256;
                    EPI_ROWS( const int row = row0 + rt; const f32x4 v0 = acc[ai][bj][m][0], v1 = acc[ai][bj][m][1];
                        row_atomic_add(ssq + row, ssq8(v0, v1), fq); store8_fp8(dst + (size_t)row * pitch + col, v0, v1);
                        if (hc == 2) *(u32x2*)(dst + (size_t)row * pitch + col + 128) = (u32x2){0u, 0u}; )
                } else {
                bf16_t* dst = hc < 3 ? QLb + hc * 128 : KVLb + (hc - 3) * 128; const int pitch = hc < 3 ? QLORA : KVLORA;
                EPI_ROWS( const int row = row0 + rt; const f32x4 v0 = acc[ai][bj][m][0], v1 = acc[ai][bj][m][1];
                    row_atomic_add(ssq + row, ssq8(v0, v1), fq); store8(dst + (size_t)row * pitch + col, v0, v1); )
                }
            } else if (hc == 5) {
                if (wc == 0) { FOR_AI { RopeCS cs[4]; FOR_M cs[m] = rope_load(cosT, sinT, row0 + RT_(ai, m), fq);
                    FOR_M { const int row = row0 + RT_(ai, m); f32x4 v0 = acc[ai][bj][m][0], v1 = acc[ai][bj][m][1]; rope_apply(v0, v1, cs[m], fq);
                        if constexpr (F8) store8_fp8((unsigned char*)KRb + (size_t)row * ROPE + col, v0, v1);
                        else store8(KRb + (size_t)row * ROPE + col, v0, v1); } } }
            } else if (hc < 10) {
                bf16_t* dst = U + (hc - 6) * 128;
                EPI_ROWS( const int row = row0 + rt; store8(dst + (size_t)row * POOLW + col, acc[ai][bj][m][0], acc[ai][bj][m][1]); )
            } else {
                bf16_t* dst = hc < 18 ? GA + (hc - 10) * 128 : GB + (hc - 18) * 128;
                EPI_ROWS( const int row = row0 + rt; f32x4 v0 = acc[ai][bj][m][0], v1 = acc[ai][bj][m][1];
                    _Pragma("unroll") for (int j = 0; j < 4; ++j) { v0[j] = sigmoidf_(v0[j]); v1[j] = sigmoidf_(v1[j]); }
                    store8(dst + (size_t)row * DM + col, v0, v1); )
            }
        }
    }
};
typedef OpInT<false> OpIn; typedef OpInT<true> OpIn8;
struct OpGate8 {
    static constexpr bool PERM = true, GATHER = false, FP8 = true;
    const bf16_t* A; const bf16_t* Bt; int K, lda, ldb;
    bf16_t *GA, *GB;
    __device__ __forceinline__ unsigned a_off(int r, int c) const { return (unsigned)(r * lda + c) * 2u; }
    __device__ __forceinline__ const char* a_base(const Unit& u) const { return (const char*)(A + (size_t)u.pm * 256 * lda); }
    __device__ __forceinline__ const char* b_base(const Unit& u) const { return (const char*)(Bt + (size_t)u.pn * 256 * ldb); }
    __device__ __forceinline__ void epi(const Acc& acc, const Unit& u, int wr, int wc, int fr, int fq) const {
        const size_t off = (size_t)u.pm * 256 * DM + ((u.pn - 5) & 3) * 256 + 32 * wc + 8 * fq;
        FOR_AI FOR_M FOR_BJ { f32x4 v0 = acc[ai][bj][m][0], v1 = acc[ai][bj][m][1];
            _Pragma("unroll") for (int j = 0; j < 4; ++j) { v0[j] = sigmoidf_(v0[j]); v1[j] = sigmoidf_(v1[j]); }
            if (u.pn < 9) store8_fp8((unsigned char*)GA + off + (size_t)RT_(ai, m) * DM + bj * 128, v0 * 256.f, v1 * 256.f);
            else store8(GB + off + (size_t)RT_(ai, m) * DM + bj * 128, v0, v1); }
    }
};
struct OffsetOrder { pg8::StaticOrder s; int off; __device__ __forceinline__ bool next(int i, Unit& u) const { if (!s.next(i, u)) return false; u.pn += off; return true; } };
struct GateOrder { pg8::StaticOrder s; int off, light;
    __device__ __forceinline__ bool next(int i, Unit& u) const { long L;
        if (2 * light != s.G || s.nwg != 8 * s.G) L = (long)i * s.G + s.c;
        else if (i < 7) L = (long)i * s.G + s.c;
        else if (s.c >= light && i < 9) L = 7L * s.G + (long)(i - 7) * light + (s.c - light);
        else return false;
        if (!s.at(L, u)) return false; u.pn += off; return true; } };
struct OpPlain {
    static constexpr bool PERM = true, GATHER = false, FP8 = false;
    const bf16_t* A; const bf16_t* Bt; int K, lda, ldb;
    bf16_t* O; int ldo;
    __device__ __forceinline__ unsigned a_off(int r, int c) const { return (unsigned)(r * lda + c) * 2u; }
    __device__ __forceinline__ const char* a_base(const Unit& u) const { return (const char*)(A + (size_t)u.pm * 256 * lda); }
    __device__ __forceinline__ const char* b_base(const Unit& u) const { return (const char*)(Bt + (size_t)u.pn * 256 * ldb); }
    __device__ __forceinline__ void epi(const Acc& acc, const Unit& u, int wr, int wc, int fr, int fq) const {
        bf16_t* base = O + (size_t)u.pm * 256 * ldo + u.pn * 256 + 32 * wc + 8 * fq;
        EPI_ROWS( _Pragma("unroll") for (int bj = 0; bj < 2; ++bj) store8(base + (size_t)rt * ldo + bj * 128, acc[ai][bj][m][0], acc[ai][bj][m][1]); )
    }
};
__device__ __forceinline__ int key_of_slot(int sl) { const int hi = sl >> 5, j = sl & 31, jj = j & 15; return ((j >> 4) << 5) + (jj & 3) + 8 * (jj >> 2) + 4 * hi; }
struct OpQ {
    static constexpr bool PERM = true, GATHER = false, FP8 = true;
    const bf16_t* A; const bf16_t* Bt; int K, lda, ldb;
    unsigned char* Q  ; const u64* ssq_q; const float *cosT, *sinT;
    __device__ __forceinline__ unsigned a_off(int r, int c) const { return (unsigned)(r * lda + c) * 2u; }
    __device__ __forceinline__ const char* a_base(const Unit& u) const { return (const char*)(A + (size_t)u.pm * 256 * lda); }
    __device__ __forceinline__ const char* b_base(const Unit& u) const { return (const char*)(Bt + (size_t)u.pn * 256 * ldb); }
    __device__ __forceinline__ void epi(const Acc& acc, const Unit& u, int wr, int wc, int fr, int fq) const {
        float rs[2][4]; FOR_AI FOR_M rs[ai][m] = fx_load(ssq_q + u.pm * 256 + RT_(ai, m));
        FOR_AI FOR_M rs[ai][m] = 16.f * C2Q * __builtin_amdgcn_rsqf(rs[ai][m] * (1.0f / QLORA) + EPS);
        const int g0 = u.pn * 8 + wc; const bool rp0 = (g0 % 3 == 2), rp1 = ((g0 + 4) % 3 == 2);
        FOR_AI _Pragma("unroll") for (int m0 = 0; m0 < 4; m0 += 2) { RopeCS cs[2]; if (rp0 || rp1) { _Pragma("unroll") for (int mi = 0; mi < 2; ++mi) cs[mi] = rope_load(cosT, sinT, u.pm * 256 + RT_(ai, m0 + mi), fq); }
            _Pragma("unroll") for (int mi = 0; mi < 2; ++mi) { const int m = m0 + mi; const int row = u.pm * 256 + RT_(ai, m);
                FOR_BJ { const int g32 = g0 + bj * 4; f32x4 v0 = acc[ai][bj][m][0] * rs[ai][m], v1 = acc[ai][bj][m][1] * rs[ai][m];
                    if (bj == 0 ? rp0 : rp1) rope_apply(v0, v1, cs[mi], fq);
                    unsigned char* qd = Q + (size_t)row * 1024 + (g32 / 3) * 128 + (g32 % 3) * 32 + 8 * fq; store8_fp8(qd, v0, v1); if (bj == 0 ? rp0 : rp1) *(u32x2*)(qd + 32) = (u32x2){0u, 0u}; } } }
    }
};
struct OpK8 {
    static constexpr bool PERM = true, GATHER = false, FP8 = true;
    const bf16_t* A; const bf16_t* Bt; int K, lda, ldb;
    unsigned char* K8; const u64* ssq_kv;
    __device__ __forceinline__ unsigned a_off(int r, int c) const { return (unsigned)(r * lda + c) * 2u; }
    __device__ __forceinline__ const char* a_base(const Unit& u) const { return (const char*)(A + (size_t)u.pm * 256 * lda); }
    __device__ __forceinline__ const char* b_base(const Unit& u) const { return (const char*)(Bt + (size_t)u.pn * 256 * ldb); }
    __device__ __forceinline__ void epi(const Acc& acc, const Unit& u, int wr, int wc, int fr, int fq) const {
        float rs[2][4]; FOR_AI FOR_M rs[ai][m] = fx_load(ssq_kv + u.pm * 256 + RT_(ai, m));
        FOR_AI FOR_M { const int row = u.pm * 256 + RT_(ai, m); const float r_ = __builtin_amdgcn_rsqf(rs[ai][m] * (1.0f / KVLORA) + EPS);
            FOR_BJ { const int col = u.pn * 256 + bj * 128 + 32 * wc + 8 * fq; store8_fp8(K8 + (size_t)row * 512 + col, acc[ai][bj][m][0] * r_, acc[ai][bj][m][1] * r_); } }
    }
};
struct OpVT {
    static constexpr bool PERM = true, GATHER = false, FP8 = true;
    const bf16_t* A; const bf16_t* Bt; int K, lda, ldb;
    unsigned char* VT8; const u64* ssq_kv;
    __device__ __forceinline__ int brow(int c) const { return (c & ~63) + key_of_slot(c & 63); }
    __device__ __forceinline__ unsigned a_off(int r, int c) const { return (unsigned)(r * lda + c) * 2u; }
    __device__ __forceinline__ const char* a_base(const Unit& u) const { return (const char*)(A + (size_t)u.pm * 256 * lda); }
    __device__ __forceinline__ const char* b_base(const Unit& u) const { return (const char*)(Bt + (size_t)u.pn * 256 * ldb); }
    __device__ __forceinline__ void epi(const Acc& acc, const Unit& u, int wr, int wc, int fr, int fq) const {
        float rs[2][2][4];
        FOR_BJ _Pragma("unroll") for (int n = 0; n < 2; ++n) _Pragma("unroll") for (int j = 0; j < 4; ++j) { const int c = bj * 128 + 32 * wc + 8 * fq + 4 * n + j; rs[bj][n][j] = fx_load(ssq_kv + u.pn * 256 + (c & ~63) + key_of_slot(c & 63)); }
        FOR_BJ _Pragma("unroll") for (int n = 0; n < 2; ++n) _Pragma("unroll") for (int j = 0; j < 4; ++j) rs[bj][n][j] = __builtin_amdgcn_rsqf(rs[bj][n][j] * (1.0f / KVLORA) + EPS);
        FOR_AI FOR_M FOR_BJ { f32x4 v0 = acc[ai][bj][m][0], v1 = acc[ai][bj][m][1];
            _Pragma("unroll") for (int j = 0; j < 4; ++j) { v0[j] *= rs[bj][0][j]; v1[j] *= rs[bj][1][j]; }
            const size_t grp = (size_t)u.pn * 4 + 2 * bj + (wc >> 1);
            store8_fp8(VT8 + (grp * 512 + u.pm * 256 + RT_(ai, m)) * 64 + (wc & 1) * 32 + 8 * fq, v0, v1); }
    }
};
struct OpYB {
    static constexpr bool PERM = true, GATHER = false, FP8 = false;
    const bf16_t* A; const bf16_t* Bt; int K, lda, ldb;
    bf16_t* GBM;
    __device__ __forceinline__ unsigned a_off(int r, int c) const { return (unsigned)(r * lda + c) * 2u; }
    __device__ __forceinline__ const char* a_base(const Unit& u) const { return (const char*)(A + (size_t)u.pm * 256 * lda); }
    __device__ __forceinline__ const char* b_base(const Unit& u) const { return (const char*)(Bt + (size_t)u.pn * 256 * ldb); }
    __device__ __forceinline__ void epi(const Acc& acc, const Unit& u, int wr, int wc, int fr, int fq) const {
        bf16_t* base = GBM + (size_t)u.pm * 256 * DM + u.pn * 256 + 32 * wc + 8 * fq;
        u32x4 gb[2][4][2]; FOR_AI FOR_M FOR_BJ gb[ai][m][bj] = *(const u32x4*)(base + (size_t)RT_(ai, m) * DM + bj * 128);
        FOR_AI FOR_M FOR_BJ { f32x4 g0, g1; unpack8(gb[ai][m][bj], g0, g1); store8(base + (size_t)RT_(ai, m) * DM + bj * 128, g0 * acc[ai][bj][m][0], g1 * acc[ai][bj][m][1]); }
    }
};
struct OpYA {
    static constexpr bool PERM = true, GATHER = false, FP8 = true;
    const bf16_t* A; const bf16_t* Bt; int K, lda, ldb;
    const bf16_t* GA; bf16_t* MB;
    __device__ __forceinline__ unsigned a_off(int r, int c) const { return (unsigned)(r * lda + c) * 2u; }
    __device__ __forceinline__ const char* a_base(const Unit& u) const { return (const char*)(A + (size_t)u.pm * 256 * lda); }
    __device__ __forceinline__ const char* b_base(const Unit& u) const { return (const char*)(Bt + (size_t)u.pn * 256 * ldb); }
    __device__ __forceinline__ void epi(const Acc& acc, const Unit& u, int wr, int wc, int fr, int fq) const {
        const size_t off0 = (size_t)u.pm * 256 * DM + u.pn * 256 + 32 * wc + 8 * fq;
        FOR_AI { u32x2 ga[4][2]; u32x4 mb[4][2]; FOR_M FOR_BJ { const size_t off = off0 + (size_t)RT_(ai, m) * DM + bj * 128; ga[m][bj] = *(const u32x2*)((const unsigned char*)GA + off); mb[m][bj] = *(const u32x4*)(MB + off); }
            FOR_M FOR_BJ { const size_t off = off0 + (size_t)RT_(ai, m) * DM + bj * 128; f32x4 g0, g1, b0, b1; unpack8_fp8(ga[m][bj], g0, g1); unpack8(mb[m][bj], b0, b1);
                store8(MB + off, g0 * (acc[ai][bj][m][0] * (0.0625f / 256.f)) + b0, g1 * (acc[ai][bj][m][1] * (0.0625f / 256.f)) + b1); } }
    }
};
template <bool BASE_F32, bool F8 = false> struct OpRes {
    static constexpr bool PERM = true, GATHER = false, FP8 = F8;
    const bf16_t* A; const bf16_t* Bt; int K, lda, ldb;
    const void* base; bf16_t* Hout; u64* ssq; size_t bbatch;
    unsigned char* H8; float ascale;
    __device__ __forceinline__ unsigned a_off(int r, int c) const { return (unsigned)(r * lda + c) * 2u; }
    __device__ __forceinline__ const char* a_base(const Unit& u) const { return (const char*)(A + (size_t)u.pm * 256 * lda); }
    __device__ __forceinline__ const char* b_base(const Unit& u) const { return (const char*)(Bt + (size_t)(u.pm >> 4) * bbatch + (size_t)u.pn * 256 * ldb); }
    __device__ __forceinline__ void epi(const Acc& acc, const Unit& u, int wr, int wc, int fr, int fq) const {
        const size_t off0 = (size_t)u.pm * 256 * DM + u.pn * 256 + 32 * wc + 8 * fq;
        constexpr int MB_ = BASE_F32 ? 2 : 4;
        FOR_AI _Pragma("unroll") for (int m0 = 0; m0 < 4; m0 += MB_) { f32x4 bv[MB_][2][2];
            _Pragma("unroll") for (int mi = 0; mi < MB_; ++mi) FOR_BJ { const size_t off = off0 + (size_t)RT_(ai, m0 + mi) * DM + bj * 128;
                if (BASE_F32) { bv[mi][bj][0] = *(const f32x4*)((const float*)base + off); bv[mi][bj][1] = *(const f32x4*)((const float*)base + off + 4); } else load8((const bf16_t*)base + off, bv[mi][bj][0], bv[mi][bj][1]); }
            _Pragma("unroll") for (int mi = 0; mi < MB_; ++mi) { const int m = m0 + mi; float s = 0.f;
                FOR_BJ { const size_t off = off0 + (size_t)RT_(ai, m) * DM + bj * 128; const f32x4 h0 = bv[mi][bj][0] + acc[ai][bj][m][0] * ascale, h1 = bv[mi][bj][1] + acc[ai][bj][m][1] * ascale; s += ssq8(h0, h1); store8(Hout + off, h0, h1); if (H8) store8_fp8(H8 + off, h0, h1); }
                row_atomic_add(ssq + u.pm * 256 + RT_(ai, m), s, fq); }
            asm volatile("" ::: "memory"); }
    }
};
struct OpPre {
    static constexpr bool PERM = true, GATHER = false, FP8 = false;
    const bf16_t* KVM; const bf16_t* W; int K, lda, ldb; unsigned char* O; int mode;
    __device__ __forceinline__ unsigned a_off(int r, int c) const { return (unsigned)(r * lda + c) * 2u; }
    __device__ __forceinline__ const char* a_base(const Unit& u) const { return mode == 0 ? (const char*)(KVM + (size_t)(u.pm >> 2) * 256 * 2048 + (u.pm & 3) * 256) : (const char*)(W + (size_t)(u.pm & 3) * 256 * DM + u.pn * 256); }
    __device__ __forceinline__ const char* b_base(const Unit& u) const { return mode == 0 ? (const char*)(W + (size_t)u.pn * 256 * DM + (u.pm & 3) * 256) : (const char*)(KVM + (size_t)(u.pm >> 2) * 256 * 2048 + DM + u.pn * 256); }
    __device__ __forceinline__ void epi(const Acc& acc, const Unit& u, int wr, int wc, int fr, int fq) const {
        unsigned char* base = O + (size_t)u.pm * 256 * DM + u.pn * 256 + 32 * wc + 8 * fq;
        FOR_AI FOR_M FOR_BJ store8_fp8(base + (size_t)RT_(ai, m) * DM + bj * 128, acc[ai][bj][m][0] * 32.f, acc[ai][bj][m][1] * 32.f);
    }
};
struct OpSX {
    static constexpr bool PERM = true, GATHER = false, FP8 = true;
    const bf16_t* A; const bf16_t* BQK; int K, lda, ldb;
    unsigned char* P; const u64* ssq1; LAS f32x4* ps;
    __device__ __forceinline__ unsigned a_off(int r, int c) const { return (unsigned)(r * lda + c) * 2u; }
    __device__ __forceinline__ const char* a_base(const Unit& u) const { return (const char*)(A + (size_t)u.pm * 256 * lda); }
    __device__ __forceinline__ const char* b_base(const Unit& u) const { return (const char*)(BQK + ((size_t)(u.pm >> 4) * DM + u.pn * 256) * ldb); }
    __device__ __forceinline__ void epi(Acc& acc, const Unit& u, int wr, int wc, int fr, int fq) const {
        float rs[2][4]; FOR_AI FOR_M rs[ai][m] = fx_load(ssq1 + u.pm * 256 + RT_(ai, m));
        FOR_AI FOR_M { const float r_ = C2X * __builtin_amdgcn_rsqf(rs[ai][m] * (1.0f / DM) + EPS); float s = 0.f;
            FOR_BJ { _Pragma("unroll") for (int n = 0; n < 2; ++n) _Pragma("unroll") for (int j = 0; j < 4; ++j) { const float e = fast_exp2(acc[ai][bj][m][n][j] * r_); acc[ai][bj][m][n][j] = e; s += e; } }
            s += __shfl_xor(s, 1); s += __shfl_xor(s, 2);
            if (fq == 0) ((LAS float*)(ps + RT_(ai, m)))[wc] = s; }
        asm volatile("s_waitcnt lgkmcnt(0)\n\ts_barrier" ::: "memory");
        unsigned char* base = P + (size_t)u.pm * 256 * DM + u.pn * 256 + 32 * wc + 8 * fq;
        FOR_AI FOR_M { const f32x4 q = ps[RT_(ai, m)]; const float inv = 256.f * __builtin_amdgcn_rcpf((q[0] + q[1]) + (q[2] + q[3]));
            FOR_BJ store8_fp8(base + (size_t)RT_(ai, m) * DM + bj * 128, acc[ai][bj][m][0] * inv, acc[ai][bj][m][1] * inv); }
    }
};
struct OpR {
    static constexpr bool PERM = false, GATHER = false, FP8 = false;
    const bf16_t* A; const bf16_t* Bt; int K, lda, ldb;
    float* LG; const u64* ssq2;
    __device__ __forceinline__ unsigned a_off(int r, int c) const { return (unsigned)(r * lda + c) * 2u; }
    __device__ __forceinline__ const char* a_base(const Unit& u) const { return (const char*)(A + (size_t)u.pm * 256 * lda); }
    __device__ __forceinline__ const char* b_base(const Unit& u) const { return (const char*)(Bt + (size_t)u.pn * 256 * ldb); }
    __device__ __forceinline__ void epi(const Acc& acc, const Unit& u, int wr, int wc, int fr, int fq) const {
        if (wc > 1) return;
        float rs[2][4]; FOR_AI FOR_M rs[ai][m] = fx_load(ssq2 + u.pm * 256 + RT_(ai, m));
        FOR_AI FOR_M { const int row = u.pm * 256 + RT_(ai, m); const float r_ = __builtin_amdgcn_rsqf(rs[ai][m] * (1.0f / DM) + EPS); float* lg = LG + (size_t)row * 40;
            if (wc == 0) { *(f32x4*)(lg + 4 * fq) = acc[ai][0][m][0] * r_; *(f32x4*)(lg + 16 + 4 * fq) = acc[ai][0][m][1] * r_; }
            else if (fq == 0) { *(f32x4*)(lg + 32) = acc[ai][0][m][0] * r_; } }
    }
};
struct MoeTab { const LAS int* tileE; const LAS int* tbase; const LAS int* cntL; };
template <int NPN> struct MoeOrder {
    int nunits, G, c;
    __device__ __forceinline__ bool next(int i, Unit& u) const { const int L = i * G + c; if (L >= nunits) return false; u.pm = L / NPN; u.pn = L - u.pm * NPN; return true; }
};
struct OpGU {
    static constexpr bool PERM = true, GATHER = true, FP8 = true;
    const bf16_t* A; const bf16_t* WGUp; int K, lda, ldb;
    unsigned char* HID  ; const int* LIST; const float* WL; const float* RSL; MoeTab tb;
    __device__ __forceinline__ unsigned a_off_u(const Unit& u, int r, int c) const { const int e = tb.tileE[u.pm]; const int p = (u.pm - tb.tbase[e]) * 256 + r;
        const int tok = p < tb.cntL[e] ? (LIST[(size_t)e * NTOK + p] >> 1) : 0; return (unsigned)(tok * lda + c) * 2u; }
    __device__ __forceinline__ const char* a_base(const Unit&) const { return (const char*)A; }
    __device__ __forceinline__ const char* b_base(const Unit& u) const { return (const char*)(WGUp + ((size_t)tb.tileE[u.pm] * 512 + u.pn * 256) * ldb); }
    __device__ __forceinline__ void epi(const Acc& acc, const Unit& u, int wr, int wc, int fr, int fq) const {
        const int e = tb.tileE[u.pm], row0 = (u.pm - tb.tbase[e]) * 256, ce = tb.cntL[e]; const size_t lb = (size_t)e * NTOK + row0;
        float cw[2][4], rs[2][4];
        FOR_AI FOR_M { const int r = RT_(ai, m); const bool v = row0 + r < ce; cw[ai][m] = v ? WL[lb + r] : 0.f; rs[ai][m] = v ? RSL[lb + r] : 0.f; }
        unsigned char* base = HID + (size_t)u.pm * 256 * EFF + u.pn * 128 + 32 * wc + 8 * fq;
        FOR_AI FOR_M { const float r_ = rs[ai][m], c_ = cw[ai][m]; f32x4 h0, h1;
#pragma unroll
            for (int j = 0; j < 4; ++j) { const float g0 = acc[ai][0][m][0][j] * r_, u0 = acc[ai][1][m][0][j] * r_, g1 = acc[ai][0][m][1][j] * r_, u1 = acc[ai][1][m][1][j] * r_;
                h0[j] = g0 * sigmoidf_(g0) * u0 * c_ * 16.f; h1[j] = g1 * sigmoidf_(g1) * u1 * c_ * 16.f; }
            store8_fp8(base + (size_t)RT_(ai, m) * EFF, h0, h1); }
    }
};
struct OpDN {
    static constexpr bool PERM = true, GATHER = false, FP8 = true;
    const bf16_t* HID; const bf16_t* WDp; int K, lda, ldb;
    unsigned char* Y  ; const int* LIST; MoeTab tb;
    __device__ __forceinline__ unsigned a_off(int r, int c) const { return (unsigned)(r * lda + c) * 2u; }
    __device__ __forceinline__ const char* a_base(const Unit& u) const { return (const char*)(HID + (size_t)u.pm * 256 * lda); }
    __device__ __forceinline__ const char* b_base(const Unit& u) const { return (const char*)(WDp + ((size_t)tb.tileE[u.pm] * DM + u.pn * 256) * ldb); }
    __device__ __forceinline__ void epi(const Acc& acc, const Unit& u, int wr, int wc, int fr, int fq) const {
        const int e = tb.tileE[u.pm], row0 = (u.pm - tb.tbase[e]) * 256, ce = tb.cntL[e]; const size_t lb = (size_t)e * NTOK + row0;
        int ent[2][4];
        FOR_AI FOR_M { const int r = RT_(ai, m); ent[ai][m] = row0 + r < ce ? LIST[lb + r] : -1; }
        FOR_AI FOR_M { const int en = ent[ai][m];
            if (en >= 0) { unsigned char* p = Y + ((size_t)(en & 1) * NTOK + (size_t)(en >> 1)) * DM + u.pn * 256 + 32 * wc + 8 * fq;
                FOR_BJ store8_fp8(p + bj * 128, acc[ai][bj][m][0], acc[ai][bj][m][1]); } }
    }
};
__device__ __forceinline__ int moe_build_tables(const unsigned* cnt, LAS int* cntL, LAS int* tbase, LAS int* tileE, int tid) {
    if (tid < NEXP) cntL[tid] = (int)__hip_atomic_load(cnt + tid, RLX_AGENT);
    __syncthreads();
    if (tid == 0) { int acc_ = 0; for (int e = 0; e < NEXP; ++e) { tbase[e] = acc_; acc_ += (cntL[e] + 255) >> 8; } tbase[NEXP] = acc_; }
    __syncthreads();
    const int nt = tbase[NEXP];
    for (int t = tid; t < nt; t += 512) { int e = 0; for (int k = 1; k < NEXP; ++k) e += (tbase[k] <= t) ? 1 : 0; tileE[t] = e; }
    __syncthreads();
    return __builtin_amdgcn_readfirstlane(nt);
}

namespace mla {
constexpr int KSLOT = 4096, RSLOT = 2048, VSLOT = 4096, NSLOT = 8;
constexpr int L_K = 0, L_R = NSLOT * KSLOT, L_V = L_R + NSLOT * RSLOT, L_WS = L_V + NSLOT * VSLOT, L_OST = L_WS + 8 * 256, L_DUM = L_OST + 8 * 4096, L_END = L_DUM + 8 * 1024;
static_assert(L_END <= RING_BYTES, "attention LDS");
constexpr float THR = 6.0f;
__device__ __forceinline__ int crow(int r, int hi) { return (r & 3) + 8 * (r >> 2) + 4 * hi; }
__device__ __forceinline__ void glds16(const void* gsrc, unsigned lds_dst) { unsigned keep;
    asm volatile("s_mov_b32 %0, m0\n\ts_mov_b32 m0, %2\n\ts_nop 0\n\tglobal_load_lds_dwordx4 %1, off\n\ts_mov_b32 m0, %0" : "=&s"(keep) : "v"(gsrc), "s"(lds_dst) : "memory"); }
#define MX3(a, b, c) __builtin_fmaxf(__builtin_fmaxf((a), (b)), (c))
__device__ __forceinline__ float rowmax(const f32x16& p0, const f32x16& p1) {
    float a = MX3(p0[0], p0[1], p1[0]), b = MX3(p0[2], p0[3], p1[1]); a = MX3(a, p1[2], p1[3]);
#pragma unroll
    for (int r = 4; r < 16; r += 4) { a = MX3(a, p0[r], p0[r + 1]); b = MX3(b, p0[r + 2], p0[r + 3]); a = MX3(a, p1[r], p1[r + 1]); b = MX3(b, p1[r + 2], p1[r + 3]); }
    a = __builtin_fmaxf(a, b);
    auto rr = __builtin_amdgcn_permlane32_swap(__float_as_uint(a), __float_as_uint(a), false, false);
    return __builtin_fmaxf(__uint_as_float(rr[0]), __uint_as_float(rr[1]));
}
#define MLA_SC1 0x7F7F7F7F
#define MLA_SCQ 0x7B7B7B7B
template <bool GA> __device__ __forceinline__ void attn_unit(int b, int h, int qb, const unsigned char* Q8, const unsigned char* K8, const unsigned char* KR8, const unsigned char* VT8, bf16_t* O, LAS unsigned char* shm, const int wv_) {
    int tid = wv_ * 64 + lane_mb(); asm volatile("" : "+v"(tid));
    const int lane = tid & 63, r32 = lane & 31, hi = lane >> 5; const int wid = __builtin_amdgcn_readfirstlane(tid >> 6);
    const long rowbase = (long)b * SEQ; const int q0 = qb * 256;
    const unsigned lds0 = (unsigned)(uintptr_t)shm;
    LAS float* wsf = (LAS float*)(shm + L_WS) + wid * 64;
    const int sw1 = (lane & 3) ^ ((lane >> 4) & 3);
    const unsigned char* src1 = wid < 4 ? K8 + (rowbase + wid * 16 + (lane >> 2)) * 512 + h * 64 + sw1 * 16
                                        : VT8 + ((size_t)(rowbase >> 6) * 512 + h * 64 + (wid - 4) * 16 + (lane >> 2)) * 64 + sw1 * 16;
    const long step1 = wid < 4 ? 64 * 512 : 512 * 64;
    const unsigned dst1 = wid < 4 ? lds0 + L_K + wid * 1024 : lds0 + L_V + (wid - 4) * 1024; const unsigned slot1 = wid < 4 ? KSLOT : VSLOT;
    const unsigned char* src2 = wid < 2 ? KR8 + (rowbase + wid * 32 + (lane >> 1)) * ROPE + ((lane & 1) ^ ((lane >> 4) & 1)) * 16 : src1;
    const long step2 = wid < 2 ? 64 * ROPE : step1;
    const unsigned dst2 = wid < 2 ? lds0 + L_R + wid * 1024 : lds0 + L_DUM + wid * 1024; const unsigned slot2 = wid < 2 ? RSLOT : 0;
#define MLA_DMA(t, s) do { glds16(src1 + (long)(t) * step1, (unsigned)__builtin_amdgcn_readfirstlane(dst1 + (s) * slot1)); \
        glds16(src2 + (long)(t) * step2, (unsigned)__builtin_amdgcn_readfirstlane(dst2 + (s) * slot2)); } while (0)
    const int NT = 4 * qb + 4, nvis = 4 * qb + (wid >> 1) + 1;
    v8i_t qf[2];
    { const unsigned char* qp = Q8 + (rowbase + q0 + wid * 32 + r32) * 1024 + h * 128 + hi * 32;
#pragma unroll
      for (int st = 0; st < 2; ++st) qf[st] = __builtin_shufflevector(*(const v4i_t*)(qp + st * 64), *(const v4i_t*)(qp + st * 64 + 16), 0, 1, 2, 3, 4, 5, 6, 7); }
    asm volatile("" ::: "memory");
    MLA_DMA(0, 0); MLA_DMA(1, 1); MLA_DMA(2, 2); MLA_DMA(3, 3);
    float mrun = 0.f; f32x16 o[2], lacc;
#pragma unroll
    for (int r = 0; r < 16; ++r) { float z0, z1, z2; asm volatile("v_mov_b32 %0, 0\n\tv_mov_b32 %1, 0\n\tv_mov_b32 %2, 0" : "=v"(z0), "=v"(z1), "=v"(z2)); o[0][r] = z0; o[1][r] = z1; lacc[r] = z2; }
    f32x16 negm;
#pragma unroll
    for (int r = 0; r < 16; ++r) { float z_; asm volatile("v_mov_b32 %0, 0" : "=v"(z_)); negm[r] = z_; }
    v8i_t kn0, kn1, kr0, kr1, p8;
    const int swr = (r32 >> 2) & 3, k64a = ((2 * hi) ^ swr) * 16, k64b = ((2 * hi + 1) ^ swr) * 16, k32a = ((r32 >> 3) & 1) * 16;
#define MLA_KLD(sl_) do { const LAS unsigned char* kp = shm + L_K + (sl_) * KSLOT + r32 * 64; const LAS unsigned char* rp = shm + L_R + (sl_) * RSLOT + r32 * 32; \
        kn0 = __builtin_shufflevector(*(const LAS v4i_t*)(kp + k64a), *(const LAS v4i_t*)(kp + k64b), 0, 1, 2, 3, 4, 5, 6, 7); \
        kn1 = __builtin_shufflevector(*(const LAS v4i_t*)(kp + 2048 + k64a), *(const LAS v4i_t*)(kp + 2048 + k64b), 0, 1, 2, 3, 4, 5, 6, 7); \
        kr0 = __builtin_shufflevector(*(const LAS v4i_t*)(rp + k32a), *(const LAS v4i_t*)(rp + (k32a ^ 16)), 0, 1, 2, 3, 4, 5, 6, 7);      \
        kr1 = __builtin_shufflevector(*(const LAS v4i_t*)(rp + 1024 + k32a), *(const LAS v4i_t*)(rp + 1024 + (k32a ^ 16)), 0, 1, 2, 3, 4, 5, 6, 7); } while (0)
#define MLA_VLD(sl_) do { const LAS unsigned char* vp = shm + L_V + (sl_) * VSLOT + r32 * 64; \
        vf0 = __builtin_shufflevector(*(const LAS v4i_t*)(vp + k64a), *(const LAS v4i_t*)(vp + k64b), 0, 1, 2, 3, 4, 5, 6, 7); \
        vf1 = __builtin_shufflevector(*(const LAS v4i_t*)(vp + 2048 + k64a), *(const LAS v4i_t*)(vp + 2048 + k64b), 0, 1, 2, 3, 4, 5, 6, 7); } while (0)
#define MLA_MF(a_, b_, c_, sa_, sb_) __builtin_amdgcn_mfma_scale_f32_32x32x64_f8f6f4(a_, b_, c_, 0, 0, 0, sa_, 0, sb_)
#define MLA_QK(P0, P1) do { \
        P0 = MLA_MF(kn0, qf[0], negm, MLA_SC1, MLA_SCQ); P1 = MLA_MF(kn1, qf[0], negm, MLA_SC1, MLA_SCQ); \
        P0 = MLA_MF(kr0, qf[1], P0, MLA_SC1, MLA_SCQ); P1 = MLA_MF(kr1, qf[1], P1, MLA_SC1, MLA_SCQ); } while (0)
#define MLA_PV() do { o[0] = MLA_MF(p8, vf0, o[0], MLA_SC1, MLA_SC1); o[1] = MLA_MF(p8, vf1, o[1], MLA_SC1, MLA_SC1); { v8i_t ones; _Pragma("unroll") for (int i = 0; i < 8; ++i) { int w_; asm volatile("v_mov_b32 %0, 0x38383838" : "=v"(w_)); ones[i] = w_; }        \
          lacc = MLA_MF(p8, ones, lacc, MLA_SC1, MLA_SC1); } } while (0)
#define MLA_SM(PA0, PA1, PB0, PB1, t, ADJB) do { \
            const float rm = rowmax(PA0, PA1); \
            if (__any(rm > THR)) { const float dl = __builtin_fmaxf(rm, 0.f); mrun += dl; \
                _Pragma("unroll") for (int r = 0; r < 16; ++r) { PA0[r] -= dl; PA1[r] -= dl; } \
                if (ADJB && (t) + 1 < nvis) { _Pragma("unroll") for (int r = 0; r < 16; ++r) { PB0[r] -= dl; PB1[r] -= dl; } } \
                _Pragma("unroll") for (int r = 0; r < 16; ++r) negm[r] = -mrun; \
                asm volatile("" : "+v"(negm)); \
                const float f = fast_exp2(-dl); if (hi == 0) wsf[r32] = f; LDS_WAIT(); \
                _Pragma("unroll") for (int r = 0; r < 16; ++r) { const float fr_ = wsf[crow(r, hi)]; o[0][r] *= fr_; o[1][r] *= fr_; lacc[r] *= fr_; } \
                LDS_WAIT(); } \
            _Pragma("unroll") for (int r = 0; r < 16; ++r) { PA0[r] = fast_exp2(PA0[r]); PA1[r] = fast_exp2(PA1[r]); } \
            _Pragma("unroll") for (int i = 0; i < 4; ++i) { p8[i] = (int)cvt4_fp8(PA0[4 * i], PA0[4 * i + 1], PA0[4 * i + 2], PA0[4 * i + 3]); p8[4 + i] = (int)cvt4_fp8(PA1[4 * i], PA1[4 * i + 1], PA1[4 * i + 2], PA1[4 * i + 3]); } \
        } while (0)
#define MLA_STEP(PA0, PA1, PB0, PB1, t) do { \
        if ((t) + 2 < NT) { if ((t) + 3 < NT) asm volatile("s_waitcnt vmcnt(2) lgkmcnt(0)\n\ts_barrier" ::: "memory"); else asm volatile("s_waitcnt vmcnt(0) lgkmcnt(0)\n\ts_barrier" ::: "memory"); } \
        if ((t) + 4 < NT) MLA_DMA((t) + 4, ((t) + 4) & 7); \
        v8i_t vf0, vf1;                                                       \
        if constexpr (GA) { \
            const bool pv_ = (t) >= 1 && (t) - 1 < nvis; \
            if (pv_) MLA_VLD(((t) - 1) & 7); \
            if ((t) + 1 < nvis) MLA_QK(PB0, PB1); \
            if (pv_) MLA_PV(); \
            if ((t) < nvis) MLA_SM(PA0, PA1, PB0, PB1, t, true); \
            __builtin_amdgcn_sched_barrier(0); \
            if ((t) + 2 < nvis) MLA_KLD(((t) + 2) & 7); \
        } else { \
            if ((t) < nvis) { \
                MLA_VLD((t) & 7); \
                if ((t) + 1 < nvis) MLA_KLD(((t) + 1) & 7); \
                MLA_SM(PA0, PA1, PB0, PB1, t, false); \
                __builtin_amdgcn_sched_barrier(0); \
                if ((t) + 1 < nvis) MLA_QK(PB0, PB1); \
                MLA_PV(); } \
        } \
    } while (0)
    asm volatile("s_waitcnt vmcnt(4) lgkmcnt(0)\n\ts_barrier" ::: "memory");
    f32x16 pA0, pA1, pB0, pB1;
    MLA_KLD(0); MLA_QK(pA0, pA1);
    { const float rm = rowmax(pA0, pA1); mrun = rm;
#pragma unroll
        for (int r = 0; r < 16; ++r) { pA0[r] -= rm; pA1[r] -= rm; negm[r] = -rm; }
        asm volatile("" : "+v"(negm)); }
    if (GA && 1 < nvis) MLA_KLD(1);
    for (int t = 0; t < NT; t += 2) {
        MLA_STEP(pA0, pA1, pB0, pB1, t);
        MLA_STEP(pB0, pB1, pA0, pA1, t + 1);
    }
    if (GA && nvis == NT) { v8i_t vf0, vf1; MLA_VLD((NT - 1) & 7); MLA_PV(); }
#undef MLA_SM
#undef MLA_VLD
#undef MLA_MF
#undef MLA_PV
#undef MLA_KLD
#undef MLA_QK
#undef MLA_STEP
    float rli[16];
#pragma unroll
    for (int r = 0; r < 16; ++r) rli[r] = __builtin_amdgcn_rcpf(lacc[r]);
    unsigned char* Ow = (unsigned char*)O + (rowbase + q0 + wid * 32) * 512 + h * 64;
    { LAS unsigned char* stg = (LAS unsigned char*)(shm + L_OST) + wid * 4096;
#pragma unroll
        for (int r = 0; r < 16; ++r) { const int orow = crow(r, hi); const unsigned w = cvt4_fp8(o[0][r] * rli[r] * 16.f, o[1][r] * rli[r] * 16.f, 0.f, 0.f);
            stg[orow * 64 + r32] = (unsigned char)(w & 0xffu); stg[orow * 64 + 32 + r32] = (unsigned char)((w >> 8) & 0xffu); }
        LDS_WAIT();
#pragma unroll
        for (int i = 0; i < 2; ++i) { const int row = i * 16 + (lane >> 2), ch = lane & 3; const u32x4 v = *(const LAS u32x4*)(stg + row * 64 + ch * 16); *(u32x4*)(Ow + (long)row * 512 + ch * 16) = v; } }
    asm volatile("s_waitcnt lgkmcnt(0)\n\ts_barrier" ::: "memory");
#undef MLA_DMA
#undef MX3
}
}

#define XB_TMO      128
#define XB_XCNT(j)  (256  + 64 * (j))
#define XB_XSUB(j)  (1280 + 64 * (j))
#define XB_XGEN(j)  (2304 + 64 * (j))
#define XB_TOP      3328
#define XB_TOPGEN   3392
#define XCD_BAR_WORDS 3456
#define XB_SPIN_CAP (1u << 18)
__device__ __forceinline__ unsigned xb_ld(unsigned* p)              { return __hip_atomic_load(p, __ATOMIC_RELAXED, __HIP_MEMORY_SCOPE_AGENT); }
__device__ __forceinline__ unsigned xb_add(unsigned* p, unsigned v) { return __hip_atomic_fetch_add(p, v, __ATOMIC_RELAXED, __HIP_MEMORY_SCOPE_AGENT); }
__device__ __forceinline__ unsigned xb_xcc_id() { return (unsigned)__builtin_amdgcn_s_getreg((3 << 11) | 20) & 0xFu; }
#define XB_SPIN(cond, bar) do { unsigned _sp = 0; while (cond) { __builtin_amdgcn_s_sleep(1); \
    if ((++_sp & 255u) == 0u) { if (xb_ld(&(bar)[XB_TMO])) break; if (_sp > XB_SPIN_CAP) { atomicAdd(&(bar)[XB_TMO], 1u); break; } } } } while (0)
struct XcdBarrier { unsigned* bar; unsigned x; volatile LAS unsigned* st; int w; };
__device__ __forceinline__ XcdBarrier xcd_barrier_post(unsigned* bar, volatile LAS unsigned* st) {
    XcdBarrier b; b.bar = bar; b.x = xb_xcc_id(); b.st = st;
    if (threadIdx.x == 0) (void)xb_add(&bar[XB_XCNT(b.x)], 1u);
    return b;
}
__device__ __forceinline__ void xcd_barrier_complete(unsigned* bar, unsigned x, unsigned& nloc, unsigned& nx) {
    const unsigned G = gridDim.x * gridDim.y * gridDim.z;
    unsigned sum, cnt, mine, sp = 0u;
    for (;;) {
        sum = 0u; cnt = 0u; mine = 0u;
#pragma unroll
        for (unsigned j = 0; j < 16; ++j) { const unsigned c = xb_ld(&bar[XB_XCNT(j)]); sum += c; cnt += (c > 0u) ? 1u : 0u; mine = (j == x) ? c : mine; }
        if (sum == G) break;
        __builtin_amdgcn_s_sleep(1);
        if ((++sp & 255u) == 0u) { if (xb_ld(&bar[XB_TMO])) break; if (sp > XB_SPIN_CAP) { atomicAdd(&bar[XB_TMO], 1u); break; } }
    }
    nloc = mine > 0u ? mine : 1u; nx = cnt > 0u ? cnt : 1u;
}
__device__ __forceinline__ void xcd_barrier(const XcdBarrier& b) {
    asm volatile("s_waitcnt vmcnt(0)" ::: "memory");
    __syncthreads();
    if (b.w == 0 && lane_mb() == 0) {
        unsigned* bar = b.bar;
        __builtin_amdgcn_s_waitcnt(0);
        unsigned nloc = b.st[0], nx = b.st[1];
        if (nloc == 0u) { xcd_barrier_complete(bar, b.x, nloc, nx); b.st[0] = nloc; b.st[1] = nx; }
        const unsigned old = xb_add(&bar[XB_XSUB(b.x)], 1u);
        const unsigned gen = old / nloc;
        if (old + 1u == (gen + 1u) * nloc) {
            __builtin_amdgcn_fence(__ATOMIC_RELEASE, "agent");
            asm volatile("s_waitcnt vmcnt(0)" ::: "memory");
            const unsigned og = xb_add(&bar[XB_TOP], 1u);
            const unsigned tg = og / nx;
            if (og + 1u == (tg + 1u) * nx) xb_add(&bar[XB_TOPGEN], 1u);
            else XB_SPIN(xb_ld(&bar[XB_TOPGEN]) == tg, bar);
            __builtin_amdgcn_fence(__ATOMIC_ACQUIRE, "agent");
            xb_add(&bar[XB_XGEN(b.x)], 1u);
            asm volatile("s_waitcnt vmcnt(0)" ::: "memory");
        } else {
            XB_SPIN(xb_ld(&bar[XB_XGEN(b.x)]) == gen, bar);
            __builtin_amdgcn_fence(__ATOMIC_ACQUIRE, "agent");
            asm volatile("s_waitcnt vmcnt(0)" ::: "memory");
        }
    }
    __syncthreads();
}

__device__ __forceinline__ void transpose_block(const float* src, int ldw, const float* gain, bf16_t* dst  , int ldt, LAS float* scr, int lane, unsigned char* dst8 = nullptr, int ldt8 = 0, float sc8 = 1.f) {
    float tv[32];
#pragma unroll
    for (int i = 0; i < 32; ++i) { const int kk = 2 * i + (lane >> 5); tv[i] = src ? src[(size_t)kk * ldw + (lane & 31)] : 0.f; }
#pragma unroll
    for (int i = 0; i < 32; ++i) { const int kk = 2 * i + (lane >> 5); float v = tv[i]; if (gain) v *= gain[kk]; scr[kk * 33 + (lane & 31)] = v; }
    LDS_WAIT(); asm volatile("" ::: "memory");
    const int c = lane & 7;
#pragma unroll
    for (int j = 0; j < 4; ++j) { const int n = (lane >> 3) + 8 * j; const LAS float* s = scr + (8 * c) * 33 + n;
        u32x4 o; o.x = cvt_pk_bf16(s[0 * 33], s[1 * 33]); o.y = cvt_pk_bf16(s[2 * 33], s[3 * 33]); o.z = cvt_pk_bf16(s[4 * 33], s[5 * 33]); o.w = cvt_pk_bf16(s[6 * 33], s[7 * 33]);
        if (dst) *(u32x4*)(dst + (size_t)n * ldt + 8 * c) = o;
        if (dst8) { u32x2 o8; o8.x = cvt4_fp8(s[0 * 33] * sc8, s[1 * 33] * sc8, s[2 * 33] * sc8, s[3 * 33] * sc8); o8.y = cvt4_fp8(s[4 * 33] * sc8, s[5 * 33] * sc8, s[6 * 33] * sc8, s[7 * 33] * sc8);
            *(u32x2*)(dst8 + (size_t)n * ldt8 + 8 * c) = o8; } }
    LDS_WAIT(); asm volatile("" ::: "memory");
}
__device__ __forceinline__ void rms_row_to_bf16(const float* xrow, const float* g, bf16_t* orow, int lane) {
    const f32x4* xr = (const f32x4*)xrow + lane; const f32x4* gr = (const f32x4*)g + lane;
    f32x4 v[4]; float s = 0.f;
#pragma unroll
    for (int j = 0; j < 4; ++j) { v[j] = xr[64 * j]; s += (v[j].x * v[j].x + v[j].y * v[j].y) + (v[j].z * v[j].z + v[j].w * v[j].w); }
    const float rstd = 1.0f / sqrtf(wave_sum(s) * (1.f / DM) + EPS);
    u32x2* o8 = (u32x2*)orow + lane;
#pragma unroll
    for (int j = 0; j < 4; ++j) { const f32x4 gg = gr[64 * j]; u32x2 w; w.x = cvt_pk_bf16(v[j].x * rstd * gg.x, v[j].y * rstd * gg.y); w.y = cvt_pk_bf16(v[j].z * rstd * gg.z, v[j].w * rstd * gg.w); o8[64 * j] = w; }
}

__device__ __forceinline__ void rms_row2_to_bf16(const float* xrow, const float* g, bf16_t* orow, int lane, unsigned char* orow8 = nullptr) {
    const f32x4* xr = (const f32x4*)xrow + lane; const f32x4* gr = (const f32x4*)g + lane;
    f32x4 v[2][4]; float s[2] = {0.f, 0.f};
#pragma unroll
    for (int r = 0; r < 2; ++r)
#pragma unroll
        for (int j = 0; j < 4; ++j) v[r][j] = xr[r * 256 + 64 * j];
#pragma unroll
    for (int r = 0; r < 2; ++r)
#pragma unroll
        for (int j = 0; j < 4; ++j) s[r] += (v[r][j].x * v[r][j].x + v[r][j].y * v[r][j].y) + (v[r][j].z * v[r][j].z + v[r][j].w * v[r][j].w);
#pragma unroll
    for (int r = 0; r < 2; ++r) { const float rstd = 1.0f / sqrtf(wave_sum(s[r]) * (1.f / DM) + EPS); u32x2* o8 = (u32x2*)(orow + (size_t)r * DM) + lane;
#pragma unroll
        for (int j = 0; j < 4; ++j) { const f32x4 gg = gr[64 * j]; u32x2 w; w.x = cvt_pk_bf16(v[r][j].x * rstd * gg.x, v[r][j].y * rstd * gg.y); w.y = cvt_pk_bf16(v[r][j].z * rstd * gg.z, v[r][j].w * rstd * gg.w); o8[64 * j] = w;
            if (orow8) ((unsigned*)(orow8 + (size_t)r * DM))[lane + 64 * j] = cvt4_fp8(v[r][j].x * rstd * gg.x, v[r][j].y * rstd * gg.y, v[r][j].z * rstd * gg.z, v[r][j].w * rstd * gg.w); } }
}
struct Args { const void* in[28]; float* out; unsigned char* ws; int ph_lo, ph_hi; };
constexpr int NPHASE = 12;

#define CAS __attribute__((address_space(4)))
#define PHASE_PTRS const CAS char* ka_ = (const CAS char*)__builtin_amdgcn_kernarg_segment_ptr(); asm volatile("" : "+s"(ka_)); unsigned char* ws = *(unsigned char* const CAS*)(ka_ + 232); float* outp = *(float* const CAS*)(ka_ + 224); const float* x = *(const float* const CAS*)(ka_ + 0); const float* mem = *(const float* const CAS*)(ka_ + 8); const int* positions = *(const int* const CAS*)(ka_ + 16); const float* mix_norm_g = *(const float* const CAS*)(ka_ + 24); const float* w_in = *(const float* const CAS*)(ka_ + 32); const float* q_norm_g = *(const float* const CAS*)(ka_ + 40); const float* w_q_up = *(const float* const CAS*)(ka_ + 48); const float* kv_norm_g = *(const float* const CAS*)(ka_ + 56); const float* w_kv_up = *(const float* const CAS*)(ka_ + 64); const float* w_attn_branch = *(const float* const CAS*)(ka_ + 72); const float* pool_w = *(const float* const CAS*)(ka_ + 80); const float* pool_scale = *(const float* const CAS*)(ka_ + 88); const float* w_pool_branch = *(const float* const CAS*)(ka_ + 96); const float* w_mix_out = *(const float* const CAS*)(ka_ + 104); const float* xattn_norm_g = *(const float* const CAS*)(ka_ + 112); const float* mem_norm_g = *(const float* const CAS*)(ka_ + 120); const float* w_xq = *(const float* const CAS*)(ka_ + 128); const float* w_xkv = *(const float* const CAS*)(ka_ + 136); const float* w_xo = *(const float* const CAS*)(ka_ + 144); const float* ffn_norm_g = *(const float* const CAS*)(ka_ + 152); const float* w_rg = *(const float* const CAS*)(ka_ + 160); const float* b_rg = *(const float* const CAS*)(ka_ + 168); const float* w_re = *(const float* const CAS*)(ka_ + 176); const float* b_re = *(const float* const CAS*)(ka_ + 184); const float* w_eg = *(const float* const CAS*)(ka_ + 192); const float* w_eu = *(const float* const CAS*)(ka_ + 200); const float* w_ed = *(const float* const CAS*)(ka_ + 208); const float* final_g = *(const float* const CAS*)(ka_ + 216); u64* ssq_q = (u64*)(ws + OFF_SSQQ); u64* ssq_kv = (u64*)(ws + OFF_SSQKV); u64* ssq1 = (u64*)(ws + OFF_SSQ1); u64* ssq2 = (u64*)(ws + OFF_SSQ2); unsigned* cnt = (unsigned*)(ws + OFF_CNT); float* cosT = (float*)(ws + WS_COS); float* sinT = (float*)(ws + WS_SIN); unsigned char* WIN8 = ws + WS_WIN8; unsigned char* HN8 = ws + WS_S6;     bf16_t* WIN = (bf16_t*)(ws + WS_WIN); unsigned char* WQ8 = ws + WS_WQ; unsigned char* WKVU8 = ws + WS_WKVU; unsigned char* WA8 = ws + WS_WA; bf16_t* WPB = (bf16_t*)(ws + WS_WPB); bf16_t* WMO = (bf16_t*)(ws + WS_WMO); bf16_t* WXKV = (bf16_t*)(ws + WS_WXKV); bf16_t* WXO = (bf16_t*)(ws + WS_WXO); bf16_t* WR = (bf16_t*)(ws + WS_WR); unsigned char* WGU8 = ws + WS_WGU; unsigned char* H28 = ws + WS_S5; unsigned char* WD8 = ws + WS_WD; bf16_t* MEMN = (bf16_t*)(ws + WS_MEMN); bf16_t* KVM = (bf16_t*)(ws + WS_KVM); bf16_t* WXQN = (bf16_t*)(ws + WS_WXQN); unsigned char* BQK = ws + WS_BQK; unsigned char* BVO = ws + WS_BVO; unsigned char* H18 = ws + WS_S5; unsigned char* P8 = ws + WS_S1; float* LG = (float*)(ws + WS_LG); bf16_t* HN = (bf16_t*)(ws + WS_S0); bf16_t* Qb = (bf16_t*)(ws + WS_S0); bf16_t* H1 = (bf16_t*)(ws + WS_S0); bf16_t* GA = (bf16_t*)(ws + WS_S1); bf16_t* XQ = (bf16_t*)(ws + WS_S1); bf16_t* Y = (bf16_t*)(ws + WS_S1); bf16_t* GBM = (bf16_t*)(ws + WS_S2); bf16_t* QLb = (bf16_t*)(ws + WS_QLB); bf16_t* KVLb = (bf16_t*)(ws + WS_KVLB); bf16_t* KRb = (bf16_t*)(ws + WS_KRB); bf16_t* H2 = (bf16_t*)(ws + WS_S3); bf16_t* U = (bf16_t*)(ws + WS_U); bf16_t* DP = (bf16_t*)(ws + WS_DP); unsigned char* HID = ws + WS_HID; int* LIST = (int*)(ws + WS_LIST); float* WL = (float*)(ws + WS_WL); float* RSL = (float*)(ws + WS_RSL); unsigned char* K8 = ws + WS_S5; unsigned char* VT8 = ws + WS_S5 + 64 * MiB; unsigned char* Q8 = ws + WS_S0; bf16_t* ATT = (bf16_t*)(ws + WS_ATT); (void)outp; int tidp_ = wave * 64 + lane_mb(); asm volatile("" : "+v"(tidp_)); const int tid = tidp_, lane = tid & 63, gt = bx * 512 + tid; (void)lane; (void)gt;
__global__ void __launch_bounds__(512, 2) fwd_kernel(Args args) {
    extern __shared__ __attribute__((aligned(16))) unsigned char lds_raw[];
    LAS unsigned char* lds = (LAS unsigned char*)lds_raw;
    LAS unsigned char* misc = lds + MISC_OFF;
    const int tid = threadIdx.x, lane = tid & 63, wave = __builtin_amdgcn_readfirstlane(tid >> 6);
    const int G = gridDim.x, bx = blockIdx.x;
    const int vcu = (G % 8 == 0) ? (bx % 8) * (G / 8) + bx / 8 : bx;
    for (int u = tid; u < (LDS_BYTES - MISC_OFF) / 4; u += 512) ((LAS unsigned*)misc)[u] = 0u;
    __syncthreads();
    unsigned* barw = (unsigned*)(args.ws + WS_CTL);
    XcdBarrier bar; bar.bar = barw; bar.x = 0; bar.st = nullptr; bar.w = wave;
    if (MK_N_LAUNCHES == 1) { bar = xcd_barrier_post(barw, (volatile LAS unsigned*)(misc + MO_BAR)); bar.w = wave; }
#define GRID_BAR() do { if (MK_N_LAUNCHES == 1) xcd_barrier(bar); } while (0)
    const int lo = args.ph_lo, hi = args.ph_hi;
#ifndef PH_MASK
#define PH_MASK 0xfff
#endif
#define IN(k) ((((PH_MASK) >> (k)) & 1) && lo <= (k) && (k) < hi)
#define BOTH(k) (IN(k) && IN((k) + 1))
    const int gw = vcu * 8 + wave, NGW = G * 8;
    const int gt = bx * 512 + tid, NGT = G * 512;

    if (IN(0)) {
        PHASE_PTRS
        for (int i = gt; i < (int)(SMALL_ZERO_BYTES / 4); i += NGT) ((unsigned*)(ws + WS_SMALL))[i] = 0u;
        for (int i = gt; i < NTOK * 16; i += NGT) { const int row = i >> 4, k = i & 15;
            const float inv = (float)exp2(-(double)k * (13.287712379549449 / 16.0)); const float ang = (float)positions[row] * inv;
            const double rev = (double)ang * 0.15915494309189535; const float fr_ = (float)(rev - rint(rev));
            cosT[i] = __builtin_amdgcn_cosf(fr_); sinT[i] = __builtin_amdgcn_sinf(fr_); }
        for (int i = gt; i < POOLW * DM; i += NGT) { const int n = i & (DM - 1), k = i >> 10, g = k >> 7; const float* pw = pool_w + (size_t)k * 128; const float* sc = pool_scale + g * 128; const float* wb = w_pool_branch + (size_t)g * 128 * DM + n;
            float s = 0.f;
            for (int e = 0; e < 128; ++e) s += pw[e] * sc[e] * wb[(size_t)e * DM];
            WPB[(size_t)n * POOLW + k] = (bf16_t)(cvt_pk_bf16(s, 0.f) & 0xffffu); }
        for (int i = gt; i < DM * DM / 8; i += NGT) { const int k = i >> 7; const float g_ = xattn_norm_g[k]; const f32x4 a0 = *(const f32x4*)(w_xq + (size_t)i * 8), a1 = *(const f32x4*)(w_xq + (size_t)i * 8 + 4); store8(WXQN + (size_t)i * 8, a0 * g_, a1 * g_); }
        for (int i = gt; i < 256 * DM; i += NGT) { const int n = i >> 10, k = i & (DM - 1); float v = 0.f;
            if (n < 32) v = w_re[k * 32 + n] * ffn_norm_g[k]; else if (n < 36) v = w_rg[k * 4 + (n - 32)] * ffn_norm_g[k];
            WR[i] = (bf16_t)(cvt_pk_bf16(v, 0.f) & 0xffffu); }
        {
            LAS float* scr = (LAS float*)(lds + wave * 16384);
            constexpr int I_IN = 16 * 104, I_Q = 8 * 24, I_KV = 4 * 32, I_A = 8 * 32, I_SQ = 16 * 32, I_XKV = 16 * 64, I_GU = 32 * 16 * 16, I_D = 32 * 4 * 32;
            constexpr int NITEMS = I_IN + I_Q + I_KV + I_A + 2 * I_SQ + I_XKV + I_GU + I_D;
            for (int it = gw; it < NITEMS; it += NGW) {
                int r = it;
                if (r < I_IN) { const int kb = r / 104, nb = r % 104, n0 = nb * 32; const int sn = n0 < 672 ? n0 : (n0 < 768 ? -1 : n0 - 96);
                    transpose_block(sn >= 0 ? w_in + (size_t)kb * 64 * IN_COLS + sn : nullptr, IN_COLS, nullptr, WIN + (size_t)n0 * DM + kb * 64, DM, scr, lane, (n0 >= 1280 || n0 < 768) ? WIN8 + (size_t)n0 * DM + kb * 64 : nullptr, DM, 32.f); continue; } r -= I_IN;
                if (r < I_Q) { const int kb = r / 24, nb = r % 24; transpose_block(kb < 6 ? w_q_up + (size_t)kb * 64 * 768 + nb * 32 : nullptr, 768, kb < 6 ? q_norm_g + kb * 64 : nullptr, nullptr, 512, scr, lane, WQ8 + (size_t)nb * 32 * 512 + kb * 64, 512, 32.f); continue; } r -= I_Q;
                if (r < I_KV) { const int kb = r / 32, nb = r % 32, n0 = nb * 32; const int nn = n0 & 511, sn = (nn >> 6) * 128 + (n0 >= 512 ? 64 : 0) + (nn & 63);
                    transpose_block(w_kv_up + (size_t)kb * 64 * 1024 + sn, 1024, kv_norm_g + kb * 64, nullptr, KVLORA, scr, lane, WKVU8 + (size_t)n0 * KVLORA + kb * 64, KVLORA, 32.f); continue; } r -= I_KV;
                if (r < I_A) { const int kb = r / 32, nb = r % 32; transpose_block(w_attn_branch + (size_t)kb * 64 * DM + nb * 32, DM, nullptr, nullptr, 512, scr, lane, WA8 + (size_t)nb * 32 * 512 + kb * 64, 512, 32.f); continue; } r -= I_A;
                if (r < I_SQ) { const int kb = r / 32, nb = r % 32; transpose_block(w_mix_out + (size_t)kb * 64 * DM + nb * 32, DM, nullptr, WMO + (size_t)nb * 32 * DM + kb * 64, DM, scr, lane); continue; } r -= I_SQ;
                if (r < I_SQ) { const int kb = r / 32, nb = r % 32; transpose_block(w_xo + (size_t)kb * 64 * DM + nb * 32, DM, nullptr, WXO + (size_t)nb * 32 * DM + kb * 64, DM, scr, lane); continue; } r -= I_SQ;
                if (r < I_XKV) { const int kb = r / 64, nb = r % 64; transpose_block(w_xkv + (size_t)kb * 64 * 2048 + nb * 32, 2048, nullptr, WXKV + (size_t)nb * 32 * DM + kb * 64, DM, scr, lane); continue; } r -= I_XKV;
                if (r < I_GU) { const int e = r / 256, q = r % 256, kb = q / 16, nb = q % 16, n0 = nb * 32;
                    const int pn = n0 >> 8, j = n0 & 255; const float* srcm = (j < 128 ? w_eg : w_eu) + (size_t)e * DM * EFF; const int sc = pn * 128 + (j & 127);
                    transpose_block(srcm + (size_t)kb * 64 * EFF + sc, EFF, ffn_norm_g + kb * 64, nullptr, DM, scr, lane, WGU8 + ((size_t)e * 512 + n0) * DM + kb * 64, DM, 32.f); continue; } r -= I_GU;
                { const int e = r / 128, q = r % 128, kb = q / 32, nb = q % 32;
                    transpose_block(w_ed + (size_t)e * EFF * DM + (size_t)kb * 64 * DM + nb * 32, DM, nullptr, nullptr, EFF, scr, lane, WD8 + ((size_t)e * DM + nb * 32) * EFF + kb * 64, EFF, 32.f); }
            }
        }
        for (int m = gw * 2; m < NTOK; m += NGW * 2) rms_row2_to_bf16(x + (size_t)m * DM, mix_norm_g, HN + (size_t)m * DM, lane, HN8 + (size_t)m * DM);
        for (int m = gw; m < NMEM; m += NGW) rms_row_to_bf16(mem + (size_t)m * DM, mem_norm_g, MEMN + (size_t)m * DM, lane);
        if (BOTH(0)) GRID_BAR();
    }

    if (IN(1)) {
        PHASE_PTRS
        { OpIn op{HN, WIN, DM, DM, DM, QLb, KVLb, KRb, U, GA, GBM, ssq_q, ssq_kv, cosT, sinT}; OffsetOrder S; S.s.init(NTOK, 512, G, bx); S.off = 3; pg8::gemm_phase(lds, op, S, wave); }
        { OpPlain op{MEMN, WXKV, DM, DM, DM, KVM, 2 * DM}; pg8::StaticOrder S; S.init(NMEM, 2 * DM, G, bx); pg8::gemm_phase(lds, op, S, wave); }
    }
    if (IN(1)) {
        PHASE_PTRS
        { OpIn8 op{(const bf16_t*)HN8, (const bf16_t*)WIN8, DM / 2, DM / 2, DM / 2, QLb, KVLb, KRb, U, GA, GBM, ssq_q, ssq_kv, cosT, sinT}; pg8::StaticOrder S; S.init(NTOK, 768, G, bx); pg8::gemm_phase(lds, op, S, wave); }
        { OpGate8 op{(const bf16_t*)HN8, (const bf16_t*)WIN8, DM / 2, DM / 2, DM / 2, GA, GBM};
          GateOrder S; S.s.init(NTOK, 2048, G, bx); S.off = 5; S.light = (NMEM / 256) * (2 * DM / 256); pg8::gemm_phase(lds, op, S, wave); }
        if (BOTH(1)) GRID_BAR();
    }

    if (IN(2)) {
        PHASE_PTRS
        { OpPre op{KVM, WXQN, 256, 2 * DM, DM, BQK, 0}; pg8::StaticOrder S; S.init(16 * DM, DM, G, bx); pg8::gemm_phase(lds, op, S, wave); }
        { OpPre op{KVM, WXO, 256, DM, 2 * DM, BVO, 1}; pg8::StaticOrder S; S.init(16 * DM, DM, G, bx); pg8::gemm_phase(lds, op, S, wave); }
        { OpQ op{QLb, (const bf16_t*)WQ8, 256, 256, 256, Q8, ssq_q, cosT, sinT}; pg8::StaticOrder S; S.init(NTOK, NHEAD * QKD, G, bx); pg8::gemm_phase(lds, op, S, wave); }
        { OpK8 op{KVLb, (const bf16_t*)WKVU8, KVLORA / 2, KVLORA / 2, KVLORA / 2, K8, ssq_kv}; pg8::StaticOrder S; S.init(NTOK, 512, G, bx); pg8::gemm_phase(lds, op, S, wave); }
        { OpVT op{(const bf16_t*)(WKVU8 + 512 * KVLORA), KVLb, KVLORA / 2, KVLORA / 2, KVLORA / 2, VT8, ssq_kv}; pg8::StaticOrder S; S.init(512, NTOK, G, bx); pg8::gemm_phase(lds, op, S, wave); }
        { RELANE
        static_assert((4 * (NTOK / 4)) % 2 == 0, "item pairs");
        for (int it = gw; it < 4 * (NTOK / 4); it += 2 * NGW) { const int g = it & 3, ch = g * 16 + (lane & 15); const bool two_ = it + NGW < 4 * (NTOK / 4);
            const int rowA = (it >> 2) * 4 + (lane >> 4), rowB = two_ ? ((it + NGW) >> 2) * 4 + (lane >> 4) : rowA, tA = rowA & (SEQ - 1), tB = rowB & (SEQ - 1);
            const bf16_t* pA = U + (size_t)rowA * POOLW + ch * 8; const bf16_t* pB = U + (size_t)rowB * POOLW + ch * 8;
            f32x4 a0, a1, ua0, ua1, b0, b1, ub0, ub1; load8(pA, ua0, ua1); load8(pB, ub0, ub1); a0 = ua0; a1 = ua1; b0 = ub0; b1 = ub1;
#define DP_WIN(W) { u32x4 wa_[W - 1], wb_[W - 1]; \
                    _Pragma("unroll") for (int j = 1; j < W; ++j) { wa_[j - 1] = *(const u32x4*)(pA - (size_t)(j <= tA ? j : 0) * POOLW); wb_[j - 1] = *(const u32x4*)(pB - (size_t)(j <= tB ? j : 0) * POOLW); } \
                    _Pragma("unroll") for (int j = 1; j < W; ++j) { const u32x4 w = wa_[j - 1]; const float k_ = (j <= tA) ? 1.f : 0.f; a0 += (f32x4){bf_lo(w.x), bf_hi(w.x), bf_lo(w.y), bf_hi(w.y)} * k_; a1 += (f32x4){bf_lo(w.z), bf_hi(w.z), bf_lo(w.w), bf_hi(w.w)} * k_; } \
                    _Pragma("unroll") for (int j = 1; j < W; ++j) { const u32x4 w = wb_[j - 1]; const float k_ = (j <= tB) ? 1.f : 0.f; b0 += (f32x4){bf_lo(w.x), bf_hi(w.x), bf_lo(w.y), bf_hi(w.y)} * k_; b1 += (f32x4){bf_lo(w.z), bf_hi(w.z), bf_lo(w.w), bf_hi(w.w)} * k_; } }
            if (g == 0) DP_WIN(2) else if (g == 1) DP_WIN(4) else if (g == 2) DP_WIN(8) else DP_WIN(16)
#undef DP_WIN
            const int w = 2 << g, nA = (tA + 1 < w) ? tA + 1 : w, nB = (tB + 1 < w) ? tB + 1 : w; const float invA = 1.0f / (float)nA, invB = 1.0f / (float)nB;
            store8(DP + (size_t)rowA * POOLW + ch * 8, a0 * invA - ua0, a1 * invA - ua1);
            if (two_) store8(DP + (size_t)rowB * POOLW + ch * 8, b0 * invB - ub0, b1 * invB - ub1); }
        }
        if (BOTH(2)) GRID_BAR();
    }

    if (IN(3)) {
        PHASE_PTRS
        { OpYB op{DP, WPB, POOLW, POOLW, POOLW, GBM}; pg8::StaticOrder S; S.init(NTOK, DM, G, bx); pg8::gemm_phase(lds, op, S, wave); }
        { const int bh = vcu >> 1, half = vcu & 1;
          if (bh < NBATCH * NHEAD) for (int i = 0; i < 8; ++i) { const int pr = i >> 1, od = i & 1; const int qb = 4 * pr + (od ? (half ? 2 : 3) : (half ? 1 : 0));
              if (wave < 4) mla::attn_unit<true>(bh >> 3, bh & 7, qb, Q8, K8, (const unsigned char*)KRb, VT8, ATT, lds, wave); else mla::attn_unit<false>(bh >> 3, bh & 7, qb, Q8, K8, (const unsigned char*)KRb, VT8, ATT, lds, wave); } }
        if (BOTH(3)) GRID_BAR();
    }

    if (IN(4)) {
        PHASE_PTRS
        { OpYA op{ATT, (const bf16_t*)WA8, 256, 256, 256, GA, GBM}; pg8::StaticOrder S; S.init(NTOK, DM, G, bx); pg8::gemm_phase(lds, op, S, wave); }
        if (BOTH(4)) GRID_BAR();
    }

    if (IN(5)) {
        PHASE_PTRS
        { OpRes<true> op{GBM, WMO, DM, DM, DM, x, H1, ssq1, 0, H18, 1.0f}; pg8::StaticOrder S; S.init(NTOK, DM, G, bx); pg8::gemm_phase(lds, op, S, wave); }
        if (BOTH(5)) GRID_BAR();
    }

    if (IN(6)) {
        PHASE_PTRS
        { OpSX op{(const bf16_t*)H18, (const bf16_t*)BQK, DM / 2, DM / 2, DM / 2, P8, ssq1, (LAS f32x4*)(misc + MO_PS)}; pg8::StaticOrder S; S.init(NTOK, DM, G, bx); pg8::gemm_phase(lds, op, S, wave); }
        if (BOTH(6)) GRID_BAR();
    }

    if (IN(7)) {
        PHASE_PTRS
        { OpRes<false, true> op{(const bf16_t*)P8, (const bf16_t*)BVO, DM / 2, DM / 2, DM / 2, H1, H2, ssq2, (size_t)DM * DM / 2, H28, 1.0f / 256.f}; pg8::StaticOrder S; S.init(NTOK, DM, G, bx); pg8::gemm_phase(lds, op, S, wave); }
        if (BOTH(7)) GRID_BAR();
    }

    if (IN(8)) {
        PHASE_PTRS
        pg8::StaticOrder S; S.init(NTOK, 256, G, bx);
        { OpR op{H2, WR, DM, DM, DM, LG, ssq2}; pg8::gemm_phase(lds, op, S, wave); }
        { RELANE
        VM_WAIT(); __syncthreads(); __builtin_amdgcn_fence(__ATOMIC_ACQUIRE, "agent"); VM_WAIT(); __syncthreads();
        LAS unsigned* hist = (LAS unsigned*)(misc + MO_HIST); LAS unsigned* basee = (LAS unsigned*)(misc + MO_BASE);
        pg8::StaticOrder S2; S2.init(NTOK, 256, G, bx);
        for (int i = 0; i < (256 + G - 1) / G; ++i) { Unit u; if (!S2.next(i, u)) break;
            if (tid < 32) hist[tid] = 0u;
            __syncthreads();
            int e1 = 0, e2 = 0; float w1 = 0.f, w2 = 0.f; unsigned r1 = 0, r2 = 0; const int row = u.pm * 256 + tid;
            if (tid < 256) {
                const float* lg = LG + (size_t)row * 40;
                float gl[4]; int gi = 0;
#pragma unroll
                for (int j = 0; j < 4; ++j) gl[j] = lg[32 + j] + b_rg[j];
                float gm = gl[0];
#pragma unroll
                for (int j = 1; j < 4; ++j) if (gl[j] > gm) { gm = gl[j]; gi = j; }
                float gs = 0.f;
#pragma unroll
                for (int j = 0; j < 4; ++j) gs += __expf(gl[j] - gm);
                const float gwt = 1.0f / gs;
                float el[8];
#pragma unroll
                for (int j = 0; j < 8; ++j) el[j] = lg[gi * 8 + j] + b_re[gi * 8 + j];
                int i1 = 0; float m1 = el[0];
#pragma unroll
                for (int j = 1; j < 8; ++j) if (el[j] > m1) { m1 = el[j]; i1 = j; }
                int i2 = -1; float m2 = -3.0e38f;
#pragma unroll
                for (int j = 0; j < 8; ++j) if (j != i1 && el[j] > m2) { m2 = el[j]; i2 = j; }
                const float p2 = __expf(m2 - m1);
                w1 = gwt / (1.0f + p2); w2 = gwt * p2 / (1.0f + p2);
                e1 = gi * 8 + i1; e2 = gi * 8 + i2;
                r1 = __hip_atomic_fetch_add(&hist[e1], 1u, __ATOMIC_RELAXED, __HIP_MEMORY_SCOPE_WORKGROUP); r2 = __hip_atomic_fetch_add(&hist[e2], 1u, __ATOMIC_RELAXED, __HIP_MEMORY_SCOPE_WORKGROUP);
            }
            __syncthreads();
            if (tid < 32) basee[tid] = hist[tid] ? __hip_atomic_fetch_add(cnt + tid, hist[tid], RLX_AGENT) : 0u;
            __syncthreads();
            if (tid < 256) { const size_t p1 = (size_t)e1 * NTOK + basee[e1] + r1, p2 = (size_t)e2 * NTOK + basee[e2] + r2;
                const float rs_ = __builtin_amdgcn_rsqf(fx_load(ssq2 + row) * (1.0f / DM) + EPS);
                LIST[p1] = row * 2; WL[p1] = w1; RSL[p1] = rs_; LIST[p2] = row * 2 + 1; WL[p2] = w2; RSL[p2] = rs_; }
            __syncthreads();
        }
        }
        if (BOTH(8)) GRID_BAR();
    }

    if (IN(9)) {
        PHASE_PTRS
        LAS int* cntL = (LAS int*)(misc + MO_CNTL); LAS int* tbase = (LAS int*)(misc + MO_TBASE); LAS int* tileE = (LAS int*)(misc + MO_TILEE);
        const int ntile = moe_build_tables(cnt, cntL, tbase, tileE, tid);
        { OpGU op{(const bf16_t*)H28, (const bf16_t*)WGU8, DM / 2, DM / 2, DM / 2, HID, LIST, WL, RSL, MoeTab{tileE, tbase, cntL}}; MoeOrder<2> S{ntile * 2, G, vcu}; pg8::gemm_phase(lds, op, S, wave); }
        if (BOTH(9)) GRID_BAR();
    }

    if (IN(10)) {
        PHASE_PTRS
        LAS int* cntL = (LAS int*)(misc + MO_CNTL); LAS int* tbase = (LAS int*)(misc + MO_TBASE); LAS int* tileE = (LAS int*)(misc + MO_TILEE);
        const int ntile = moe_build_tables(cnt, cntL, tbase, tileE, tid);
        { OpDN op{(const bf16_t*)HID, (const bf16_t*)WD8, EFF / 2, EFF / 2, EFF / 2, (unsigned char*)Y, LIST, MoeTab{tileE, tbase, cntL}}; MoeOrder<4> S{ntile * 4, G, vcu}; pg8::gemm_phase(lds, op, S, wave); }
        if (BOTH(10)) GRID_BAR();
    }

    if (IN(11)) {
        PHASE_PTRS
        const f32x4 g00 = *(const f32x4*)(final_g + lane * 8), g01 = *(const f32x4*)(final_g + lane * 8 + 4), g10 = *(const f32x4*)(final_g + 512 + lane * 8), g11 = *(const f32x4*)(final_g + 512 + lane * 8 + 4);
        for (int m = gw * 2; m < NTOK; m += NGW * 2) {
            u32x4 w[2][2]; u32x2 y8[2][2][2]; const unsigned char* Y8 = (const unsigned char*)Y;
#pragma unroll
            for (int r = 0; r < 2; ++r)
#pragma unroll
                for (int hf = 0; hf < 2; ++hf) { const size_t o = (size_t)(m + r) * DM + hf * 512 + lane * 8; w[r][hf] = *(const u32x4*)(H2 + o); y8[r][hf][0] = *(const u32x2*)(Y8 + o); y8[r][hf][1] = *(const u32x2*)(Y8 + (size_t)NTOK * DM + o); }
#pragma unroll
            for (int r = 0; r < 2; ++r) { f32x4 v[2][2]; float s = 0.f;
#pragma unroll
                for (int hf = 0; hf < 2; ++hf) { f32x4 a0, a1, b0, b1, c0, c1; unpack8(w[r][hf], a0, a1); unpack8_fp8(y8[r][hf][0], b0, b1); unpack8_fp8(y8[r][hf][1], c0, c1);
                    a0 += (b0 + c0) * 0.0625f; a1 += (b1 + c1) * 0.0625f; v[hf][0] = a0; v[hf][1] = a1; s += ssq8(a0, a1); }
                const float rstd = 1.0f / sqrtf(wave_sum(s) * (1.f / DM) + EPS); float* op_ = outp + (size_t)(m + r) * DM + lane * 8;
                *(f32x4*)(op_) = v[0][0] * rstd * g00; *(f32x4*)(op_ + 4) = v[0][1] * rstd * g01; *(f32x4*)(op_ + 512) = v[1][0] * rstd * g10; *(f32x4*)(op_ + 516) = v[1][1] * rstd * g11; }
        }
    }
#undef IN
#undef BOTH
#undef GRID_BAR
}

extern "C" void kernel_launch(void* const* d_in, const int* in_sizes, int n_in, void* d_out, int out_size, void* d_ws, size_t ws_size, hipStream_t stream) {
    static int grid = 0;
    if (grid == 0) {
        if (n_in != 28 || in_sizes[0] != NTOK * DM || out_size != NTOK * DM || ws_size < WS_END) { fprintf(stderr, "kernel_launch: unexpected shapes (n_in %d, in0 %d, out %d, ws %zu); nothing launched\n", n_in, n_in > 0 ? in_sizes[0] : -1, out_size, ws_size); grid = -1; return; }
        int dev = 0, cus = 0, per_cu = 0;
        if (hipGetDevice(&dev) != hipSuccess || hipDeviceGetAttribute(&cus, hipDeviceAttributeMultiprocessorCount, dev) != hipSuccess) { fprintf(stderr, "kernel_launch: device query failed\n"); grid = -1; return; }
        if (hipFuncSetAttribute((const void*)fwd_kernel, hipFuncAttributeMaxDynamicSharedMemorySize, LDS_BYTES) != hipSuccess) { fprintf(stderr, "kernel_launch: hipFuncSetAttribute failed\n"); grid = -1; return; }
        if (hipOccupancyMaxActiveBlocksPerMultiprocessor(&per_cu, (const void*)fwd_kernel, 512, LDS_BYTES) != hipSuccess || per_cu < 1) { fprintf(stderr, "kernel_launch: occupancy query reports %d blocks per CU\n", per_cu); }
        (void)hipGetLastError();
        grid = cus;
        if (grid > 256) grid = 256;
    }
    if (grid < 0) return;
    (void)hipMemsetAsync((char*)d_ws + WS_CTL, 0, CTL_ZERO_BYTES, stream);
    Args a{};
    for (int i = 0; i < 28; ++i) a.in[i] = d_in[i];
    a.out = (float*)d_out; a.ws = (unsigned char*)d_ws;
    if (MK_N_LAUNCHES == 1) { a.ph_lo = 0; a.ph_hi = NPHASE; hipLaunchKernelGGL(fwd_kernel, dim3(grid), dim3(512), LDS_BYTES, stream, a); }
    else for (int p = 0; p < NPHASE; ++p) { a.ph_lo = p; a.ph_hi = p + 1; hipLaunchKernelGGL(fwd_kernel, dim3(grid), dim3(512), LDS_BYTES, stream, a); }
    const hipError_t le = hipPeekAtLastError();
    if (le != hipSuccess) fprintf(stderr, "kernel_launch: launch failed: %s\n", hipGetErrorName(le));
}
```

```cpp
#include <hip/hip_runtime.h>
#include <cstdio>
#include <cstdint>
#include <type_traits>
#include <utility>

#ifndef PG8_SP2
#define PG8_SP2 1
#endif
#ifndef PG8_ALIGN_EPI
#define PG8_ALIGN_EPI 1
#endif
#ifndef MK_N_LAUNCHES
#define MK_N_LAUNCHES 1
#endif

#define GAS __attribute__((address_space(1)))
#define LAS __attribute__((address_space(3)))
typedef unsigned short bf16_t;
typedef short bf16x8 __attribute__((ext_vector_type(8)));
typedef short s16x4 __attribute__((ext_vector_type(4)));
typedef float f32x2 __attribute__((ext_vector_type(2)));
typedef float f32x4 __attribute__((ext_vector_type(4)));
typedef float f32x16 __attribute__((ext_vector_type(16)));
typedef unsigned u32x4 __attribute__((ext_vector_type(4)));
typedef unsigned u32x2 __attribute__((ext_vector_type(2)));
typedef int v4i_t __attribute__((ext_vector_type(4)));
typedef int v8i_t __attribute__((ext_vector_type(8)));
typedef GAS unsigned gu32;
#define RLX_AGENT __ATOMIC_RELAXED, __HIP_MEMORY_SCOPE_AGENT
#define LDS_WAIT() asm volatile("s_waitcnt lgkmcnt(0)" ::: "memory")
#define VM_WAIT() asm volatile("s_waitcnt vmcnt(0)" ::: "memory")

constexpr int DM = 1024, NBATCH = 16, SEQ = 4096, NTOK = NBATCH * SEQ;
constexpr int QLORA = 384, KVLORA = 256, ROPE = 32, POOLW = 512, NHEAD = 8, QKD = 96, VD = 64;
constexpr int MEMLEN = 256, NMEM = NBATCH * MEMLEN;
constexpr int NEXP = 32, EFF = 256;
constexpr int IN_COLS = 3232, IN_PAD = 3328;
constexpr float EPS = 1e-6f;
constexpr float C2Q = 0.10206207261596577f * 1.4426950408889634f;
constexpr float C2X = 0.0625f * 1.4426950408889634f;

constexpr size_t MiB = 1u << 20;
constexpr size_t WS_CTL = 0, CTL_ZERO_BYTES = 64 * 1024;
constexpr size_t WS_SMALL = 1 * MiB;
constexpr size_t OFF_SSQQ = WS_SMALL, OFF_SSQKV = OFF_SSQQ + 524288, OFF_SSQ1 = OFF_SSQKV + 524288, OFF_SSQ2 = OFF_SSQ1 + 524288, OFF_CNT = OFF_SSQ2 + 524288;
constexpr size_t SMALL_ZERO_BYTES = 4 * 524288 + 4096;
constexpr size_t WS_COS = 4 * MiB, WS_SIN = 8 * MiB;
constexpr size_t WS_WIN = 12 * MiB;
constexpr size_t WS_WQ = 19 * MiB;
constexpr size_t WS_WKVU = 20 * MiB;
constexpr size_t WS_WA = 21 * MiB, WS_WPB = 22 * MiB;
constexpr size_t WS_WMO = 23 * MiB, WS_WXKV = 27 * MiB, WS_WXO = 31 * MiB;
constexpr size_t WS_WR = 33 * MiB;
constexpr size_t WS_WGU = 34 * MiB;
constexpr size_t WS_WD = 66 * MiB;
constexpr size_t WS_MEMN = 82 * MiB, WS_KVM = 90 * MiB;
constexpr size_t WS_WIN8 = 122 * MiB;
constexpr size_t WS_WXQN = 120 * MiB;
constexpr size_t WS_BQK = 960 * MiB, WS_BVO = 992 * MiB;
constexpr size_t WS_LG = 106 * MiB;
constexpr size_t WS_S0 = 128 * MiB;
constexpr size_t WS_S1 = 256 * MiB;
constexpr size_t WS_S2 = 384 * MiB;
constexpr size_t WS_S3 = 512 * MiB;
constexpr size_t WS_S4 = 640 * MiB;
constexpr size_t WS_S5 = 768 * MiB;
constexpr size_t WS_S6 = 896 * MiB;
constexpr size_t WS_END = 1024 * MiB;
constexpr size_t WS_QLB = WS_S3, WS_KVLB = WS_S3 + 48 * MiB, WS_KRB = WS_S3 + 80 * MiB;
constexpr size_t WS_U = WS_S4, WS_DP = WS_S4 + 64 * MiB;
constexpr size_t WS_HID = WS_S4, WS_LIST = WS_S4 + 80 * MiB, WS_WL = WS_S4 + 88 * MiB, WS_RSL = WS_S4 + 96 * MiB;
constexpr size_t WS_KN = WS_S5, WS_V = WS_S5 + 64 * MiB;
constexpr size_t WS_ATT = WS_S6;

constexpr int RING_BYTES = 131072;
constexpr int MISC_OFF = RING_BYTES;
constexpr int LDS_BYTES = RING_BYTES + 24576;
constexpr int MO_BAR = 0;
constexpr int MO_HIST = 64, MO_BASE = 64 + 128;
constexpr int MO_CNTL = 1024, MO_TBASE = 1024 + 128, MO_TILEE = 2048;
constexpr int MAX_TILES = 544;
constexpr int MO_PS = 8192;

typedef __bf16 bf16x2_t __attribute__((ext_vector_type(2)));
__device__ __forceinline__ unsigned cvt_pk_bf16(float lo, float hi) { const f32x2 v = {lo, hi}; const bf16x2_t b = __builtin_convertvector(v, bf16x2_t); return __builtin_bit_cast(unsigned, b); }
__device__ __forceinline__ float bf_lo(unsigned w) { return __uint_as_float(w << 16); }
__device__ __forceinline__ float bf_hi(unsigned w) { return __uint_as_float(w & 0xffff0000u); }
__device__ __forceinline__ int lane_mb() { int l; asm volatile("v_mbcnt_lo_u32_b32 %0, -1, 0\n\tv_mbcnt_hi_u32_b32 %0, -1, %0" : "=v"(l)); return l; }
#define RELANE int tidq_ = wave * 64 + lane_mb(); asm volatile("" : "+v"(tidq_)); const int tid = tidq_, lane = tid & 63; (void)lane;
__device__ __forceinline__ void store8(bf16_t* p, const f32x4 v0, const f32x4 v1) {
    u32x4 w; w.x = cvt_pk_bf16(v0[0], v0[1]); w.y = cvt_pk_bf16(v0[2], v0[3]); w.z = cvt_pk_bf16(v1[0], v1[1]); w.w = cvt_pk_bf16(v1[2], v1[3]);
    *(u32x4*)p = w; }
__device__ __forceinline__ unsigned cvt4_fp8(float a, float b, float c, float d) { unsigned w = __float_as_uint(a);      w = __builtin_amdgcn_cvt_pk_fp8_f32(a, b, w, false); w = __builtin_amdgcn_cvt_pk_fp8_f32(c, d, w, true); return w; }
__device__ __forceinline__ void store8_fp8(unsigned char* p, const f32x4 v0, const f32x4 v1) { u32x2 w; w.x = cvt4_fp8(v0[0], v0[1], v0[2], v0[3]); w.y = cvt4_fp8(v1[0], v1[1], v1[2], v1[3]); *(u32x2*)p = w; }
__device__ __forceinline__ void unpack8_fp8(const u32x2 w, f32x4& v0, f32x4& v1) { const f32x2 a = __builtin_amdgcn_cvt_pk_f32_fp8((int)w.x, false), b = __builtin_amdgcn_cvt_pk_f32_fp8((int)w.x, true), c = __builtin_amdgcn_cvt_pk_f32_fp8((int)w.y, false), d = __builtin_amdgcn_cvt_pk_f32_fp8((int)w.y, true);
    v0 = (f32x4){a.x, a.y, b.x, b.y}; v1 = (f32x4){c.x, c.y, d.x, d.y}; }
__device__ __forceinline__ void load8(const bf16_t* p, f32x4& v0, f32x4& v1) {
    const u32x4 w = *(const u32x4*)p; v0 = (f32x4){bf_lo(w.x), bf_hi(w.x), bf_lo(w.y), bf_hi(w.y)}; v1 = (f32x4){bf_lo(w.z), bf_hi(w.z), bf_lo(w.w), bf_hi(w.w)}; }
__device__ __forceinline__ float fast_exp2(float x) { return __builtin_amdgcn_exp2f(x); }
__device__ __forceinline__ float sigmoidf_(float x) { return __builtin_amdgcn_rcpf(1.0f + fast_exp2(-1.4426950408889634f * x)); }
__device__ __forceinline__ float wave_sum(float v) {
#pragma unroll
    for (int o = 1; o < 64; o <<= 1) v += __shfl_xor(v, o);
    return v;
}

namespace pg8 {
#ifndef PG8_WGM
#define PG8_WGM 8
#endif
constexpr int BM = 256, BK = 64, HALF = 128, HTB = HALF * BK * 2, NXCD = 8, WGM = PG8_WGM;
__host__ __device__ __forceinline__ int lds_byte(int r, int c) { const int st = (r >> 4) * 2 + (c >> 5), rr = r & 15, cc = c & 31, ob = rr * 64 + cc * 2; return st * 1024 + (ob ^ (((ob >> 9) & 1) << 5)); }
__host__ __device__ __forceinline__ void stage_rc(int b, int& R, int& C) { const int st = b / 1024, sb = b % 1024, swz = sb ^ (((sb >> 9) & 1) << 5); R = (st >> 1) * 16 + swz / 64; C = (st & 1) * 32 + (swz % 64) / 2; }
__host__ __device__ __forceinline__ int perm32(int rho) { const int n = rho >> 4, i = rho & 15; return 8 * (i >> 2) + 4 * n + (i & 3); }
struct Unit { int pm, pn; };
struct StaticOrder {
    int nM, nN, nwg, G, c;
    __host__ __device__ __forceinline__ void init(int M, int N, int G_, int c_) { nM = M / BM; nN = N / BM; nwg = nM * nN; G = G_; c = c_; }
    __host__ __device__ __forceinline__ bool next(int i, Unit& u) const {
        const long L = (long)i * G + c; if (L >= nwg) return false;
        int wgid = (int)L; { const int q = nwg / NXCD, r = nwg % NXCD, xcd = wgid % NXCD, off = wgid / NXCD; wgid = (xcd < r ? xcd * (q + 1) : r * (q + 1) + (xcd - r) * q) + off; }
        const int nig = WGM * nN, gid = wgid / nig, fm = gid * WGM, gsz = (nM - fm) < WGM ? (nM - fm) : WGM;
        u.pm = fm + ((wgid % nig) % gsz); u.pn = (wgid % nig) / gsz; return true;
    }
};
struct ListOrder {
    int pm, n;
    __device__ __forceinline__ bool next(int i, Unit& u) const { if (i >= n) return false; u.pm = pm; u.pn = i; return true; }
};
template <class T, class = void> struct HasBrow : std::false_type {};
template <class T> struct HasBrow<T, std::void_t<decltype(std::declval<const T&>().brow(0))>> : std::true_type {};
template <class Op, class Sched>
__device__ __forceinline__ void gemm_phase(LAS unsigned char* lds, const Op& op, const Sched& S, const int wv_) {
    int tid_ = wv_ * 64 + lane_mb(); asm volatile("" : "+v"(tid_));
    const int tid = tid_, wid = __builtin_amdgcn_readfirstlane(tid >> 6), lane = tid & 63, wr = wid >> 2, wc = wid & 3, fr = lane & 15, fq = lane >> 4;
    const int K = op.K, nt = K / BK;
    unsigned voffA0[2], voffA1[2], voffB[2];
#pragma unroll
    for (int i = 0; i < 2; ++i) { int R, C; stage_rc(tid * 16 + i * 8192, R, C); int Rb = Op::PERM ? ((R & ~31) + perm32(R & 31)) : R; if constexpr (HasBrow<Op>::value) Rb = op.brow(Rb);
        if constexpr (!Op::GATHER) { voffA0[i] = op.a_off(R, C); voffA1[i] = 0u; } voffB[i] = (unsigned)(Rb * op.ldb + C) * 2u; }
    const size_t kstep = (size_t)(BK * 2);
    const size_t hstepB = (size_t)HALF * op.ldb * 2;
    size_t hstepA = 0; if constexpr (!Op::GATHER) hstepA = (size_t)op.a_off(HALF, 0);
    const unsigned ldsw = (unsigned)wid * 1024u;
    const int aoff = lds_byte(wr * 64 + fr, fq * 8), boff = lds_byte(wc * 32 + fr, fq * 8);
#define PG8_SA(b, h) (((b) * 2 + (h)) * HTB)
#define PG8_SB(b, h) ((4 + (b) * 2 + (h)) * HTB)
#define PG8_STAGE(bufoff, gbase, voff) do { _Pragma("unroll") for (int _i = 0; _i < 2; ++_i) \
        __builtin_amdgcn_global_load_lds((const unsigned*)((const char*)(gbase) + (voff)[_i]), (LAS unsigned*)(lds + (bufoff) + ldsw + _i * 8192), 16, 0, 0); } while (0)
#define PG8_STAGE_A1(bufoff, gbase, vg) do { if constexpr (Op::GATHER) PG8_STAGE(bufoff, gbase, vg); else PG8_STAGE(bufoff, (gbase) + hstepA, voffA0); } while (0)
#define PG8_LDA(dst, b, h) do { if constexpr (Op::FP8) { _Pragma("unroll") for (int m = 0; m < 4; ++m) dst##8[m] = __builtin_shufflevector(*(const LAS v4i_t*)(lds + PG8_SA(b, h) + aoff + m * 2048), *(const LAS v4i_t*)(lds + PG8_SA(b, h) + aoff + m * 2048 + 1024), 0, 1, 2, 3, 4, 5, 6, 7); } \
        else { _Pragma("unroll") for (int m = 0; m < 4; ++m) _Pragma("unroll") for (int k = 0; k < 2; ++k) dst[m][k] = *(const LAS bf16x8*)(lds + PG8_SA(b, h) + aoff + m * 2048 + k * 1024); } } while (0)
#define PG8_LDB(dst, b, h) do { if constexpr (Op::FP8) { _Pragma("unroll") for (int n = 0; n < 2; ++n) dst##8[n] = __builtin_shufflevector(*(const LAS v4i_t*)(lds + PG8_SB(b, h) + boff + n * 2048), *(const LAS v4i_t*)(lds + PG8_SB(b, h) + boff + n * 2048 + 1024), 0, 1, 2, 3, 4, 5, 6, 7); } \
        else { _Pragma("unroll") for (int n = 0; n < 2; ++n) _Pragma("unroll") for (int k = 0; k < 2; ++k) dst[n][k] = *(const LAS bf16x8*)(lds + PG8_SB(b, h) + boff + n * 2048 + k * 1024); } } while (0)
#define PG8_MMA(ai, bj, At, Bt) do { __builtin_amdgcn_s_setprio(1); _Pragma("unroll") for (int m = 0; m < 4; ++m) _Pragma("unroll") for (int n = 0; n < 2; ++n) _Pragma("unroll") for (int k = 0; k < 2; ++k) \
        acc[ai][bj][m][n] = __builtin_amdgcn_mfma_f32_16x16x32_bf16(Bt[n][k], At[m][k], acc[ai][bj][m][n], 0, 0, 0); __builtin_amdgcn_s_setprio(0); } while (0)
#define PG8_MMA8(ai, bj, At, Bt) do { __builtin_amdgcn_s_setprio(1); _Pragma("unroll") for (int m = 0; m < 4; ++m) _Pragma("unroll") for (int n = 0; n < 2; ++n) \
        asm volatile("v_mfma_scale_f32_16x16x128_f8f6f4 %0, %1, %2, %0, %3, %4 op_sel_hi:[0,0,0]" : "+v"(acc[ai][bj][m][n]) : "v"(Bt##8[n]), "v"(At##8[m]), "v"(sclW), "v"(sclA)); \
        __builtin_amdgcn_s_setprio(0); } while (0)
#define PG8_MMAX(ai, bj, At, Bt) do { if constexpr (Op::FP8) PG8_MMA8(ai, bj, At, Bt); else PG8_MMA(ai, bj, At, Bt); } while (0)
#define PG8_WAIT_V(n) asm volatile("s_waitcnt vmcnt(" #n ")" ::: "memory")
#define PG8_WAIT_L(n) asm volatile("s_waitcnt lgkmcnt(" #n ")" ::: "memory")
#define PG8_BAR __builtin_amdgcn_s_barrier()
#define PG8_SCHED __builtin_amdgcn_sched_barrier(0)
    Unit cur, nxt; int ui = 0;
    if (!S.next(0, cur)) return;
    unsigned nvA0[2], nvA1[2];
    if constexpr (Op::GATHER) {
#pragma unroll
        for (int i = 0; i < 2; ++i) { int R, C; stage_rc(tid * 16 + i * 8192, R, C); voffA0[i] = op.a_off_u(cur, R, C); voffA1[i] = op.a_off_u(cur, R + HALF, C); nvA0[i] = voffA0[i]; nvA1[i] = voffA1[i]; } }
    f32x4 acc[2][2][4][2];
#pragma unroll
    for (int a = 0; a < 2; ++a)
#pragma unroll
        for (int b = 0; b < 2; ++b)
#pragma unroll
            for (int m = 0; m < 4; ++m)
#pragma unroll
                for (int n = 0; n < 2; ++n) acc[a][b][m][n] = (f32x4){0.f, 0.f, 0.f, 0.f};
    int sclW = 0x7A7A7A7A, sclA = 0x7F7F7F7F; (void)sclW; (void)sclA;
    bf16x8 At[4][2], B0[2][2], B1[2][2]; v8i_t At8[4], B08[2], B18[2];
    const char* cA = op.a_base(cur); const char* cB = op.b_base(cur);
    if (PG8_SP2) {
        PG8_STAGE(PG8_SB(0, 0), cB, voffB); PG8_STAGE(PG8_SB(0, 1), cB + hstepB, voffB); PG8_STAGE(PG8_SA(0, 0), cA, voffA0); PG8_STAGE_A1(PG8_SA(0, 1), cA, voffA1);
        if (wr == 1) PG8_BAR;
        PG8_WAIT_V(2); PG8_BAR;
        PG8_STAGE(PG8_SB(1, 0), cB + kstep, voffB); PG8_STAGE(PG8_SA(1, 0), cA + kstep, voffA0); PG8_STAGE(PG8_SB(1, 1), cB + hstepB + kstep, voffB);
        PG8_WAIT_V(6); PG8_BAR;
    } else {
    PG8_STAGE(PG8_SB(0, 0), cB, voffB); PG8_STAGE(PG8_SA(0, 0), cA, voffA0); PG8_STAGE(PG8_SB(0, 1), cB + hstepB, voffB); PG8_STAGE_A1(PG8_SA(0, 1), cA, voffA1);
    if (wr == 1) PG8_BAR;
    PG8_WAIT_V(4); PG8_BAR;
    PG8_STAGE(PG8_SB(1, 0), cB + kstep, voffB); PG8_STAGE(PG8_SA(1, 0), cA + kstep, voffA0); PG8_STAGE(PG8_SB(1, 1), cB + hstepB + kstep, voffB);
    PG8_WAIT_V(6); PG8_BAR;
    }
    for (;;) {
        const bool has_next = S.next(ui + 1, nxt);
        const char* nA = has_next ? op.a_base(nxt) : cA; const char* nB = has_next ? op.b_base(nxt) : cB;
        if constexpr (Op::GATHER) { if (has_next) {
#pragma unroll
            for (int i = 0; i < 2; ++i) { int R, C; stage_rc(tid * 16 + i * 8192, R, C); nvA0[i] = op.a_off_u(nxt, R, C); nvA1[i] = op.a_off_u(nxt, R + HALF, C); } } }
        for (int t = 0; t < nt; t += 2) {
            const bool last = (t == nt - 2);
            if constexpr (Op::GATHER) asm volatile("" : "+v"(voffA1[0]), "+v"(voffA1[1]));
            asm volatile("" : "+v"(voffA0[0]), "+v"(voffA0[1]), "+v"(voffB[0]), "+v"(voffB[1]));
            const char* a1 = cA + (size_t)(t + 1) * kstep;
            const char* a2 = last ? nA : cA + (size_t)(t + 2) * kstep; const char* b2 = last ? nB : cB + (size_t)(t + 2) * kstep;
            const char* a3 = a2 + kstep; const char* b3 = b2 + kstep;
            unsigned sA0[2], sA1[2];
#pragma unroll
            for (int i = 0; i < 2; ++i) { if constexpr (Op::GATHER) { sA0[i] = last ? nvA0[i] : voffA0[i]; sA1[i] = last ? nvA1[i] : voffA1[i]; } else { sA0[i] = voffA0[i]; sA1[i] = voffA1[i]; } }
            if (PG8_SP2) {
            const bool fresh = (t == 0) && (ui > 0);
            PG8_LDB(B0, 0, 0); PG8_LDB(B1, 0, 1); PG8_SCHED; PG8_LDA(At, 0, 0); if (!fresh) PG8_STAGE_A1(PG8_SA(1, 1), a1, voffA1);
            if (!fresh) PG8_WAIT_V(8); PG8_WAIT_L(0); PG8_BAR; PG8_MMAX(0, 0, At, B0); PG8_MMAX(0, 1, At, B1); PG8_BAR; PG8_SCHED;
            PG8_LDA(At, 0, 1); PG8_STAGE(PG8_SB(0, 0), b2, voffB); PG8_STAGE(PG8_SB(0, 1), b2 + hstepB, voffB); PG8_STAGE(PG8_SA(0, 0), a2, sA0);
            if (!fresh) PG8_WAIT_V(8); PG8_WAIT_L(0); PG8_BAR; PG8_MMAX(1, 0, At, B0); PG8_MMAX(1, 1, At, B1); PG8_BAR; PG8_SCHED;
            PG8_LDB(B0, 1, 0); PG8_LDB(B1, 1, 1); PG8_SCHED; PG8_LDA(At, 1, 0); PG8_STAGE_A1(PG8_SA(0, 1), a2, sA1);
            if (!fresh) PG8_WAIT_V(8); PG8_WAIT_L(0); PG8_BAR; PG8_MMAX(0, 0, At, B0); PG8_MMAX(0, 1, At, B1); PG8_BAR; PG8_SCHED;
            PG8_LDA(At, 1, 1); PG8_STAGE(PG8_SB(1, 0), b3, voffB); PG8_STAGE(PG8_SB(1, 1), b3 + hstepB, voffB); PG8_STAGE(PG8_SA(1, 0), a3, sA0);
            if (!fresh) PG8_WAIT_V(8); PG8_WAIT_L(0); PG8_BAR; PG8_MMAX(1, 0, At, B0); PG8_MMAX(1, 1, At, B1); PG8_BAR; PG8_SCHED;
            } else {
            PG8_LDB(B0, 0, 0); PG8_SCHED; PG8_LDA(At, 0, 0); PG8_STAGE_A1(PG8_SA(1, 1), a1, voffA1);
            PG8_WAIT_L(8); PG8_BAR; PG8_WAIT_L(0); PG8_MMAX(0, 0, At, B0); PG8_BAR; PG8_SCHED;
            PG8_LDB(B1, 0, 1); PG8_STAGE(PG8_SB(0, 0), b2, voffB);
            PG8_BAR; PG8_WAIT_L(0); PG8_MMAX(0, 1, At, B1); PG8_BAR;
            PG8_LDA(At, 0, 1); PG8_STAGE(PG8_SA(0, 0), a2, sA0);
            PG8_BAR; PG8_WAIT_L(0); PG8_MMAX(1, 0, At, B0); PG8_BAR; PG8_SCHED;
            PG8_STAGE(PG8_SB(0, 1), b2 + hstepB, voffB);
            PG8_WAIT_V(6); PG8_BAR; PG8_MMAX(1, 1, At, B1); PG8_BAR;
            PG8_LDB(B0, 1, 0); PG8_SCHED; PG8_LDA(At, 1, 0); PG8_STAGE_A1(PG8_SA(0, 1), a2, sA1);
            PG8_WAIT_L(8); PG8_BAR; PG8_WAIT_L(0); PG8_MMAX(0, 0, At, B0); PG8_BAR; PG8_SCHED;
            PG8_LDB(B1, 1, 1); PG8_STAGE(PG8_SB(1, 0), b3, voffB);
            PG8_BAR; PG8_WAIT_L(0); PG8_MMAX(0, 1, At, B1); PG8_BAR;
            PG8_LDA(At, 1, 1); PG8_STAGE(PG8_SA(1, 0), a3, sA0);
            PG8_BAR; PG8_WAIT_L(0); PG8_MMAX(1, 0, At, B0); PG8_BAR; PG8_SCHED;
            PG8_STAGE(PG8_SB(1, 1), b3 + hstepB, voffB);
            PG8_WAIT_V(6); PG8_BAR; PG8_MMAX(1, 1, At, B1); PG8_BAR;
            }
        }
        if constexpr (Op::FP8) asm volatile("s_nop 15\n\ts_nop 15" ::: "memory");
        if (PG8_ALIGN_EPI) { if (wr == 0) PG8_BAR; }
        if (PG8_SP2 && PG8_ALIGN_EPI && has_next) {
            if constexpr (Op::GATHER) { PG8_STAGE_A1(PG8_SA(1, 1), nA + kstep, nvA1); } else { PG8_STAGE_A1(PG8_SA(1, 1), nA + kstep, voffA1); } }
        {
          int lane_e = (int)__builtin_amdgcn_mbcnt_hi(~0u, __builtin_amdgcn_mbcnt_lo(~0u, 0u)); asm volatile("" : "+v"(lane_e));
          const int src_ = ((((lane_e & 3) << 4) | (lane_e >> 2)) << 2);
#pragma unroll
          for (int a = 0; a < 2; ++a)
#pragma unroll
              for (int b = 0; b < 2; ++b)
#pragma unroll
                  for (int m = 0; m < 4; ++m)
#pragma unroll
                      for (int n = 0; n < 2; ++n)
#pragma unroll
                          for (int j = 0; j < 4; ++j) acc[a][b][m][n][j] = __int_as_float(__builtin_amdgcn_ds_bpermute(src_, __float_as_int(acc[a][b][m][n][j])));
          if (PG8_SP2 && PG8_ALIGN_EPI) PG8_WAIT_V(0);
          op.epi(acc, cur, wr, wc, lane_e >> 2, lane_e & 3); }
        if (!has_next) break;
#pragma unroll
        for (int a = 0; a < 2; ++a)
#pragma unroll
            for (int b = 0; b < 2; ++b)
#pragma unroll
                for (int m = 0; m < 4; ++m)
#pragma unroll
                    for (int n = 0; n < 2; ++n) acc[a][b][m][n] = (f32x4){0.f, 0.f, 0.f, 0.f};
        cur = nxt; cA = nA; cB = nB; ++ui;
        if constexpr (Op::GATHER) {
#pragma unroll
            for (int i = 0; i < 2; ++i) { voffA0[i] = nvA0[i]; voffA1[i] = nvA1[i]; } }
        if (PG8_ALIGN_EPI) { if (wr == 1) PG8_BAR; }
    }
    PG8_WAIT_V(0);
    if (!PG8_ALIGN_EPI) { if (wr == 0) PG8_BAR; }
    PG8_BAR;
#undef PG8_SA
#undef PG8_SB
#undef PG8_STAGE
#undef PG8_LDA
#undef PG8_STAGE_A1
#undef PG8_LDB
#undef PG8_MMA
#undef PG8_MMA8
#undef PG8_MMAX
#undef PG8_WAIT_V
#undef PG8_WAIT_L
#undef PG8_BAR
#undef PG8_SCHED
}
}
using pg8::Unit;
typedef f32x4 Acc[2][2][4][2];

struct RopeCS { f32x4 c0, c1, s0, s1; };
__device__ __forceinline__ RopeCS rope_load(const float* cosT, const float* sinT, int row, int fq) { const int i0 = 8 * (fq & 1); RopeCS r;
    r.c0 = *(const f32x4*)(cosT + (size_t)row * 16 + i0); r.c1 = *(const f32x4*)(cosT + (size_t)row * 16 + i0 + 4); r.s0 = *(const f32x4*)(sinT + (size_t)row * 16 + i0); r.s1 = *(const f32x4*)(sinT + (size_t)row * 16 + i0 + 4); return r; }
__device__ __forceinline__ void rope_apply(f32x4& v0, f32x4& v1, const RopeCS& r, int fq) {
    f32x4 p0, p1;
#pragma unroll
    for (int j = 0; j < 4; ++j) { p0[j] = __shfl_xor(v0[j], 2); p1[j] = __shfl_xor(v1[j], 2); }
    if (fq < 2) { v0 = v0 * r.c0 - p0 * r.s0; v1 = v1 * r.c1 - p1 * r.s1; } else { v0 = v0 * r.c0 + p0 * r.s0; v1 = v1 * r.c1 + p1 * r.s1; }
}
__device__ __forceinline__ void rope8(f32x4& v0, f32x4& v1, const float* cosT, const float* sinT, int row, int fq) {
    f32x4 p0, p1;
#pragma unroll
    for (int j = 0; j < 4; ++j) { p0[j] = __shfl_xor(v0[j], 2); p1[j] = __shfl_xor(v1[j], 2); }
    const int i0 = 8 * (fq & 1);
    const f32x4 c0 = *(const f32x4*)(cosT + (size_t)row * 16 + i0), c1 = *(const f32x4*)(cosT + (size_t)row * 16 + i0 + 4);
    const f32x4 s0 = *(const f32x4*)(sinT + (size_t)row * 16 + i0), s1 = *(const f32x4*)(sinT + (size_t)row * 16 + i0 + 4);
    if (fq < 2) { v0 = v0 * c0 - p0 * s0; v1 = v1 * c1 - p1 * s1; }
    else        { v0 = v0 * c0 + p0 * s0; v1 = v1 * c1 + p1 * s1; }
}
__device__ __forceinline__ float ssq8(const f32x4 v0, const f32x4 v1) { return (v0[0] * v0[0] + v0[1] * v0[1]) + (v0[2] * v0[2] + v0[3] * v0[3]) + (v1[0] * v1[0] + v1[1] * v1[1]) + (v1[2] * v1[2] + v1[3] * v1[3]); }
typedef unsigned long long u64;
constexpr float FX_SCALE = 16777216.0f, FX_INV = 1.0f / 16777216.0f;
__device__ __forceinline__ void row_atomic_add(u64* p, float s, int fq) { s += __shfl_xor(s, 1); s += __shfl_xor(s, 2); if (fq == 0) __hip_atomic_fetch_add(p, (u64)(s * FX_SCALE + 0.5f), RLX_AGENT); }
__device__ __forceinline__ float fx_load(const u64* p) { return (float)(*p) * FX_INV; }

#ifndef EPI_FENCE
#define EPI_FENCE
#endif
#define RT_(ai, m) ((ai) * 128 + wr * 64 + (m) * 16 + fr)
#define FOR_AI _Pragma("unroll") for (int ai = 0; ai < 2; ++ai)
#define FOR_M _Pragma("unroll") for (int m = 0; m < 4; ++m)
#define FOR_BJ _Pragma("unroll") for (int bj = 0; bj < 2; ++bj)
__device__ __forceinline__ void unpack8(const u32x4 w, f32x4& v0, f32x4& v1) { v0 = (f32x4){bf_lo(w.x), bf_hi(w.x), bf_lo(w.y), bf_hi(w.y)}; v1 = (f32x4){bf_lo(w.z), bf_hi(w.z), bf_lo(w.w), bf_hi(w.w)}; }
#define EPI_ROWS(...) _Pragma("unroll") for (int ai = 0; ai < 2; ++ai) _Pragma("unroll") for (int m = 0; m < 4; ++m) { const int rt = ai * 128 + wr * 64 + m * 16 + fr; __VA_ARGS__ EPI_FENCE }

template <bool F8> struct OpInT {
    static constexpr bool PERM = true, GATHER = false, FP8 = F8;
    const bf16_t* A; const bf16_t* Bt; int K, lda, ldb;
    bf16_t *QLb, *KVLb, *KRb, *U, *GA, *GB; u64 *ssq_q, *ssq_kv; const float *cosT, *sinT;
    __device__ __forceinline__ unsigned a_off(int r, int c) const { return (unsigned)(r * lda + c) * 2u; }
    __device__ __forceinline__ const char* a_base(const Unit& u) const { return (const char*)(A + (size_t)u.pm * 256 * lda); }
    __device__ __forceinline__ const char* b_base(const Unit& u) const { return (const char*)(Bt + (size_t)u.pn * 256 * ldb); }
    __device__ __forceinline__ void epi(const Acc& acc, const Unit& u, int wr, int wc, int fr, int fq) const {
        const int row0 = u.pm * 256, col = 32 * wc + 8 * fq;
#pragma unroll
        for (int bj = 0; bj < 2; ++bj) {
            const int hc = u.pn * 2 + bj;
            if (hc < 5) {
                u64* ssq = hc < 3 ? ssq_q : ssq_kv;
                if constexpr (F8) {
                    unsigned char* dst = hc < 3 ? (unsigned char*)QLb + hc * 128 : (unsigned char*)KVLb + (hc - 3) * 128; const int pitch = hc < 3 ? 512 : 256;
                    EPI_ROWS( const int row = row0 + rt; const f32x4 v0 = acc[ai][bj][m][0], v1 = acc[ai][bj][m][1];
                        row_atomic_add(ssq + row, ssq8(v0, v1), fq); store8_fp8(dst + (size_t)row * pitch + col, v0, v1);
                        if (hc == 2) *(u32x2*)(dst + (size_t)row * pitch + col + 128) = (u32x2){0u, 0u}; )
                } else {
                bf16_t* dst = hc < 3 ? QLb + hc * 128 : KVLb + (hc - 3) * 128; const int pitch = hc < 3 ? QLORA : KVLORA;
                EPI_ROWS( const int row = row0 + rt; const f32x4 v0 = acc[ai][bj][m][0], v1 = acc[ai][bj][m][1];
                    row_atomic_add(ssq + row, ssq8(v0, v1), fq); store8(dst + (size_t)row * pitch + col, v0, v1); )
                }
            } else if (hc == 5) {
                if (wc == 0) { FOR_AI { RopeCS cs[4]; FOR_M cs[m] = rope_load(cosT, sinT, row0 + RT_(ai, m), fq);
                    FOR_M { const int row = row0 + RT_(ai, m); f32x4 v0 = acc[ai][bj][m][0], v1 = acc[ai][bj][m][1]; rope_apply(v0, v1, cs[m], fq);
                        if constexpr (F8) store8_fp8((unsigned char*)KRb + (size_t)row * ROPE + col, v0, v1);
                        else store8(KRb + (size_t)row * ROPE + col, v0, v1); } } }
            } else if (hc < 10) {
                bf16_t* dst = U + (hc - 6) * 128;
                EPI_ROWS( const int row = row0 + rt; store8(dst + (size_t)row * POOLW + col, acc[ai][bj][m][0], acc[ai][bj][m][1]); )
            } else {
                bf16_t* dst = hc < 18 ? GA + (hc - 10) * 128 : GB + (hc - 18) * 128;
                EPI_ROWS( const int row = row0 + rt; f32x4 v0 = acc[ai][bj][m][0], v1 = acc[ai][bj][m][1];
                    _Pragma("unroll") for (int j = 0; j < 4; ++j) { v0[j] = sigmoidf_(v0[j]); v1[j] = sigmoidf_(v1[j]); }
                    store8(dst + (size_t)row * DM + col, v0, v1); )
            }
        }
    }
};
typedef OpInT<false> OpIn; typedef OpInT<true> OpIn8;
struct OpGate8 {
    static constexpr bool PERM = true, GATHER = false, FP8 = true;
    const bf16_t* A; const bf16_t* Bt; int K, lda, ldb;
    bf16_t *GA, *GB;
    __device__ __forceinline__ unsigned a_off(int r, int c) const { return (unsigned)(r * lda + c) * 2u; }
    __device__ __forceinline__ const char* a_base(const Unit& u) const { return (const char*)(A + (size_t)u.pm * 256 * lda); }
    __device__ __forceinline__ const char* b_base(const Unit& u) const { return (const char*)(Bt + (size_t)u.pn * 256 * ldb); }
    __device__ __forceinline__ void epi(const Acc& acc, const Unit& u, int wr, int wc, int fr, int fq) const {
        const size_t off = (size_t)u.pm * 256 * DM + ((u.pn - 5) & 3) * 256 + 32 * wc + 8 * fq;
        FOR_AI FOR_M FOR_BJ { f32x4 v0 = acc[ai][bj][m][0], v1 = acc[ai][bj][m][1];
            _Pragma("unroll") for (int j = 0; j < 4; ++j) { v0[j] = sigmoidf_(v0[j]); v1[j] = sigmoidf_(v1[j]); }
            if (u.pn < 9) store8_fp8((unsigned char*)GA + off + (size_t)RT_(ai, m) * DM + bj * 128, v0 * 256.f, v1 * 256.f);
            else store8(GB + off + (size_t)RT_(ai, m) * DM + bj * 128, v0, v1); }
    }
};
struct OffsetOrder { pg8::StaticOrder s; int off; __device__ __forceinline__ bool next(int i, Unit& u) const { if (!s.next(i, u)) return false; u.pn += off; return true; } };
struct OpPlain {
    static constexpr bool PERM = true, GATHER = false, FP8 = false;
    const bf16_t* A; const bf16_t* Bt; int K, lda, ldb;
    bf16_t* O; int ldo;
    __device__ __forceinline__ unsigned a_off(int r, int c) const { return (unsigned)(r * lda + c) * 2u; }
    __device__ __forceinline__ const char* a_base(const Unit& u) const { return (const char*)(A + (size_t)u.pm * 256 * lda); }
    __device__ __forceinline__ const char* b_base(const Unit& u) const { return (const char*)(Bt + (size_t)u.pn * 256 * ldb); }
    __device__ __forceinline__ void epi(const Acc& acc, const Unit& u, int wr, int wc, int fr, int fq) const {
        bf16_t* base = O + (size_t)u.pm * 256 * ldo + u.pn * 256 + 32 * wc + 8 * fq;
        EPI_ROWS( _Pragma("unroll") for (int bj = 0; bj < 2; ++bj) store8(base + (size_t)rt * ldo + bj * 128, acc[ai][bj][m][0], acc[ai][bj][m][1]); )
    }
};
__device__ __forceinline__ int key_of_slot(int sl) { const int hi = sl >> 5, j = sl & 31, jj = j & 15; return ((j >> 4) << 5) + (jj & 3) + 8 * (jj >> 2) + 4 * hi; }
struct OpQ {
    static constexpr bool PERM = true, GATHER = false, FP8 = true;
    const bf16_t* A; const bf16_t* Bt; int K, lda, ldb;
    unsigned char* Q  ; const u64* ssq_q; const float *cosT, *sinT;
    __device__ __forceinline__ unsigned a_off(int r, int c) const { return (unsigned)(r * lda + c) * 2u; }
    __device__ __forceinline__ const char* a_base(const Unit& u) const { return (const char*)(A + (size_t)u.pm * 256 * lda); }
    __device__ __forceinline__ const char* b_base(const Unit& u) const { return (const char*)(Bt + (size_t)u.pn * 256 * ldb); }
    __device__ __forceinline__ void epi(const Acc& acc, const Unit& u, int wr, int wc, int fr, int fq) const {
        float rs[2][4]; FOR_AI FOR_M rs[ai][m] = fx_load(ssq_q + u.pm * 256 + RT_(ai, m));
        FOR_AI FOR_M rs[ai][m] = 16.f * C2Q * __builtin_amdgcn_rsqf(rs[ai][m] * (1.0f / QLORA) + EPS);
        const int g0 = u.pn * 8 + wc; const bool rp0 = (g0 % 3 == 2), rp1 = ((g0 + 4) % 3 == 2);
        FOR_AI _Pragma("unroll") for (int m0 = 0; m0 < 4; m0 += 2) { RopeCS cs[2]; if (rp0 || rp1) { _Pragma("unroll") for (int mi = 0; mi < 2; ++mi) cs[mi] = rope_load(cosT, sinT, u.pm * 256 + RT_(ai, m0 + mi), fq); }
            _Pragma("unroll") for (int mi = 0; mi < 2; ++mi) { const int m = m0 + mi; const int row = u.pm * 256 + RT_(ai, m);
                FOR_BJ { const int g32 = g0 + bj * 4; f32x4 v0 = acc[ai][bj][m][0] * rs[ai][m], v1 = acc[ai][bj][m][1] * rs[ai][m];
                    if (bj == 0 ? rp0 : rp1) rope_apply(v0, v1, cs[mi], fq);
                    unsigned char* qd = Q + (size_t)row * 1024 + (g32 / 3) * 128 + (g32 % 3) * 32 + 8 * fq; store8_fp8(qd, v0, v1); if (bj == 0 ? rp0 : rp1) *(u32x2*)(qd + 32) = (u32x2){0u, 0u}; } } }
    }
};
struct OpK8 {
    static constexpr bool PERM = true, GATHER = false, FP8 = true;
    const bf16_t* A; const bf16_t* Bt; int K, lda, ldb;
    unsigned char* K8; const u64* ssq_kv;
    __device__ __forceinline__ unsigned a_off(int r, int c) const { return (unsigned)(r * lda + c) * 2u; }
    __device__ __forceinline__ const char* a_base(const Unit& u) const { return (const char*)(A + (size_t)u.pm * 256 * lda); }
    __device__ __forceinline__ const char* b_base(const Unit& u) const { return (const char*)(Bt + (size_t)u.pn * 256 * ldb); }
    __device__ __forceinline__ void epi(const Acc& acc, const Unit& u, int wr, int wc, int fr, int fq) const {
        float rs[2][4]; FOR_AI FOR_M rs[ai][m] = fx_load(ssq_kv + u.pm * 256 + RT_(ai, m));
        FOR_AI FOR_M { const int row = u.pm * 256 + RT_(ai, m); const float r_ = __builtin_amdgcn_rsqf(rs[ai][m] * (1.0f / KVLORA) + EPS);
            FOR_BJ { const int col = u.pn * 256 + bj * 128 + 32 * wc + 8 * fq; store8_fp8(K8 + (size_t)row * 512 + col, acc[ai][bj][m][0] * r_, acc[ai][bj][m][1] * r_); } }
    }
};
struct OpVT {
    static constexpr bool PERM = true, GATHER = false, FP8 = true;
    const bf16_t* A; const bf16_t* Bt; int K, lda, ldb;
    unsigned char* VT8; const u64* ssq_kv;
    __device__ __forceinline__ int brow(int c) const { return (c & ~63) + key_of_slot(c & 63); }
    __device__ __forceinline__ unsigned a_off(int r, int c) const { return (unsigned)(r * lda + c) * 2u; }
    __device__ __forceinline__ const char* a_base(const Unit& u) const { return (const char*)(A + (size_t)u.pm * 256 * lda); }
    __device__ __forceinline__ const char* b_base(const Unit& u) const { return (const char*)(Bt + (size_t)u.pn * 256 * ldb); }
    __device__ __forceinline__ void epi(const Acc& acc, const Unit& u, int wr, int wc, int fr, int fq) const {
        float rs[2][2][4];
        FOR_BJ _Pragma("unroll") for (int n = 0; n < 2; ++n) _Pragma("unroll") for (int j = 0; j < 4; ++j) { const int c = bj * 128 + 32 * wc + 8 * fq + 4 * n + j; rs[bj][n][j] = fx_load(ssq_kv + u.pn * 256 + (c & ~63) + key_of_slot(c & 63)); }
        FOR_BJ _Pragma("unroll") for (int n = 0; n < 2; ++n) _Pragma("unroll") for (int j = 0; j < 4; ++j) rs[bj][n][j] = __builtin_amdgcn_rsqf(rs[bj][n][j] * (1.0f / KVLORA) + EPS);
        FOR_AI FOR_M FOR_BJ { f32x4 v0 = acc[ai][bj][m][0], v1 = acc[ai][bj][m][1];
            _Pragma("unroll") for (int j = 0; j < 4; ++j) { v0[j] *= rs[bj][0][j]; v1[j] *= rs[bj][1][j]; }
            const size_t grp = (size_t)u.pn * 4 + 2 * bj + (wc >> 1);
            store8_fp8(VT8 + (grp * 512 + u.pm * 256 + RT_(ai, m)) * 64 + (wc & 1) * 32 + 8 * fq, v0, v1); }
    }
};
struct OpYB {
    static constexpr bool PERM = true, GATHER = false, FP8 = false;
    const bf16_t* A; const bf16_t* Bt; int K, lda, ldb;
    bf16_t* GBM;
    __device__ __forceinline__ unsigned a_off(int r, int c) const { return (unsigned)(r * lda + c) * 2u; }
    __device__ __forceinline__ const char* a_base(const Unit& u) const { return (const char*)(A + (size_t)u.pm * 256 * lda); }
    __device__ __forceinline__ const char* b_base(const Unit& u) const { return (const char*)(Bt + (size_t)u.pn * 256 * ldb); }
    __device__ __forceinline__ void epi(const Acc& acc, const Unit& u, int wr, int wc, int fr, int fq) const {
        bf16_t* base = GBM + (size_t)u.pm * 256 * DM + u.pn * 256 + 32 * wc + 8 * fq;
        u32x4 gb[2][4][2]; FOR_AI FOR_M FOR_BJ gb[ai][m][bj] = *(const u32x4*)(base + (size_t)RT_(ai, m) * DM + bj * 128);
        FOR_AI FOR_M FOR_BJ { f32x4 g0, g1; unpack8(gb[ai][m][bj], g0, g1); store8(base + (size_t)RT_(ai, m) * DM + bj * 128, g0 * acc[ai][bj][m][0], g1 * acc[ai][bj][m][1]); }
    }
};
struct OpYA {
    static constexpr bool PERM = true, GATHER = false, FP8 = true;
    const bf16_t* A; const bf16_t* Bt; int K, lda, ldb;
    const bf16_t* GA; bf16_t* MB;
    __device__ __forceinline__ unsigned a_off(int r, int c) const { return (unsigned)(r * lda + c) * 2u; }
    __device__ __forceinline__ const char* a_base(const Unit& u) const { return (const char*)(A + (size_t)u.pm * 256 * lda); }
    __device__ __forceinline__ const char* b_base(const Unit& u) const { return (const char*)(Bt + (size_t)u.pn * 256 * ldb); }
    __device__ __forceinline__ void epi(const Acc& acc, const Unit& u, int wr, int wc, int fr, int fq) const {
        const size_t off0 = (size_t)u.pm * 256 * DM + u.pn * 256 + 32 * wc + 8 * fq;
        FOR_AI { u32x2 ga[4][2]; u32x4 mb[4][2]; FOR_M FOR_BJ { const size_t off = off0 + (size_t)RT_(ai, m) * DM + bj * 128; ga[m][bj] = *(const u32x2*)((const unsigned char*)GA + off); mb[m][bj] = *(const u32x4*)(MB + off); }
            FOR_M FOR_BJ { const size_t off = off0 + (size_t)RT_(ai, m) * DM + bj * 128; f32x4 g0, g1, b0, b1; unpack8_fp8(ga[m][bj], g0, g1); unpack8(mb[m][bj], b0, b1);
                store8(MB + off, g0 * (acc[ai][bj][m][0] * (0.0625f / 256.f)) + b0, g1 * (acc[ai][bj][m][1] * (0.0625f / 256.f)) + b1); } }
    }
};
template <bool BASE_F32, bool F8 = false> struct OpRes {
    static constexpr bool PERM = true, GATHER = false, FP8 = F8;
    const bf16_t* A; const bf16_t* Bt; int K, lda, ldb;
    const void* base; bf16_t* Hout; u64* ssq; size_t bbatch;
    unsigned char* H8; float ascale;
    __device__ __forceinline__ unsigned a_off(int r, int c) const { return (unsigned)(r * lda + c) * 2u; }
    __device__ __forceinline__ const char* a_base(const Unit& u) const { return (const char*)(A + (size_t)u.pm * 256 * lda); }
    __device__ __forceinline__ const char* b_base(const Unit& u) const { return (const char*)(Bt + (size_t)(u.pm >> 4) * bbatch + (size_t)u.pn * 256 * ldb); }
    __device__ __forceinline__ void epi(const Acc& acc, const Unit& u, int wr, int wc, int fr, int fq) const {
        const size_t off0 = (size_t)u.pm * 256 * DM + u.pn * 256 + 32 * wc + 8 * fq;
        constexpr int MB_ = BASE_F32 ? 2 : 4;
        FOR_AI _Pragma("unroll") for (int m0 = 0; m0 < 4; m0 += MB_) { f32x4 bv[MB_][2][2];
            _Pragma("unroll") for (int mi = 0; mi < MB_; ++mi) FOR_BJ { const size_t off = off0 + (size_t)RT_(ai, m0 + mi) * DM + bj * 128;
                if (BASE_F32) { bv[mi][bj][0] = *(const f32x4*)((const float*)base + off); bv[mi][bj][1] = *(const f32x4*)((const float*)base + off + 4); } else load8((const bf16_t*)base + off, bv[mi][bj][0], bv[mi][bj][1]); }
            _Pragma("unroll") for (int mi = 0; mi < MB_; ++mi) { const int m = m0 + mi; float s = 0.f;
                FOR_BJ { const size_t off = off0 + (size_t)RT_(ai, m) * DM + bj * 128; const f32x4 h0 = bv[mi][bj][0] + acc[ai][bj][m][0] * ascale, h1 = bv[mi][bj][1] + acc[ai][bj][m][1] * ascale; s += ssq8(h0, h1); store8(Hout + off, h0, h1); if (H8) store8_fp8(H8 + off, h0, h1); }
                row_atomic_add(ssq + u.pm * 256 + RT_(ai, m), s, fq); }
            asm volatile("" ::: "memory"); }
    }
};
struct OpPre {
    static constexpr bool PERM = true, GATHER = false, FP8 = false;
    const bf16_t* KVM; const bf16_t* W; int K, lda, ldb; unsigned char* O; int mode;
    __device__ __forceinline__ unsigned a_off(int r, int c) const { return (unsigned)(r * lda + c) * 2u; }
    __device__ __forceinline__ const char* a_base(const Unit& u) const { return mode == 0 ? (const char*)(KVM + (size_t)(u.pm >> 2) * 256 * 2048 + (u.pm & 3) * 256) : (const char*)(W + (size_t)(u.pm & 3) * 256 * DM + u.pn * 256); }
    __device__ __forceinline__ const char* b_base(const Unit& u) const { return mode == 0 ? (const char*)(W + (size_t)u.pn * 256 * DM + (u.pm & 3) * 256) : (const char*)(KVM + (size_t)(u.pm >> 2) * 256 * 2048 + DM + u.pn * 256); }
    __device__ __forceinline__ void epi(const Acc& acc, const Unit& u, int wr, int wc, int fr, int fq) const {
        unsigned char* base = O + (size_t)u.pm * 256 * DM + u.pn * 256 + 32 * wc + 8 * fq;
        FOR_AI FOR_M FOR_BJ store8_fp8(base + (size_t)RT_(ai, m) * DM + bj * 128, acc[ai][bj][m][0] * 32.f, acc[ai][bj][m][1] * 32.f);
    }
};
struct OpSX {
    static constexpr bool PERM = true, GATHER = false, FP8 = true;
    const bf16_t* A; const bf16_t* BQK; int K, lda, ldb;
    unsigned char* P; const u64* ssq1; LAS f32x4* ps;
    __device__ __forceinline__ unsigned a_off(int r, int c) const { return (unsigned)(r * lda + c) * 2u; }
    __device__ __forceinline__ const char* a_base(const Unit& u) const { return (const char*)(A + (size_t)u.pm * 256 * lda); }
    __device__ __forceinline__ const char* b_base(const Unit& u) const { return (const char*)(BQK + ((size_t)(u.pm >> 4) * DM + u.pn * 256) * ldb); }
    __device__ __forceinline__ void epi(Acc& acc, const Unit& u, int wr, int wc, int fr, int fq) const {
        float rs[2][4]; FOR_AI FOR_M rs[ai][m] = fx_load(ssq1 + u.pm * 256 + RT_(ai, m));
        FOR_AI FOR_M { const float r_ = C2X * __builtin_amdgcn_rsqf(rs[ai][m] * (1.0f / DM) + EPS); float s = 0.f;
            FOR_BJ { _Pragma("unroll") for (int n = 0; n < 2; ++n) _Pragma("unroll") for (int j = 0; j < 4; ++j) { const float e = fast_exp2(acc[ai][bj][m][n][j] * r_); acc[ai][bj][m][n][j] = e; s += e; } }
            s += __shfl_xor(s, 1); s += __shfl_xor(s, 2);
            if (fq == 0) ((LAS float*)(ps + RT_(ai, m)))[wc] = s; }
        asm volatile("s_waitcnt lgkmcnt(0)\n\ts_barrier" ::: "memory");
        unsigned char* base = P + (size_t)u.pm * 256 * DM + u.pn * 256 + 32 * wc + 8 * fq;
        FOR_AI FOR_M { const f32x4 q = ps[RT_(ai, m)]; const float inv = 256.f * __builtin_amdgcn_rcpf((q[0] + q[1]) + (q[2] + q[3]));
            FOR_BJ store8_fp8(base + (size_t)RT_(ai, m) * DM + bj * 128, acc[ai][bj][m][0] * inv, acc[ai][bj][m][1] * inv); }
    }
};
struct OpR {
    static constexpr bool PERM = false, GATHER = false, FP8 = false;
    const bf16_t* A; const bf16_t* Bt; int K, lda, ldb;
    float* LG; const u64* ssq2;
    __device__ __forceinline__ unsigned a_off(int r, int c) const { return (unsigned)(r * lda + c) * 2u; }
    __device__ __forceinline__ const char* a_base(const Unit& u) const { return (const char*)(A + (size_t)u.pm * 256 * lda); }
    __device__ __forceinline__ const char* b_base(const Unit& u) const { return (const char*)(Bt + (size_t)u.pn * 256 * ldb); }
    __device__ __forceinline__ void epi(const Acc& acc, const Unit& u, int wr, int wc, int fr, int fq) const {
        if (wc > 1) return;
        float rs[2][4]; FOR_AI FOR_M rs[ai][m] = fx_load(ssq2 + u.pm * 256 + RT_(ai, m));
        FOR_AI FOR_M { const int row = u.pm * 256 + RT_(ai, m); const float r_ = __builtin_amdgcn_rsqf(rs[ai][m] * (1.0f / DM) + EPS); float* lg = LG + (size_t)row * 40;
            if (wc == 0) { *(f32x4*)(lg + 4 * fq) = acc[ai][0][m][0] * r_; *(f32x4*)(lg + 16 + 4 * fq) = acc[ai][0][m][1] * r_; }
            else if (fq == 0) { *(f32x4*)(lg + 32) = acc[ai][0][m][0] * r_; } }
    }
};
struct MoeTab { const LAS int* tileE; const LAS int* tbase; const LAS int* cntL; };
template <int NPN> struct MoeOrder {
    int nunits, G, c;
    __device__ __forceinline__ bool next(int i, Unit& u) const { const int L = i * G + c; if (L >= nunits) return false; u.pm = L / NPN; u.pn = L - u.pm * NPN; return true; }
};
struct OpGU {
    static constexpr bool PERM = true, GATHER = true, FP8 = true;
    const bf16_t* A; const bf16_t* WGUp; int K, lda, ldb;
    unsigned char* HID  ; const int* LIST; const float* WL; const float* RSL; MoeTab tb;
    __device__ __forceinline__ unsigned a_off_u(const Unit& u, int r, int c) const { const int e = tb.tileE[u.pm]; const int p = (u.pm - tb.tbase[e]) * 256 + r;
        const int tok = p < tb.cntL[e] ? (LIST[(size_t)e * NTOK + p] >> 1) : 0; return (unsigned)(tok * lda + c) * 2u; }
    __device__ __forceinline__ const char* a_base(const Unit&) const { return (const char*)A; }
    __device__ __forceinline__ const char* b_base(const Unit& u) const { return (const char*)(WGUp + ((size_t)tb.tileE[u.pm] * 512 + u.pn * 256) * ldb); }
    __device__ __forceinline__ void epi(const Acc& acc, const Unit& u, int wr, int wc, int fr, int fq) const {
        const int e = tb.tileE[u.pm], row0 = (u.pm - tb.tbase[e]) * 256, ce = tb.cntL[e]; const size_t lb = (size_t)e * NTOK + row0;
        float cw[2][4], rs[2][4];
        FOR_AI FOR_M { const int r = RT_(ai, m); const bool v = row0 + r < ce; cw[ai][m] = v ? WL[lb + r] : 0.f; rs[ai][m] = v ? RSL[lb + r] : 0.f; }
        unsigned char* base = HID + (size_t)u.pm * 256 * EFF + u.pn * 128 + 32 * wc + 8 * fq;
        FOR_AI FOR_M { const float r_ = rs[ai][m], c_ = cw[ai][m]; f32x4 h0, h1;
#pragma unroll
            for (int j = 0; j < 4; ++j) { const float g0 = acc[ai][0][m][0][j] * r_, u0 = acc[ai][1][m][0][j] * r_, g1 = acc[ai][0][m][1][j] * r_, u1 = acc[ai][1][m][1][j] * r_;
                h0[j] = g0 * sigmoidf_(g0) * u0 * c_ * 16.f; h1[j] = g1 * sigmoidf_(g1) * u1 * c_ * 16.f; }
            store8_fp8(base + (size_t)RT_(ai, m) * EFF, h0, h1); }
    }
};
struct OpDN {
    static constexpr bool PERM = true, GATHER = false, FP8 = true;
    const bf16_t* HID; const bf16_t* WDp; int K, lda, ldb;
    unsigned char* Y  ; const int* LIST; MoeTab tb;
    __device__ __forceinline__ unsigned a_off(int r, int c) const { return (unsigned)(r * lda + c) * 2u; }
    __device__ __forceinline__ const char* a_base(const Unit& u) const { return (const char*)(HID + (size_t)u.pm * 256 * lda); }
    __device__ __forceinline__ const char* b_base(const Unit& u) const { return (const char*)(WDp + ((size_t)tb.tileE[u.pm] * DM + u.pn * 256) * ldb); }
    __device__ __forceinline__ void epi(const Acc& acc, const Unit& u, int wr, int wc, int fr, int fq) const {
        const int e = tb.tileE[u.pm], row0 = (u.pm - tb.tbase[e]) * 256, ce = tb.cntL[e]; const size_t lb = (size_t)e * NTOK + row0;
        int ent[2][4];
        FOR_AI FOR_M { const int r = RT_(ai, m); ent[ai][m] = row0 + r < ce ? LIST[lb + r] : -1; }
        FOR_AI FOR_M { const int en = ent[ai][m];
            if (en >= 0) { unsigned char* p = Y + ((size_t)(en & 1) * NTOK + (size_t)(en >> 1)) * DM + u.pn * 256 + 32 * wc + 8 * fq;
                FOR_BJ store8_fp8(p + bj * 128, acc[ai][bj][m][0], acc[ai][bj][m][1]); } }
    }
};
__device__ __forceinline__ int moe_build_tables(const unsigned* cnt, LAS int* cntL, LAS int* tbase, LAS int* tileE, int tid) {
    if (tid < NEXP) cntL[tid] = (int)__hip_atomic_load(cnt + tid, RLX_AGENT);
    __syncthreads();
    if (tid == 0) { int acc_ = 0; for (int e = 0; e < NEXP; ++e) { tbase[e] = acc_; acc_ += (cntL[e] + 255) >> 8; } tbase[NEXP] = acc_; }
    __syncthreads();
    const int nt = tbase[NEXP];
    for (int t = tid; t < nt; t += 512) { int e = 0; for (int k = 1; k < NEXP; ++k) e += (tbase[k] <= t) ? 1 : 0; tileE[t] = e; }
    __syncthreads();
    return __builtin_amdgcn_readfirstlane(nt);
}

namespace mla {
constexpr int KSLOT = 4096, RSLOT = 2048, VSLOT = 4096, NSLOT = 8;
constexpr int L_K = 0, L_R = NSLOT * KSLOT, L_V = L_R + NSLOT * RSLOT, L_WS = L_V + NSLOT * VSLOT, L_OST = L_WS + 8 * 256, L_DUM = L_OST + 8 * 4096, L_END = L_DUM + 8 * 1024;
static_assert(L_END <= RING_BYTES, "attention LDS");
constexpr float THR = 6.0f;
__device__ __forceinline__ int crow(int r, int hi) { return (r & 3) + 8 * (r >> 2) + 4 * hi; }
__device__ __forceinline__ void glds16(const void* gsrc, unsigned lds_dst) { unsigned keep;
    asm volatile("s_mov_b32 %0, m0\n\ts_mov_b32 m0, %2\n\ts_nop 0\n\tglobal_load_lds_dwordx4 %1, off\n\ts_mov_b32 m0, %0" : "=&s"(keep) : "v"(gsrc), "s"(lds_dst) : "memory"); }
#define MX3(a, b, c) __builtin_fmaxf(__builtin_fmaxf((a), (b)), (c))
__device__ __forceinline__ float rowmax(const f32x16& p0, const f32x16& p1) {
    float a = MX3(p0[0], p0[1], p1[0]), b = MX3(p0[2], p0[3], p1[1]); a = MX3(a, p1[2], p1[3]);
#pragma unroll
    for (int r = 4; r < 16; r += 4) { a = MX3(a, p0[r], p0[r + 1]); b = MX3(b, p0[r + 2], p0[r + 3]); a = MX3(a, p1[r], p1[r + 1]); b = MX3(b, p1[r + 2], p1[r + 3]); }
    a = __builtin_fmaxf(a, b);
    auto rr = __builtin_amdgcn_permlane32_swap(__float_as_uint(a), __float_as_uint(a), false, false);
    return __builtin_fmaxf(__uint_as_float(rr[0]), __uint_as_float(rr[1]));
}
#define MLA_SC1 0x7F7F7F7F
#define MLA_SCQ 0x7B7B7B7B
template <bool GA> __device__ __forceinline__ void attn_unit(int b, int h, int qb, const unsigned char* Q8, const unsigned char* K8, const unsigned char* KR8, const unsigned char* VT8, bf16_t* O, LAS unsigned char* shm, const int wv_) {
    int tid = wv_ * 64 + lane_mb(); asm volatile("" : "+v"(tid));
    const int lane = tid & 63, r32 = lane & 31, hi = lane >> 5; const int wid = __builtin_amdgcn_readfirstlane(tid >> 6);
    const long rowbase = (long)b * SEQ; const int q0 = qb * 256;
    const unsigned lds0 = (unsigned)(uintptr_t)shm;
    LAS float* wsf = (LAS float*)(shm + L_WS) + wid * 64;
    const int sw1 = (lane & 3) ^ ((lane >> 4) & 3);
    const unsigned char* src1 = wid < 4 ? K8 + (rowbase + wid * 16 + (lane >> 2)) * 512 + h * 64 + sw1 * 16
                                        : VT8 + ((size_t)(rowbase >> 6) * 512 + h * 64 + (wid - 4) * 16 + (lane >> 2)) * 64 + sw1 * 16;
    const long step1 = wid < 4 ? 64 * 512 : 512 * 64;
    const unsigned dst1 = wid < 4 ? lds0 + L_K + wid * 1024 : lds0 + L_V + (wid - 4) * 1024; const unsigned slot1 = wid < 4 ? KSLOT : VSLOT;
    const unsigned char* src2 = wid < 2 ? KR8 + (rowbase + wid * 32 + (lane >> 1)) * ROPE + ((lane & 1) ^ ((lane >> 4) & 1)) * 16 : src1;
    const long step2 = wid < 2 ? 64 * ROPE : step1;
    const unsigned dst2 = wid < 2 ? lds0 + L_R + wid * 1024 : lds0 + L_DUM + wid * 1024; const unsigned slot2 = wid < 2 ? RSLOT : 0;
#define MLA_DMA(t, s) do { glds16(src1 + (long)(t) * step1, (unsigned)__builtin_amdgcn_readfirstlane(dst1 + (s) * slot1)); \
        glds16(src2 + (long)(t) * step2, (unsigned)__builtin_amdgcn_readfirstlane(dst2 + (s) * slot2)); } while (0)
    const int NT = 4 * qb + 4, nvis = 4 * qb + (wid >> 1) + 1;
    v8i_t qf[2];
    { const unsigned char* qp = Q8 + (rowbase + q0 + wid * 32 + r32) * 1024 + h * 128 + hi * 32;
#pragma unroll
      for (int st = 0; st < 2; ++st) qf[st] = __builtin_shufflevector(*(const v4i_t*)(qp + st * 64), *(const v4i_t*)(qp + st * 64 + 16), 0, 1, 2, 3, 4, 5, 6, 7); }
    asm volatile("" ::: "memory");
    MLA_DMA(0, 0); MLA_DMA(1, 1); MLA_DMA(2, 2); MLA_DMA(3, 3);
    float mrun = 0.f; f32x16 o[2], lacc;
#pragma unroll
    for (int r = 0; r < 16; ++r) { float z0, z1, z2; asm volatile("v_mov_b32 %0, 0\n\tv_mov_b32 %1, 0\n\tv_mov_b32 %2, 0" : "=v"(z0), "=v"(z1), "=v"(z2)); o[0][r] = z0; o[1][r] = z1; lacc[r] = z2; }
    f32x16 negm;
#pragma unroll
    for (int r = 0; r < 16; ++r) { float z_; asm volatile("v_mov_b32 %0, 0" : "=v"(z_)); negm[r] = z_; }
    v8i_t kn0, kn1, kr0, kr1, p8;
    const int swr = (r32 >> 2) & 3, k64a = ((2 * hi) ^ swr) * 16, k64b = ((2 * hi + 1) ^ swr) * 16, k32a = ((r32 >> 3) & 1) * 16;
#define MLA_KLD(sl_) do { const LAS unsigned char* kp = shm + L_K + (sl_) * KSLOT + r32 * 64; const LAS unsigned char* rp = shm + L_R + (sl_) * RSLOT + r32 * 32; \
        kn0 = __builtin_shufflevector(*(const LAS v4i_t*)(kp + k64a), *(const LAS v4i_t*)(kp + k64b), 0, 1, 2, 3, 4, 5, 6, 7); \
        kn1 = __builtin_shufflevector(*(const LAS v4i_t*)(kp + 2048 + k64a), *(const LAS v4i_t*)(kp + 2048 + k64b), 0, 1, 2, 3, 4, 5, 6, 7); \
        kr0 = __builtin_shufflevector(*(const LAS v4i_t*)(rp + k32a), *(const LAS v4i_t*)(rp + (k32a ^ 16)), 0, 1, 2, 3, 4, 5, 6, 7);      \
        kr1 = __builtin_shufflevector(*(const LAS v4i_t*)(rp + 1024 + k32a), *(const LAS v4i_t*)(rp + 1024 + (k32a ^ 16)), 0, 1, 2, 3, 4, 5, 6, 7); } while (0)
#define MLA_VLD(sl_) do { const LAS unsigned char* vp = shm + L_V + (sl_) * VSLOT + r32 * 64; \
        vf0 = __builtin_shufflevector(*(const LAS v4i_t*)(vp + k64a), *(const LAS v4i_t*)(vp + k64b), 0, 1, 2, 3, 4, 5, 6, 7); \
        vf1 = __builtin_shufflevector(*(const LAS v4i_t*)(vp + 2048 + k64a), *(const LAS v4i_t*)(vp + 2048 + k64b), 0, 1, 2, 3, 4, 5, 6, 7); } while (0)
#define MLA_MF(a_, b_, c_, sa_, sb_) __builtin_amdgcn_mfma_scale_f32_32x32x64_f8f6f4(a_, b_, c_, 0, 0, 0, sa_, 0, sb_)
#define MLA_QK(P0, P1) do { \
        P0 = MLA_MF(kn0, qf[0], negm, MLA_SC1, MLA_SCQ); P1 = MLA_MF(kn1, qf[0], negm, MLA_SC1, MLA_SCQ); \
        P0 = MLA_MF(kr0, qf[1], P0, MLA_SC1, MLA_SCQ); P1 = MLA_MF(kr1, qf[1], P1, MLA_SC1, MLA_SCQ); } while (0)
#define MLA_PV() do { o[0] = MLA_MF(p8, vf0, o[0], MLA_SC1, MLA_SC1); o[1] = MLA_MF(p8, vf1, o[1], MLA_SC1, MLA_SC1); { v8i_t ones; _Pragma("unroll") for (int i = 0; i < 8; ++i) { int w_; asm volatile("v_mov_b32 %0, 0x38383838" : "=v"(w_)); ones[i] = w_; }        \
          lacc = MLA_MF(p8, ones, lacc, MLA_SC1, MLA_SC1); } } while (0)
#define MLA_SM(PA0, PA1, PB0, PB1, t, ADJB) do { \
            const float rm = rowmax(PA0, PA1); \
            if (__any(rm > THR)) { const float dl = __builtin_fmaxf(rm, 0.f); mrun += dl; \
                _Pragma("unroll") for (int r = 0; r < 16; ++r) { PA0[r] -= dl; PA1[r] -= dl; } \
                if (ADJB && (t) + 1 < nvis) { _Pragma("unroll") for (int r = 0; r < 16; ++r) { PB0[r] -= dl; PB1[r] -= dl; } } \
                _Pragma("unroll") for (int r = 0; r < 16; ++r) negm[r] = -mrun; \
                asm volatile("" : "+v"(negm)); \
                const float f = fast_exp2(-dl); if (hi == 0) wsf[r32] = f; LDS_WAIT(); \
                _Pragma("unroll") for (int r = 0; r < 16; ++r) { const float fr_ = wsf[crow(r, hi)]; o[0][r] *= fr_; o[1][r] *= fr_; lacc[r] *= fr_; } \
                LDS_WAIT(); } \
            _Pragma("unroll") for (int r = 0; r < 16; ++r) { PA0[r] = fast_exp2(PA0[r]); PA1[r] = fast_exp2(PA1[r]); } \
            _Pragma("unroll") for (int i = 0; i < 4; ++i) { p8[i] = (int)cvt4_fp8(PA0[4 * i], PA0[4 * i + 1], PA0[4 * i + 2], PA0[4 * i + 3]); p8[4 + i] = (int)cvt4_fp8(PA1[4 * i], PA1[4 * i + 1], PA1[4 * i + 2], PA1[4 * i + 3]); } \
        } while (0)
#define MLA_STEP(PA0, PA1, PB0, PB1, t) do { \
        if ((t) + 2 < NT) { if ((t) + 3 < NT) asm volatile("s_waitcnt vmcnt(2) lgkmcnt(0)\n\ts_barrier" ::: "memory"); else asm volatile("s_waitcnt vmcnt(0) lgkmcnt(0)\n\ts_barrier" ::: "memory"); } \
        if ((t) + 4 < NT) MLA_DMA((t) + 4, ((t) + 4) & 7); \
        v8i_t vf0, vf1;                                                       \
        if constexpr (GA) { \
            const bool pv_ = (t) >= 1 && (t) - 1 < nvis; \
            if (pv_) MLA_VLD(((t) - 1) & 7); \
            if ((t) + 1 < nvis) MLA_QK(PB0, PB1); \
            if (pv_) MLA_PV(); \
            if ((t) < nvis) MLA_SM(PA0, PA1, PB0, PB1, t, true); \
            __builtin_amdgcn_sched_barrier(0); \
            if ((t) + 2 < nvis) MLA_KLD(((t) + 2) & 7); \
        } else { \
            if ((t) < nvis) { \
                MLA_VLD((t) & 7); \
                if ((t) + 1 < nvis) MLA_KLD(((t) + 1) & 7); \
                MLA_SM(PA0, PA1, PB0, PB1, t, false); \
                __builtin_amdgcn_sched_barrier(0); \
                if ((t) + 1 < nvis) MLA_QK(PB0, PB1); \
                MLA_PV(); } \
        } \
    } while (0)
    asm volatile("s_waitcnt vmcnt(4) lgkmcnt(0)\n\ts_barrier" ::: "memory");
    f32x16 pA0, pA1, pB0, pB1;
    MLA_KLD(0); MLA_QK(pA0, pA1);
    { const float rm = rowmax(pA0, pA1); mrun = rm;
#pragma unroll
        for (int r = 0; r < 16; ++r) { pA0[r] -= rm; pA1[r] -= rm; negm[r] = -rm; }
        asm volatile("" : "+v"(negm)); }
    if (GA && 1 < nvis) MLA_KLD(1);
    for (int t = 0; t < NT; t += 2) {
        MLA_STEP(pA0, pA1, pB0, pB1, t);
        MLA_STEP(pB0, pB1, pA0, pA1, t + 1);
    }
    if (GA && nvis == NT) { v8i_t vf0, vf1; MLA_VLD((NT - 1) & 7); MLA_PV(); }
#undef MLA_SM
#undef MLA_VLD
#undef MLA_MF
#undef MLA_PV
#undef MLA_KLD
#undef MLA_QK
#undef MLA_STEP
    float rli[16];
#pragma unroll
    for (int r = 0; r < 16; ++r) rli[r] = __builtin_amdgcn_rcpf(lacc[r]);
    unsigned char* Ow = (unsigned char*)O + (rowbase + q0 + wid * 32) * 512 + h * 64;
    { LAS unsigned char* stg = (LAS unsigned char*)(shm + L_OST) + wid * 4096;
#pragma unroll
        for (int r = 0; r < 16; ++r) { const int orow = crow(r, hi); const unsigned w = cvt4_fp8(o[0][r] * rli[r] * 16.f, o[1][r] * rli[r] * 16.f, 0.f, 0.f);
            stg[orow * 64 + r32] = (unsigned char)(w & 0xffu); stg[orow * 64 + 32 + r32] = (unsigned char)((w >> 8) & 0xffu); }
        LDS_WAIT();
#pragma unroll
        for (int i = 0; i < 2; ++i) { const int row = i * 16 + (lane >> 2), ch = lane & 3; const u32x4 v = *(const LAS u32x4*)(stg + row * 64 + ch * 16); *(u32x4*)(Ow + (long)row * 512 + ch * 16) = v; } }
    asm volatile("s_waitcnt lgkmcnt(0)\n\ts_barrier" ::: "memory");
#undef MLA_DMA
#undef MX3
}
}

#define XB_TMO      128
#define XB_XCNT(j)  (256  + 64 * (j))
#define XB_XSUB(j)  (1280 + 64 * (j))
#define XB_XGEN(j)  (2304 + 64 * (j))
#define XB_TOP      3328
#define XB_TOPGEN   3392
#define XCD_BAR_WORDS 3456
#define XB_SPIN_CAP (1u << 18)
__device__ __forceinline__ unsigned xb_ld(unsigned* p)              { return __hip_atomic_load(p, __ATOMIC_RELAXED, __HIP_MEMORY_SCOPE_AGENT); }
__device__ __forceinline__ unsigned xb_add(unsigned* p, unsigned v) { return __hip_atomic_fetch_add(p, v, __ATOMIC_RELAXED, __HIP_MEMORY_SCOPE_AGENT); }
__device__ __forceinline__ unsigned xb_xcc_id() { return (unsigned)__builtin_amdgcn_s_getreg((3 << 11) | 20) & 0xFu; }
#define XB_SPIN(cond, bar) do { unsigned _sp = 0; while (cond) { __builtin_amdgcn_s_sleep(1); \
    if ((++_sp & 255u) == 0u) { if (xb_ld(&(bar)[XB_TMO])) break; if (_sp > XB_SPIN_CAP) { atomicAdd(&(bar)[XB_TMO], 1u); break; } } } } while (0)
struct XcdBarrier { unsigned* bar; unsigned x; volatile LAS unsigned* st; int w; };
__device__ __forceinline__ XcdBarrier xcd_barrier_post(unsigned* bar, volatile LAS unsigned* st) {
    XcdBarrier b; b.bar = bar; b.x = xb_xcc_id(); b.st = st;
    if (threadIdx.x == 0) (void)xb_add(&bar[XB_XCNT(b.x)], 1u);
    return b;
}
__device__ __forceinline__ void xcd_barrier_complete(unsigned* bar, unsigned x, unsigned& nloc, unsigned& nx) {
    const unsigned G = gridDim.x * gridDim.y * gridDim.z;
    unsigned sum, cnt, mine, sp = 0u;
    for (;;) {
        sum = 0u; cnt = 0u; mine = 0u;
#pragma unroll
        for (unsigned j = 0; j < 16; ++j) { const unsigned c = xb_ld(&bar[XB_XCNT(j)]); sum += c; cnt += (c > 0u) ? 1u : 0u; mine = (j == x) ? c : mine; }
        if (sum == G) break;
        __builtin_amdgcn_s_sleep(1);
        if ((++sp & 255u) == 0u) { if (xb_ld(&bar[XB_TMO])) break; if (sp > XB_SPIN_CAP) { atomicAdd(&bar[XB_TMO], 1u); break; } }
    }
    nloc = mine > 0u ? mine : 1u; nx = cnt > 0u ? cnt : 1u;
}
__device__ __forceinline__ void xcd_barrier(const XcdBarrier& b) {
    asm volatile("s_waitcnt vmcnt(0)" ::: "memory");
    __syncthreads();
    if (b.w == 0 && lane_mb() == 0) {
        unsigned* bar = b.bar;
        __builtin_amdgcn_s_waitcnt(0);
        unsigned nloc = b.st[0], nx = b.st[1];
        if (nloc == 0u) { xcd_barrier_complete(bar, b.x, nloc, nx); b.st[0] = nloc; b.st[1] = nx; }
        const unsigned old = xb_add(&bar[XB_XSUB(b.x)], 1u);
        const unsigned gen = old / nloc;
        if (old + 1u == (gen + 1u) * nloc) {
            __builtin_amdgcn_fence(__ATOMIC_RELEASE, "agent");
            asm volatile("s_waitcnt vmcnt(0)" ::: "memory");
            const unsigned og = xb_add(&bar[XB_TOP], 1u);
            const unsigned tg = og / nx;
            if (og + 1u == (tg + 1u) * nx) xb_add(&bar[XB_TOPGEN], 1u);
            else XB_SPIN(xb_ld(&bar[XB_TOPGEN]) == tg, bar);
            __builtin_amdgcn_fence(__ATOMIC_ACQUIRE, "agent");
            xb_add(&bar[XB_XGEN(b.x)], 1u);
            asm volatile("s_waitcnt vmcnt(0)" ::: "memory");
        } else {
            XB_SPIN(xb_ld(&bar[XB_XGEN(b.x)]) == gen, bar);
            __builtin_amdgcn_fence(__ATOMIC_ACQUIRE, "agent");
            asm volatile("s_waitcnt vmcnt(0)" ::: "memory");
        }
    }
    __syncthreads();
}

__device__ __forceinline__ void transpose_block(const float* src, int ldw, const float* gain, bf16_t* dst  , int ldt, LAS float* scr, int lane, unsigned char* dst8 = nullptr, int ldt8 = 0, float sc8 = 1.f) {
    float tv[32];
#pragma unroll
    for (int i = 0; i < 32; ++i) { const int kk = 2 * i + (lane >> 5); tv[i] = src ? src[(size_t)kk * ldw + (lane & 31)] : 0.f; }
#pragma unroll
    for (int i = 0; i < 32; ++i) { const int kk = 2 * i + (lane >> 5); float v = tv[i]; if (gain) v *= gain[kk]; scr[kk * 33 + (lane & 31)] = v; }
    LDS_WAIT(); asm volatile("" ::: "memory");
    const int c = lane & 7;
#pragma unroll
    for (int j = 0; j < 4; ++j) { const int n = (lane >> 3) + 8 * j; const LAS float* s = scr + (8 * c) * 33 + n;
        u32x4 o; o.x = cvt_pk_bf16(s[0 * 33], s[1 * 33]); o.y = cvt_pk_bf16(s[2 * 33], s[3 * 33]); o.z = cvt_pk_bf16(s[4 * 33], s[5 * 33]); o.w = cvt_pk_bf16(s[6 * 33], s[7 * 33]);
        if (dst) *(u32x4*)(dst + (size_t)n * ldt + 8 * c) = o;
        if (dst8) { u32x2 o8; o8.x = cvt4_fp8(s[0 * 33] * sc8, s[1 * 33] * sc8, s[2 * 33] * sc8, s[3 * 33] * sc8); o8.y = cvt4_fp8(s[4 * 33] * sc8, s[5 * 33] * sc8, s[6 * 33] * sc8, s[7 * 33] * sc8);
            *(u32x2*)(dst8 + (size_t)n * ldt8 + 8 * c) = o8; } }
    LDS_WAIT(); asm volatile("" ::: "memory");
}
__device__ __forceinline__ void rms_row_to_bf16(const float* xrow, const float* g, bf16_t* orow, int lane) {
    const f32x4* xr = (const f32x4*)xrow + lane; const f32x4* gr = (const f32x4*)g + lane;
    f32x4 v[4]; float s = 0.f;
#pragma unroll
    for (int j = 0; j < 4; ++j) { v[j] = xr[64 * j]; s += (v[j].x * v[j].x + v[j].y * v[j].y) + (v[j].z * v[j].z + v[j].w * v[j].w); }
    const float rstd = 1.0f / sqrtf(wave_sum(s) * (1.f / DM) + EPS);
    u32x2* o8 = (u32x2*)orow + lane;
#pragma unroll
    for (int j = 0; j < 4; ++j) { const f32x4 gg = gr[64 * j]; u32x2 w; w.x = cvt_pk_bf16(v[j].x * rstd * gg.x, v[j].y * rstd * gg.y); w.y = cvt_pk_bf16(v[j].z * rstd * gg.z, v[j].w * rstd * gg.w); o8[64 * j] = w; }
}

__device__ __forceinline__ void rms_row2_to_bf16(const float* xrow, const float* g, bf16_t* orow, int lane, unsigned char* orow8 = nullptr) {
    const f32x4* xr = (const f32x4*)xrow + lane; const f32x4* gr = (const f32x4*)g + lane;
    f32x4 v[2][4]; float s[2] = {0.f, 0.f};
#pragma unroll
    for (int r = 0; r < 2; ++r)
#pragma unroll
        for (int j = 0; j < 4; ++j) v[r][j] = xr[r * 256 + 64 * j];
#pragma unroll
    for (int r = 0; r < 2; ++r)
#pragma unroll
        for (int j = 0; j < 4; ++j) s[r] += (v[r][j].x * v[r][j].x + v[r][j].y * v[r][j].y) + (v[r][j].z * v[r][j].z + v[r][j].w * v[r][j].w);
#pragma unroll
    for (int r = 0; r < 2; ++r) { const float rstd = 1.0f / sqrtf(wave_sum(s[r]) * (1.f / DM) + EPS); u32x2* o8 = (u32x2*)(orow + (size_t)r * DM) + lane;
#pragma unroll
        for (int j = 0; j < 4; ++j) { const f32x4 gg = gr[64 * j]; u32x2 w; w.x = cvt_pk_bf16(v[r][j].x * rstd * gg.x, v[r][j].y * rstd * gg.y); w.y = cvt_pk_bf16(v[r][j].z * rstd * gg.z, v[r][j].w * rstd * gg.w); o8[64 * j] = w;
            if (orow8) ((unsigned*)(orow8 + (size_t)r * DM))[lane + 64 * j] = cvt4_fp8(v[r][j].x * rstd * gg.x, v[r][j].y * rstd * gg.y, v[r][j].z * rstd * gg.z, v[r][j].w * rstd * gg.w); } }
}
struct Args { const void* in[28]; float* out; unsigned char* ws; int ph_lo, ph_hi; };
constexpr int NPHASE = 12;

#define CAS __attribute__((address_space(4)))
#define PHASE_PTRS const CAS char* ka_ = (const CAS char*)__builtin_amdgcn_kernarg_segment_ptr(); asm volatile("" : "+s"(ka_)); unsigned char* ws = *(unsigned char* const CAS*)(ka_ + 232); float* outp = *(float* const CAS*)(ka_ + 224); const float* x = *(const float* const CAS*)(ka_ + 0); const float* mem = *(const float* const CAS*)(ka_ + 8); const int* positions = *(const int* const CAS*)(ka_ + 16); const float* mix_norm_g = *(const float* const CAS*)(ka_ + 24); const float* w_in = *(const float* const CAS*)(ka_ + 32); const float* q_norm_g = *(const float* const CAS*)(ka_ + 40); const float* w_q_up = *(const float* const CAS*)(ka_ + 48); const float* kv_norm_g = *(const float* const CAS*)(ka_ + 56); const float* w_kv_up = *(const float* const CAS*)(ka_ + 64); const float* w_attn_branch = *(const float* const CAS*)(ka_ + 72); const float* pool_w = *(const float* const CAS*)(ka_ + 80); const float* pool_scale = *(const float* const CAS*)(ka_ + 88); const float* w_pool_branch = *(const float* const CAS*)(ka_ + 96); const float* w_mix_out = *(const float* const CAS*)(ka_ + 104); const float* xattn_norm_g = *(const float* const CAS*)(ka_ + 112); const float* mem_norm_g = *(const float* const CAS*)(ka_ + 120); const float* w_xq = *(const float* const CAS*)(ka_ + 128); const float* w_xkv = *(const float* const CAS*)(ka_ + 136); const float* w_xo = *(const float* const CAS*)(ka_ + 144); const float* ffn_norm_g = *(const float* const CAS*)(ka_ + 152); const float* w_rg = *(const float* const CAS*)(ka_ + 160); const float* b_rg = *(const float* const CAS*)(ka_ + 168); const float* w_re = *(const float* const CAS*)(ka_ + 176); const float* b_re = *(const float* const CAS*)(ka_ + 184); const float* w_eg = *(const float* const CAS*)(ka_ + 192); const float* w_eu = *(const float* const CAS*)(ka_ + 200); const float* w_ed = *(const float* const CAS*)(ka_ + 208); const float* final_g = *(const float* const CAS*)(ka_ + 216); u64* ssq_q = (u64*)(ws + OFF_SSQQ); u64* ssq_kv = (u64*)(ws + OFF_SSQKV); u64* ssq1 = (u64*)(ws + OFF_SSQ1); u64* ssq2 = (u64*)(ws + OFF_SSQ2); unsigned* cnt = (unsigned*)(ws + OFF_CNT); float* cosT = (float*)(ws + WS_COS); float* sinT = (float*)(ws + WS_SIN); unsigned char* WIN8 = ws + WS_WIN8; unsigned char* HN8 = ws + WS_S6;     bf16_t* WIN = (bf16_t*)(ws + WS_WIN); unsigned char* WQ8 = ws + WS_WQ; unsigned char* WKVU8 = ws + WS_WKVU; unsigned char* WA8 = ws + WS_WA; bf16_t* WPB = (bf16_t*)(ws + WS_WPB); bf16_t* WMO = (bf16_t*)(ws + WS_WMO); bf16_t* WXKV = (bf16_t*)(ws + WS_WXKV); bf16_t* WXO = (bf16_t*)(ws + WS_WXO); bf16_t* WR = (bf16_t*)(ws + WS_WR); unsigned char* WGU8 = ws + WS_WGU; unsigned char* H28 = ws + WS_S5; unsigned char* WD8 = ws + WS_WD; bf16_t* MEMN = (bf16_t*)(ws + WS_MEMN); bf16_t* KVM = (bf16_t*)(ws + WS_KVM); bf16_t* WXQN = (bf16_t*)(ws + WS_WXQN); unsigned char* BQK = ws + WS_BQK; unsigned char* BVO = ws + WS_BVO; unsigned char* H18 = ws + WS_S5; unsigned char* P8 = ws + WS_S1; float* LG = (float*)(ws + WS_LG); bf16_t* HN = (bf16_t*)(ws + WS_S0); bf16_t* Qb = (bf16_t*)(ws + WS_S0); bf16_t* H1 = (bf16_t*)(ws + WS_S0); bf16_t* GA = (bf16_t*)(ws + WS_S1); bf16_t* XQ = (bf16_t*)(ws + WS_S1); bf16_t* Y = (bf16_t*)(ws + WS_S1); bf16_t* GBM = (bf16_t*)(ws + WS_S2); bf16_t* QLb = (bf16_t*)(ws + WS_QLB); bf16_t* KVLb = (bf16_t*)(ws + WS_KVLB); bf16_t* KRb = (bf16_t*)(ws + WS_KRB); bf16_t* H2 = (bf16_t*)(ws + WS_S3); bf16_t* U = (bf16_t*)(ws + WS_U); bf16_t* DP = (bf16_t*)(ws + WS_DP); unsigned char* HID = ws + WS_HID; int* LIST = (int*)(ws + WS_LIST); float* WL = (float*)(ws + WS_WL); float* RSL = (float*)(ws + WS_RSL); unsigned char* K8 = ws + WS_S5; unsigned char* VT8 = ws + WS_S5 + 64 * MiB; unsigned char* Q8 = ws + WS_S0; bf16_t* ATT = (bf16_t*)(ws + WS_ATT); (void)outp; int tidp_ = wave * 64 + lane_mb(); asm volatile("" : "+v"(tidp_)); const int tid = tidp_, lane = tid & 63, gt = bx * 512 + tid; (void)lane; (void)gt;
__global__ void __launch_bounds__(512, 2) fwd_kernel(Args args) {
    extern __shared__ __attribute__((aligned(16))) unsigned char lds_raw[];
    LAS unsigned char* lds = (LAS unsigned char*)lds_raw;
    LAS unsigned char* misc = lds + MISC_OFF;
    const int tid = threadIdx.x, lane = tid & 63, wave = __builtin_amdgcn_readfirstlane(tid >> 6);
    const int G = gridDim.x, bx = blockIdx.x;
    const int vcu = (G % 8 == 0) ? (bx % 8) * (G / 8) + bx / 8 : bx;
    for (int u = tid; u < (LDS_BYTES - MISC_OFF) / 4; u += 512) ((LAS unsigned*)misc)[u] = 0u;
    __syncthreads();
    unsigned* barw = (unsigned*)(args.ws + WS_CTL);
    XcdBarrier bar; bar.bar = barw; bar.x = 0; bar.st = nullptr; bar.w = wave;
    if (MK_N_LAUNCHES == 1) { bar = xcd_barrier_post(barw, (volatile LAS unsigned*)(misc + MO_BAR)); bar.w = wave; }
#define GRID_BAR() do { if (MK_N_LAUNCHES == 1) xcd_barrier(bar); } while (0)
    const int lo = args.ph_lo, hi = args.ph_hi;
#ifndef PH_MASK
#define PH_MASK 0xfff
#endif
#define IN(k) ((((PH_MASK) >> (k)) & 1) && lo <= (k) && (k) < hi)
#define BOTH(k) (IN(k) && IN((k) + 1))
    const int gw = vcu * 8 + wave, NGW = G * 8;
    const int gt = bx * 512 + tid, NGT = G * 512;

    if (IN(0)) {
        PHASE_PTRS
        for (int i = gt; i < (int)(SMALL_ZERO_BYTES / 4); i += NGT) ((unsigned*)(ws + WS_SMALL))[i] = 0u;
        for (int i = gt; i < NTOK * 16; i += NGT) { const int row = i >> 4, k = i & 15;
            const float inv = (float)exp2(-(double)k * (13.287712379549449 / 16.0)); const float ang = (float)positions[row] * inv;
            const double rev = (double)ang * 0.15915494309189535; const float fr_ = (float)(rev - rint(rev));
            cosT[i] = __builtin_amdgcn_cosf(fr_); sinT[i] = __builtin_amdgcn_sinf(fr_); }
        for (int i = gt; i < POOLW * DM; i += NGT) { const int n = i & (DM - 1), k = i >> 10, g = k >> 7; const float* pw = pool_w + (size_t)k * 128; const float* sc = pool_scale + g * 128; const float* wb = w_pool_branch + (size_t)g * 128 * DM + n;
            float s = 0.f;
            for (int e = 0; e < 128; ++e) s += pw[e] * sc[e] * wb[(size_t)e * DM];
            WPB[(size_t)n * POOLW + k] = (bf16_t)(cvt_pk_bf16(s, 0.f) & 0xffffu); }
        for (int i = gt; i < DM * DM / 8; i += NGT) { const int k = i >> 7; const float g_ = xattn_norm_g[k]; const f32x4 a0 = *(const f32x4*)(w_xq + (size_t)i * 8), a1 = *(const f32x4*)(w_xq + (size_t)i * 8 + 4); store8(WXQN + (size_t)i * 8, a0 * g_, a1 * g_); }
        for (int i = gt; i < 256 * DM; i += NGT) { const int n = i >> 10, k = i & (DM - 1); float v = 0.f;
            if (n < 32) v = w_re[k * 32 + n] * ffn_norm_g[k]; else if (n < 36) v = w_rg[k * 4 + (n - 32)] * ffn_norm_g[k];
            WR[i] = (bf16_t)(cvt_pk_bf16(v, 0.f) & 0xffffu); }
        {
            LAS float* scr = (LAS float*)(lds + wave * 16384);
            constexpr int I_IN = 16 * 104, I_Q = 8 * 24, I_KV = 4 * 32, I_A = 8 * 32, I_SQ = 16 * 32, I_XKV = 16 * 64, I_GU = 32 * 16 * 16, I_D = 32 * 4 * 32;
            constexpr int NITEMS = I_IN + I_Q + I_KV + I_A + 2 * I_SQ + I_XKV + I_GU + I_D;
            for (int it = gw; it < NITEMS; it += NGW) {
                int r = it;
                if (r < I_IN) { const int kb = r / 104, nb = r % 104, n0 = nb * 32; const int sn = n0 < 672 ? n0 : (n0 < 768 ? -1 : n0 - 96);
                    transpose_block(sn >= 0 ? w_in + (size_t)kb * 64 * IN_COLS + sn : nullptr, IN_COLS, nullptr, WIN + (size_t)n0 * DM + kb * 64, DM, scr, lane, (n0 >= 1280 || n0 < 768) ? WIN8 + (size_t)n0 * DM + kb * 64 : nullptr, DM, 32.f); continue; } r -= I_IN;
                if (r < I_Q) { const int kb = r / 24, nb = r % 24; transpose_block(kb < 6 ? w_q_up + (size_t)kb * 64 * 768 + nb * 32 : nullptr, 768, kb < 6 ? q_norm_g + kb * 64 : nullptr, nullptr, 512, scr, lane, WQ8 + (size_t)nb * 32 * 512 + kb * 64, 512, 32.f); continue; } r -= I_Q;
                if (r < I_KV) { const int kb = r / 32, nb = r % 32, n0 = nb * 32; const int nn = n0 & 511, sn = (nn >> 6) * 128 + (n0 >= 512 ? 64 : 0) + (nn & 63);
                    transpose_block(w_kv_up + (size_t)kb * 64 * 1024 + sn, 1024, kv_norm_g + kb * 64, nullptr, KVLORA, scr, lane, WKVU8 + (size_t)n0 * KVLORA + kb * 64, KVLORA, 32.f); continue; } r -= I_KV;
                if (r < I_A) { const int kb = r / 32, nb = r % 32; transpose_block(w_attn_branch + (size_t)kb * 64 * DM + nb * 32, DM, nullptr, nullptr, 512, scr, lane, WA8 + (size_t)nb * 32 * 512 + kb * 64, 512, 32.f); continue; } r -= I_A;
                if (r < I_SQ) { const int kb = r / 32, nb = r % 32; transpose_block(w_mix_out + (size_t)kb * 64 * DM + nb * 32, DM, nullptr, WMO + (size_t)nb * 32 * DM + kb * 64, DM, scr, lane); continue; } r -= I_SQ;
                if (r < I_SQ) { const int kb = r / 32, nb = r % 32; transpose_block(w_xo + (size_t)kb * 64 * DM + nb * 32, DM, nullptr, WXO + (size_t)nb * 32 * DM + kb * 64, DM, scr, lane); continue; } r -= I_SQ;
                if (r < I_XKV) { const int kb = r / 64, nb = r % 64; transpose_block(w_xkv + (size_t)kb * 64 * 2048 + nb * 32, 2048, nullptr, WXKV + (size_t)nb * 32 * DM + kb * 64, DM, scr, lane); continue; } r -= I_XKV;
                if (r < I_GU) { const int e = r / 256, q = r % 256, kb = q / 16, nb = q % 16, n0 = nb * 32;
                    const int pn = n0 >> 8, j = n0 & 255; const float* srcm = (j < 128 ? w_eg : w_eu) + (size_t)e * DM * EFF; const int sc = pn * 128 + (j & 127);
                    transpose_block(srcm + (size_t)kb * 64 * EFF + sc, EFF, ffn_norm_g + kb * 64, nullptr, DM, scr, lane, WGU8 + ((size_t)e * 512 + n0) * DM + kb * 64, DM, 32.f); continue; } r -= I_GU;
                { const int e = r / 128, q = r % 128, kb = q / 32, nb = q % 32;
                    transpose_block(w_ed + (size_t)e * EFF * DM + (size_t)kb * 64 * DM + nb * 32, DM, nullptr, nullptr, EFF, scr, lane, WD8 + ((size_t)e * DM + nb * 32) * EFF + kb * 64, EFF, 32.f); }
            }
        }
        for (int m = gw * 2; m < NTOK; m += NGW * 2) rms_row2_to_bf16(x + (size_t)m * DM, mix_norm_g, HN + (size_t)m * DM, lane, HN8 + (size_t)m * DM);
        for (int m = gw; m < NMEM; m += NGW) rms_row_to_bf16(mem + (size_t)m * DM, mem_norm_g, MEMN + (size_t)m * DM, lane);
        if (BOTH(0)) GRID_BAR();
    }

    if (IN(1)) {
        PHASE_PTRS
        { OpIn op{HN, WIN, DM, DM, DM, QLb, KVLb, KRb, U, GA, GBM, ssq_q, ssq_kv, cosT, sinT}; OffsetOrder S; S.s.init(NTOK, 512, G, bx); S.off = 3; pg8::gemm_phase(lds, op, S, wave); }
        { OpPlain op{MEMN, WXKV, DM, DM, DM, KVM, 2 * DM}; pg8::StaticOrder S; S.init(NMEM, 2 * DM, G, bx); pg8::gemm_phase(lds, op, S, wave); }
    }
    if (IN(1)) {
        PHASE_PTRS
        { OpIn8 op{(const bf16_t*)HN8, (const bf16_t*)WIN8, DM / 2, DM / 2, DM / 2, QLb, KVLb, KRb, U, GA, GBM, ssq_q, ssq_kv, cosT, sinT}; pg8::StaticOrder S; S.init(NTOK, 768, G, bx); pg8::gemm_phase(lds, op, S, wave); }
        { OpGate8 op{(const bf16_t*)HN8, (const bf16_t*)WIN8, DM / 2, DM / 2, DM / 2, GA, GBM};
          OffsetOrder S; S.s.init(NTOK, 2048, G, bx); S.off = 5; pg8::gemm_phase(lds, op, S, wave); }
        if (BOTH(1)) GRID_BAR();
    }

    if (IN(2)) {
        PHASE_PTRS
        { OpPre op{KVM, WXQN, 256, 2 * DM, DM, BQK, 0}; pg8::StaticOrder S; S.init(16 * DM, DM, G, bx); pg8::gemm_phase(lds, op, S, wave); }
        { OpPre op{KVM, WXO, 256, DM, 2 * DM, BVO, 1}; pg8::StaticOrder S; S.init(16 * DM, DM, G, bx); pg8::gemm_phase(lds, op, S, wave); }
        { OpQ op{QLb, (const bf16_t*)WQ8, 256, 256, 256, Q8, ssq_q, cosT, sinT}; pg8::StaticOrder S; S.init(NTOK, NHEAD * QKD, G, bx); pg8::gemm_phase(lds, op, S, wave); }
        { OpK8 op{KVLb, (const bf16_t*)WKVU8, KVLORA / 2, KVLORA / 2, KVLORA / 2, K8, ssq_kv}; pg8::StaticOrder S; S.init(NTOK, 512, G, bx); pg8::gemm_phase(lds, op, S, wave); }
        { OpVT op{(const bf16_t*)(WKVU8 + 512 * KVLORA), KVLb, KVLORA / 2, KVLORA / 2, KVLORA / 2, VT8, ssq_kv}; pg8::StaticOrder S; S.init(512, NTOK, G, bx); pg8::gemm_phase(lds, op, S, wave); }
        { RELANE
        static_assert((4 * (NTOK / 4)) % 2 == 0, "item pairs");
        for (int it = gw; it < 4 * (NTOK / 4); it += 2 * NGW) { const int g = it & 3, ch = g * 16 + (lane & 15); const bool two_ = it + NGW < 4 * (NTOK / 4);
            const int rowA = (it >> 2) * 4 + (lane >> 4), rowB = two_ ? ((it + NGW) >> 2) * 4 + (lane >> 4) : rowA, tA = rowA & (SEQ - 1), tB = rowB & (SEQ - 1);
            const bf16_t* pA = U + (size_t)rowA * POOLW + ch * 8; const bf16_t* pB = U + (size_t)rowB * POOLW + ch * 8;
            f32x4 a0, a1, ua0, ua1, b0, b1, ub0, ub1; load8(pA, ua0, ua1); load8(pB, ub0, ub1); a0 = ua0; a1 = ua1; b0 = ub0; b1 = ub1;
#define DP_WIN(W) { u32x4 wa_[W - 1], wb_[W - 1]; \
                    _Pragma("unroll") for (int j = 1; j < W; ++j) { wa_[j - 1] = *(const u32x4*)(pA - (size_t)(j <= tA ? j : 0) * POOLW); wb_[j - 1] = *(const u32x4*)(pB - (size_t)(j <= tB ? j : 0) * POOLW); } \
                    _Pragma("unroll") for (int j = 1; j < W; ++j) { const u32x4 w = wa_[j - 1]; const float k_ = (j <= tA) ? 1.f : 0.f; a0 += (f32x4){bf_lo(w.x), bf_hi(w.x), bf_lo(w.y), bf_hi(w.y)} * k_; a1 += (f32x4){bf_lo(w.z), bf_hi(w.z), bf_lo(w.w), bf_hi(w.w)} * k_; } \
                    _Pragma("unroll") for (int j = 1; j < W; ++j) { const u32x4 w = wb_[j - 1]; const float k_ = (j <= tB) ? 1.f : 0.f; b0 += (f32x4){bf_lo(w.x), bf_hi(w.x), bf_lo(w.y), bf_hi(w.y)} * k_; b1 += (f32x4){bf_lo(w.z), bf_hi(w.z), bf_lo(w.w), bf_hi(w.w)} * k_; } }
            if (g == 0) DP_WIN(2) else if (g == 1) DP_WIN(4) else if (g == 2) DP_WIN(8) else DP_WIN(16)
#undef DP_WIN
            const int w = 2 << g, nA = (tA + 1 < w) ? tA + 1 : w, nB = (tB + 1 < w) ? tB + 1 : w; const float invA = 1.0f / (float)nA, invB = 1.0f / (float)nB;
            store8(DP + (size_t)rowA * POOLW + ch * 8, a0 * invA - ua0, a1 * invA - ua1);
            if (two_) store8(DP + (size_t)rowB * POOLW + ch * 8, b0 * invB - ub0, b1 * invB - ub1); }
        }
        if (BOTH(2)) GRID_BAR();
    }

    if (IN(3)) {
        PHASE_PTRS
        { OpYB op{DP, WPB, POOLW, POOLW, POOLW, GBM}; pg8::StaticOrder S; S.init(NTOK, DM, G, bx); pg8::gemm_phase(lds, op, S, wave); }
        { const int bh = vcu >> 1, half = vcu & 1;
          if (bh < NBATCH * NHEAD) for (int i = 0; i < 8; ++i) { const int pr = i >> 1, od = i & 1; const int qb = 4 * pr + (od ? (half ? 2 : 3) : (half ? 1 : 0));
              if (wave < 4) mla::attn_unit<true>(bh >> 3, bh & 7, qb, Q8, K8, (const unsigned char*)KRb, VT8, ATT, lds, wave); else mla::attn_unit<false>(bh >> 3, bh & 7, qb, Q8, K8, (const unsigned char*)KRb, VT8, ATT, lds, wave); } }
        if (BOTH(3)) GRID_BAR();
    }

    if (IN(4)) {
        PHASE_PTRS
        { OpYA op{ATT, (const bf16_t*)WA8, 256, 256, 256, GA, GBM}; pg8::StaticOrder S; S.init(NTOK, DM, G, bx); pg8::gemm_phase(lds, op, S, wave); }
        if (BOTH(4)) GRID_BAR();
    }

    if (IN(5)) {
        PHASE_PTRS
        { OpRes<true> op{GBM, WMO, DM, DM, DM, x, H1, ssq1, 0, H18, 1.0f}; pg8::StaticOrder S; S.init(NTOK, DM, G, bx); pg8::gemm_phase(lds, op, S, wave); }
        if (BOTH(5)) GRID_BAR();
    }

    if (IN(6)) {
        PHASE_PTRS
        { OpSX op{(const bf16_t*)H18, (const bf16_t*)BQK, DM / 2, DM / 2, DM / 2, P8, ssq1, (LAS f32x4*)(misc + MO_PS)}; pg8::StaticOrder S; S.init(NTOK, DM, G, bx); pg8::gemm_phase(lds, op, S, wave); }
        if (BOTH(6)) GRID_BAR();
    }

    if (IN(7)) {
        PHASE_PTRS
        { OpRes<false, true> op{(const bf16_t*)P8, (const bf16_t*)BVO, DM / 2, DM / 2, DM / 2, H1, H2, ssq2, (size_t)DM * DM / 2, H28, 1.0f / 256.f}; pg8::StaticOrder S; S.init(NTOK, DM, G, bx); pg8::gemm_phase(lds, op, S, wave); }
        if (BOTH(7)) GRID_BAR();
    }

    if (IN(8)) {
        PHASE_PTRS
        pg8::StaticOrder S; S.init(NTOK, 256, G, bx);
        { OpR op{H2, WR, DM, DM, DM, LG, ssq2}; pg8::gemm_phase(lds, op, S, wave); }
        { RELANE
        VM_WAIT(); __syncthreads(); __builtin_amdgcn_fence(__ATOMIC_ACQUIRE, "agent"); VM_WAIT(); __syncthreads();
        LAS unsigned* hist = (LAS unsigned*)(misc + MO_HIST); LAS unsigned* basee = (LAS unsigned*)(misc + MO_BASE);
        pg8::StaticOrder S2; S2.init(NTOK, 256, G, bx);
        for (int i = 0; i < (256 + G - 1) / G; ++i) { Unit u; if (!S2.next(i, u)) break;
            if (tid < 32) hist[tid] = 0u;
            __syncthreads();
            int e1 = 0, e2 = 0; float w1 = 0.f, w2 = 0.f; unsigned r1 = 0, r2 = 0; const int row = u.pm * 256 + tid;
            if (tid < 256) {
                const float* lg = LG + (size_t)row * 40;
                float gl[4]; int gi = 0;
#pragma unroll
                for (int j = 0; j < 4; ++j) gl[j] = lg[32 + j] + b_rg[j];
                float gm = gl[0];
#pragma unroll
                for (int j = 1; j < 4; ++j) if (gl[j] > gm) { gm = gl[j]; gi = j; }
                float gs = 0.f;
#pragma unroll
                for (int j = 0; j < 4; ++j) gs += __expf(gl[j] - gm);
                const float gwt = 1.0f / gs;
                float el[8];
#pragma unroll
                for (int j = 0; j < 8; ++j) el[j] = lg[gi * 8 + j] + b_re[gi * 8 + j];
                int i1 = 0; float m1 = el[0];
#pragma unroll
                for (int j = 1; j < 8; ++j) if (el[j] > m1) { m1 = el[j]; i1 = j; }
                int i2 = -1; float m2 = -3.0e38f;
#pragma unroll
                for (int j = 0; j < 8; ++j) if (j != i1 && el[j] > m2) { m2 = el[j]; i2 = j; }
                const float p2 = __expf(m2 - m1);
                w1 = gwt / (1.0f + p2); w2 = gwt * p2 / (1.0f + p2);
                e1 = gi * 8 + i1; e2 = gi * 8 + i2;
                r1 = __hip_atomic_fetch_add(&hist[e1], 1u, __ATOMIC_RELAXED, __HIP_MEMORY_SCOPE_WORKGROUP); r2 = __hip_atomic_fetch_add(&hist[e2], 1u, __ATOMIC_RELAXED, __HIP_MEMORY_SCOPE_WORKGROUP);
            }
            __syncthreads();
            if (tid < 32) basee[tid] = hist[tid] ? __hip_atomic_fetch_add(cnt + tid, hist[tid], RLX_AGENT) : 0u;
            __syncthreads();
            if (tid < 256) { const size_t p1 = (size_t)e1 * NTOK + basee[e1] + r1, p2 = (size_t)e2 * NTOK + basee[e2] + r2;
                const float rs_ = __builtin_amdgcn_rsqf(fx_load(ssq2 + row) * (1.0f / DM) + EPS);
                LIST[p1] = row * 2; WL[p1] = w1; RSL[p1] = rs_; LIST[p2] = row * 2 + 1; WL[p2] = w2; RSL[p2] = rs_; }
            __syncthreads();
        }
        }
        if (BOTH(8)) GRID_BAR();
    }

    if (IN(9)) {
        PHASE_PTRS
        LAS int* cntL = (LAS int*)(misc + MO_CNTL); LAS int* tbase = (LAS int*)(misc + MO_TBASE); LAS int* tileE = (LAS int*)(misc + MO_TILEE);
        const int ntile = moe_build_tables(cnt, cntL, tbase, tileE, tid);
        { OpGU op{(const bf16_t*)H28, (const bf16_t*)WGU8, DM / 2, DM / 2, DM / 2, HID, LIST, WL, RSL, MoeTab{tileE, tbase, cntL}}; MoeOrder<2> S{ntile * 2, G, vcu}; pg8::gemm_phase(lds, op, S, wave); }
        if (BOTH(9)) GRID_BAR();
    }

    if (IN(10)) {
        PHASE_PTRS
        LAS int* cntL = (LAS int*)(misc + MO_CNTL); LAS int* tbase = (LAS int*)(misc + MO_TBASE); LAS int* tileE = (LAS int*)(misc + MO_TILEE);
        const int ntile = moe_build_tables(cnt, cntL, tbase, tileE, tid);
        { OpDN op{(const bf16_t*)HID, (const bf16_t*)WD8, EFF / 2, EFF / 2, EFF / 2, (unsigned char*)Y, LIST, MoeTab{tileE, tbase, cntL}}; MoeOrder<4> S{ntile * 4, G, vcu}; pg8::gemm_phase(lds, op, S, wave); }
        if (BOTH(10)) GRID_BAR();
    }

    if (IN(11)) {
        PHASE_PTRS
        const f32x4 g00 = *(const f32x4*)(final_g + lane * 8), g01 = *(const f32x4*)(final_g + lane * 8 + 4), g10 = *(const f32x4*)(final_g + 512 + lane * 8), g11 = *(const f32x4*)(final_g + 512 + lane * 8 + 4);
        for (int m = gw * 2; m < NTOK; m += NGW * 2) {
            u32x4 w[2][2]; u32x2 y8[2][2][2]; const unsigned char* Y8 = (const unsigned char*)Y;
#pragma unroll
            for (int r = 0; r < 2; ++r)
#pragma unroll
                for (int hf = 0; hf < 2; ++hf) { const size_t o = (size_t)(m + r) * DM + hf * 512 + lane * 8; w[r][hf] = *(const u32x4*)(H2 + o); y8[r][hf][0] = *(const u32x2*)(Y8 + o); y8[r][hf][1] = *(const u32x2*)(Y8 + (size_t)NTOK * DM + o); }
#pragma unroll
            for (int r = 0; r < 2; ++r) { f32x4 v[2][2]; float s = 0.f;
#pragma unroll
                for (int hf = 0; hf < 2; ++hf) { f32x4 a0, a1, b0, b1, c0, c1; unpack8(w[r][hf], a0, a1); unpack8_fp8(y8[r][hf][0], b0, b1); unpack8_fp8(y8[r][hf][1], c0, c1);
                    a0 += (b0 + c0) * 0.0625f; a1 += (b1 + c1) * 0.0625f; v[hf][0] = a0; v[hf][1] = a1; s += ssq8(a0, a1); }
                const float rstd = 1.0f / sqrtf(wave_sum(s) * (1.f / DM) + EPS); float* op_ = outp + (size_t)(m + r) * DM + lane * 8;
                *(f32x4*)(op_) = v[0][0] * rstd * g00; *(f32x4*)(op_ + 4) = v[0][1] * rstd * g01; *(f32x4*)(op_ + 512) = v[1][0] * rstd * g10; *(f32x4*)(op_ + 516) = v[1][1] * rstd * g11; }
        }
    }
#undef IN
#undef BOTH
#undef GRID_BAR
}

extern "C" void kernel_launch(void* const* d_in, const int* in_sizes, int n_in, void* d_out, int out_size, void* d_ws, size_t ws_size, hipStream_t stream) {
    static int grid = 0;
    if (grid == 0) {
        if (n_in != 28 || in_sizes[0] != NTOK * DM || out_size != NTOK * DM || ws_size < WS_END) { fprintf(stderr, "kernel_launch: unexpected shapes (n_in %d, in0 %d, out %d, ws %zu); nothing launched\n", n_in, n_in > 0 ? in_sizes[0] : -1, out_size, ws_size); grid = -1; return; }
        int dev = 0, cus = 0, per_cu = 0;
        if (hipGetDevice(&dev) != hipSuccess || hipDeviceGetAttribute(&cus, hipDeviceAttributeMultiprocessorCount, dev) != hipSuccess) { fprintf(stderr, "kernel_launch: device query failed\n"); grid = -1; return; }
        if (hipFuncSetAttribute((const void*)fwd_kernel, hipFuncAttributeMaxDynamicSharedMemorySize, LDS_BYTES) != hipSuccess) { fprintf(stderr, "kernel_launch: hipFuncSetAttribute failed\n"); grid = -1; return; }
        if (hipOccupancyMaxActiveBlocksPerMultiprocessor(&per_cu, (const void*)fwd_kernel, 512, LDS_BYTES) != hipSuccess || per_cu < 1) { fprintf(stderr, "kernel_launch: occupancy query reports %d blocks per CU\n", per_cu); }
        (void)hipGetLastError();
        grid = cus;
        if (grid > 256) grid = 256;
    }
    if (grid < 0) return;
    (void)hipMemsetAsync((char*)d_ws + WS_CTL, 0, CTL_ZERO_BYTES, stream);
    Args a{};
    for (int i = 0; i < 28; ++i) a.in[i] = d_in[i];
    a.out = (float*)d_out; a.ws = (unsigned char*)d_ws;
    if (MK_N_LAUNCHES == 1) { a.ph_lo = 0; a.ph_hi = NPHASE; hipLaunchKernelGGL(fwd_kernel, dim3(grid), dim3(512), LDS_BYTES, stream, a); }
    else for (int p = 0; p < NPHASE; ++p) { a.ph_lo = p; a.ph_hi = p + 1; hipLaunchKernelGGL(fwd_kernel, dim3(grid), dim3(512), LDS_BYTES, stream, a); }
    const hipError_t le = hipPeekAtLastError();
    if (le != hipSuccess) fprintf(stderr, "kernel_launch: launch failed: %s\n", hipGetErrorName(le));
}
```

```cpp
#include <hip/hip_runtime.h>
#include <cstdio>
#include <cstdint>
#include <type_traits>
#include <utility>

#ifndef PG8_SP2
#define PG8_SP2 1
#endif
#ifndef PG8_ALIGN_EPI
#define PG8_ALIGN_EPI 1
#endif
#ifndef MK_N_LAUNCHES
#define MK_N_LAUNCHES 1
#endif

#define GAS __attribute__((address_space(1)))
#define LAS __attribute__((address_space(3)))
typedef unsigned short bf16_t;
typedef short bf16x8 __attribute__((ext_vector_type(8)));
typedef short s16x4 __attribute__((ext_vector_type(4)));
typedef float f32x2 __attribute__((ext_vector_type(2)));
typedef float f32x4 __attribute__((ext_vector_type(4)));
typedef float f32x16 __attribute__((ext_vector_type(16)));
typedef unsigned u32x4 __attribute__((ext_vector_type(4)));
typedef unsigned u32x2 __attribute__((ext_vector_type(2)));
typedef int v4i_t __attribute__((ext_vector_type(4)));
typedef int v8i_t __attribute__((ext_vector_type(8)));
typedef GAS unsigned gu32;
#define RLX_AGENT __ATOMIC_RELAXED, __HIP_MEMORY_SCOPE_AGENT
#define LDS_WAIT() asm volatile("s_waitcnt lgkmcnt(0)" ::: "memory")
#define VM_WAIT() asm volatile("s_waitcnt vmcnt(0)" ::: "memory")

constexpr int DM = 1024, NBATCH = 16, SEQ = 4096, NTOK = NBATCH * SEQ;
constexpr int QLORA = 384, KVLORA = 256, ROPE = 32, POOLW = 512, NHEAD = 8, QKD = 96, VD = 64;
constexpr int MEMLEN = 256, NMEM = NBATCH * MEMLEN;
constexpr int NEXP = 32, EFF = 256;
constexpr int IN_COLS = 3232, IN_PAD = 3328;
constexpr float EPS = 1e-6f;
constexpr float C2Q = 0.10206207261596577f * 1.4426950408889634f;
constexpr float C2X = 0.0625f * 1.4426950408889634f;

constexpr size_t MiB = 1u << 20;
constexpr size_t WS_CTL = 0, CTL_ZERO_BYTES = 64 * 1024;
constexpr size_t WS_SMALL = 1 * MiB;
constexpr size_t OFF_SSQQ = WS_SMALL, OFF_SSQKV = OFF_SSQQ + 524288, OFF_SSQ1 = OFF_SSQKV + 524288, OFF_SSQ2 = OFF_SSQ1 + 524288, OFF_CNT = OFF_SSQ2 + 524288;
constexpr size_t SMALL_ZERO_BYTES = 4 * 524288 + 4096;
constexpr size_t WS_COS = 4 * MiB, WS_SIN = 8 * MiB;
constexpr size_t WS_WIN = 12 * MiB;
constexpr size_t WS_WQ = 19 * MiB;
constexpr size_t WS_WKVU = 20 * MiB;
constexpr size_t WS_WA = 21 * MiB, WS_WPB = 22 * MiB;
constexpr size_t WS_WMO = 23 * MiB, WS_WXKV = 27 * MiB, WS_WXO = 31 * MiB;
constexpr size_t WS_WR = 33 * MiB;
constexpr size_t WS_WGU = 34 * MiB;
constexpr size_t WS_WD = 66 * MiB;
constexpr size_t WS_MEMN = 82 * MiB, WS_KVM = 90 * MiB;
constexpr size_t WS_WIN8 = 122 * MiB;
constexpr size_t WS_WXQN = 120 * MiB;
constexpr size_t WS_BQK = 960 * MiB, WS_BVO = 992 * MiB;
constexpr size_t WS_LG = 106 * MiB;
constexpr size_t WS_S0 = 128 * MiB;
constexpr size_t WS_S1 = 256 * MiB;
constexpr size_t WS_S2 = 384 * MiB;
constexpr size_t WS_S3 = 512 * MiB;
constexpr size_t WS_S4 = 640 * MiB;
constexpr size_t WS_S5 = 768 * MiB;
constexpr size_t WS_S6 = 896 * MiB;
constexpr size_t WS_END = 1024 * MiB;
constexpr size_t WS_QLB = WS_S3, WS_KVLB = WS_S3 + 48 * MiB, WS_KRB = WS_S3 + 80 * MiB;
constexpr size_t WS_U = WS_S4, WS_DP = WS_S4 + 64 * MiB;
constexpr size_t WS_HID = WS_S4, WS_LIST = WS_S4 + 80 * MiB, WS_WL = WS_S4 + 88 * MiB, WS_RSL = WS_S4 + 96 * MiB;
constexpr size_t WS_KN = WS_S5, WS_V = WS_S5 + 64 * MiB;
constexpr size_t WS_ATT = WS_S6;

constexpr int RING_BYTES = 131072;
constexpr int MISC_OFF = RING_BYTES;
constexpr int LDS_BYTES = RING_BYTES + 24576;
constexpr int MO_BAR = 0;
constexpr int MO_HIST = 64, MO_BASE = 64 + 128;
constexpr int MO_CNTL = 1024, MO_TBASE = 1024 + 128, MO_TILEE = 2048;
constexpr int MAX_TILES = 544;
constexpr int MO_PS = 8192;

typedef __bf16 bf16x2_t __attribute__((ext_vector_type(2)));
__device__ __forceinline__ unsigned cvt_pk_bf16(float lo, float hi) { const f32x2 v = {lo, hi}; const bf16x2_t b = __builtin_convertvector(v, bf16x2_t); return __builtin_bit_cast(unsigned, b); }
__device__ __forceinline__ float bf_lo(unsigned w) { return __uint_as_float(w << 16); }
__device__ __forceinline__ float bf_hi(unsigned w) { return __uint_as_float(w & 0xffff0000u); }
__device__ __forceinline__ int lane_mb() { int l; asm volatile("v_mbcnt_lo_u32_b32 %0, -1, 0\n\tv_mbcnt_hi_u32_b32 %0, -1, %0" : "=v"(l)); return l; }
#define RELANE int tidq_ = wave * 64 + lane_mb(); asm volatile("" : "+v"(tidq_)); const int tid = tidq_, lane = tid & 63; (void)lane;
__device__ __forceinline__ void store8(bf16_t* p, const f32x4 v0, const f32x4 v1) {
    u32x4 w; w.x = cvt_pk_bf16(v0[0], v0[1]); w.y = cvt_pk_bf16(v0[2], v0[3]); w.z = cvt_pk_bf16(v1[0], v1[1]); w.w = cvt_pk_bf16(v1[2], v1[3]);
    *(u32x4*)p = w; }
__device__ __forceinline__ unsigned cvt4_fp8(float a, float b, float c, float d) { unsigned w = __float_as_uint(a);      w = __builtin_amdgcn_cvt_pk_fp8_f32(a, b, w, false); w = __builtin_amdgcn_cvt_pk_fp8_f32(c, d, w, true); return w; }
__device__ __forceinline__ void store8_fp8(unsigned char* p, const f32x4 v0, const f32x4 v1) { u32x2 w; w.x = cvt4_fp8(v0[0], v0[1], v0[2], v0[3]); w.y = cvt4_fp8(v1[0], v1[1], v1[2], v1[3]); *(u32x2*)p = w; }
__device__ __forceinline__ void unpack8_fp8(const u32x2 w, f32x4& v0, f32x4& v1) { const f32x2 a = __builtin_amdgcn_cvt_pk_f32_fp8((int)w.x, false), b = __builtin_amdgcn_cvt_pk_f32_fp8((int)w.x, true), c = __builtin_amdgcn_cvt_pk_f32_fp8((int)w.y, false), d = __builtin_amdgcn_cvt_pk_f32_fp8((int)w.y, true);
    v0 = (f32x4){a.x, a.y, b.x, b.y}; v1 = (f32x4){c.x, c.y, d.x, d.y}; }
__device__ __forceinline__ void load8(const bf16_t* p, f32x4& v0, f32x4& v1) {
    const u32x4 w = *(const u32x4*)p; v0 = (f32x4){bf_lo(w.x), bf_hi(w.x), bf_lo(w.y), bf_hi(w.y)}; v1 = (f32x4){bf_lo(w.z), bf_hi(w.z), bf_lo(w.w), bf_hi(w.w)}; }
__device__ __forceinline__ float fast_exp2(float x) { return __builtin_amdgcn_exp2f(x); }
__device__ __forceinline__ float sigmoidf_(float x) { return __builtin_amdgcn_rcpf(1.0f + fast_exp2(-1.4426950408889634f * x)); }
__device__ __forceinline__ float wave_sum(float v) {
#pragma unroll
    for (int o = 1; o < 64; o <<= 1) v += __shfl_xor(v, o);
    return v;
}

namespace pg8 {
#ifndef PG8_WGM
#define PG8_WGM 8
#endif
constexpr int BM = 256, BK = 64, HALF = 128, HTB = HALF * BK * 2, NXCD = 8, WGM = PG8_WGM;
__host__ __device__ __forceinline__ int lds_byte(int r, int c) { const int st = (r >> 4) * 2 + (c >> 5), rr = r & 15, cc = c & 31, ob = rr * 64 + cc * 2; return st * 1024 + (ob ^ (((ob >> 9) & 1) << 5)); }
__host__ __device__ __forceinline__ void stage_rc(int b, int& R, int& C) { const int st = b / 1024, sb = b % 1024, swz = sb ^ (((sb >> 9) & 1) << 5); R = (st >> 1) * 16 + swz / 64; C = (st & 1) * 32 + (swz % 64) / 2; }
__host__ __device__ __forceinline__ int perm32(int rho) { const int n = rho >> 4, i = rho & 15; return 8 * (i >> 2) + 4 * n + (i & 3); }
struct Unit { int pm, pn; };
struct StaticOrder {
    int nM, nN, nwg, G, c;
    __host__ __device__ __forceinline__ void init(int M, int N, int G_, int c_) { nM = M / BM; nN = N / BM; nwg = nM * nN; G = G_; c = c_; }
    __host__ __device__ __forceinline__ bool next(int i, Unit& u) const {
        const long L = (long)i * G + c; if (L >= nwg) return false;
        int wgid = (int)L; { const int q = nwg / NXCD, r = nwg % NXCD, xcd = wgid % NXCD, off = wgid / NXCD; wgid = (xcd < r ? xcd * (q + 1) : r * (q + 1) + (xcd - r) * q) + off; }
        const int nig = WGM * nN, gid = wgid / nig, fm = gid * WGM, gsz = (nM - fm) < WGM ? (nM - fm) : WGM;
        u.pm = fm + ((wgid % nig) % gsz); u.pn = (wgid % nig) / gsz; return true;
    }
};
struct ListOrder {
    int pm, n;
    __device__ __forceinline__ bool next(int i, Unit& u) const { if (i >= n) return false; u.pm = pm; u.pn = i; return true; }
};
template <class T, class = void> struct HasBrow : std::false_type {};
template <class T> struct HasBrow<T, std::void_t<decltype(std::declval<const T&>().brow(0))>> : std::true_type {};
template <class Op, class Sched>
__device__ __forceinline__ void gemm_phase(LAS unsigned char* lds, const Op& op, const Sched& S, const int wv_) {
    int tid_ = wv_ * 64 + lane_mb(); asm volatile("" : "+v"(tid_));
    const int tid = tid_, wid = __builtin_amdgcn_readfirstlane(tid >> 6), lane = tid & 63, wr = wid >> 2, wc = wid & 3, fr = lane & 15, fq = lane >> 4;
    const int K = op.K, nt = K / BK;
    unsigned voffA0[2], voffA1[2], voffB[2];
#pragma unroll
    for (int i = 0; i < 2; ++i) { int R, C; stage_rc(tid * 16 + i * 8192, R, C); int Rb = Op::PERM ? ((R & ~31) + perm32(R & 31)) : R; if constexpr (HasBrow<Op>::value) Rb = op.brow(Rb);
        if constexpr (!Op::GATHER) { voffA0[i] = op.a_off(R, C); voffA1[i] = 0u; } voffB[i] = (unsigned)(Rb * op.ldb + C) * 2u; }
    const size_t kstep = (size_t)(BK * 2);
    const size_t hstepB = (size_t)HALF * op.ldb * 2;
    size_t hstepA = 0; if constexpr (!Op::GATHER) hstepA = (size_t)op.a_off(HALF, 0);
    const unsigned ldsw = (unsigned)wid * 1024u;
    const int aoff = lds_byte(wr * 64 + fr, fq * 8), boff = lds_byte(wc * 32 + fr, fq * 8);
#define PG8_SA(b, h) (((b) * 2 + (h)) * HTB)
#define PG8_SB(b, h) ((4 + (b) * 2 + (h)) * HTB)
#define PG8_STAGE(bufoff, gbase, voff) do { _Pragma("unroll") for (int _i = 0; _i < 2; ++_i) \
        __builtin_amdgcn_global_load_lds((const unsigned*)((const char*)(gbase) + (voff)[_i]), (LAS unsigned*)(lds + (bufoff) + ldsw + _i * 8192), 16, 0, 0); } while (0)
#define PG8_STAGE_A1(bufoff, gbase, vg) do { if constexpr (Op::GATHER) PG8_STAGE(bufoff, gbase, vg); else PG8_STAGE(bufoff, (gbase) + hstepA, voffA0); } while (0)
#define PG8_LDA(dst, b, h) do { if constexpr (Op::FP8) { _Pragma("unroll") for (int m = 0; m < 4; ++m) dst##8[m] = __builtin_shufflevector(*(const LAS v4i_t*)(lds + PG8_SA(b, h) + aoff + m * 2048), *(const LAS v4i_t*)(lds + PG8_SA(b, h) + aoff + m * 2048 + 1024), 0, 1, 2, 3, 4, 5, 6, 7); } \
        else { _Pragma("unroll") for (int m = 0; m < 4; ++m) _Pragma("unroll") for (int k = 0; k < 2; ++k) dst[m][k] = *(const LAS bf16x8*)(lds + PG8_SA(b, h) + aoff + m * 2048 + k * 1024); } } while (0)
#define PG8_LDB(dst, b, h) do { if constexpr (Op::FP8) { _Pragma("unroll") for (int n = 0; n < 2; ++n) dst##8[n] = __builtin_shufflevector(*(const LAS v4i_t*)(lds + PG8_SB(b, h) + boff + n * 2048), *(const LAS v4i_t*)(lds + PG8_SB(b, h) + boff + n * 2048 + 1024), 0, 1, 2, 3, 4, 5, 6, 7); } \
        else { _Pragma("unroll") for (int n = 0; n < 2; ++n) _Pragma("unroll") for (int k = 0; k < 2; ++k) dst[n][k] = *(const LAS bf16x8*)(lds + PG8_SB(b, h) + boff + n * 2048 + k * 1024); } } while (0)
#define PG8_MMA(ai, bj, At, Bt) do { __builtin_amdgcn_s_setprio(1); _Pragma("unroll") for (int m = 0; m < 4; ++m) _Pragma("unroll") for (int n = 0; n < 2; ++n) _Pragma("unroll") for (int k = 0; k < 2; ++k) \
        acc[ai][bj][m][n] = __builtin_amdgcn_mfma_f32_16x16x32_bf16(Bt[n][k], At[m][k], acc[ai][bj][m][n], 0, 0, 0); __builtin_amdgcn_s_setprio(0); } while (0)
#define PG8_MMA8(ai, bj, At, Bt) do { __builtin_amdgcn_s_setprio(1); _Pragma("unroll") for (int m = 0; m < 4; ++m) _Pragma("unroll") for (int n = 0; n < 2; ++n) \
        asm volatile("v_mfma_scale_f32_16x16x128_f8f6f4 %0, %1, %2, %0, %3, %4 op_sel_hi:[0,0,0]" : "+v"(acc[ai][bj][m][n]) : "v"(Bt##8[n]), "v"(At##8[m]), "v"(sclW), "v"(sclA)); \
        __builtin_amdgcn_s_setprio(0); } while (0)
#define PG8_MMAX(ai, bj, At, Bt) do { if constexpr (Op::FP8) PG8_MMA8(ai, bj, At, Bt); else PG8_MMA(ai, bj, At, Bt); } while (0)
#define PG8_WAIT_V(n) asm volatile("s_waitcnt vmcnt(" #n ")" ::: "memory")
#define PG8_WAIT_L(n) asm volatile("s_waitcnt lgkmcnt(" #n ")" ::: "memory")
#define PG8_BAR __builtin_amdgcn_s_barrier()
#define PG8_SCHED __builtin_amdgcn_sched_barrier(0)
    Unit cur, nxt; int ui = 0;
    if (!S.next(0, cur)) return;
    unsigned nvA0[2], nvA1[2];
    if constexpr (Op::GATHER) {
#pragma unroll
        for (int i = 0; i < 2; ++i) { int R, C; stage_rc(tid * 16 + i * 8192, R, C); voffA0[i] = op.a_off_u(cur, R, C); voffA1[i] = op.a_off_u(cur, R + HALF, C); nvA0[i] = voffA0[i]; nvA1[i] = voffA1[i]; } }
    f32x4 acc[2][2][4][2];
#pragma unroll
    for (int a = 0; a < 2; ++a)
#pragma unroll
        for (int b = 0; b < 2; ++b)
#pragma unroll
            for (int m = 0; m < 4; ++m)
#pragma unroll
                for (int n = 0; n < 2; ++n) acc[a][b][m][n] = (f32x4){0.f, 0.f, 0.f, 0.f};
    int sclW = 0x7A7A7A7A, sclA = 0x7F7F7F7F; (void)sclW; (void)sclA;
    bf16x8 At[4][2], B0[2][2], B1[2][2]; v8i_t At8[4], B08[2], B18[2];
    const char* cA = op.a_base(cur); const char* cB = op.b_base(cur);
    if (PG8_SP2) {
        PG8_STAGE(PG8_SB(0, 0), cB, voffB); PG8_STAGE(PG8_SB(0, 1), cB + hstepB, voffB); PG8_STAGE(PG8_SA(0, 0), cA, voffA0); PG8_STAGE_A1(PG8_SA(0, 1), cA, voffA1);
        if (wr == 1) PG8_BAR;
        PG8_WAIT_V(2); PG8_BAR;
        PG8_STAGE(PG8_SB(1, 0), cB + kstep, voffB); PG8_STAGE(PG8_SA(1, 0), cA + kstep, voffA0); PG8_STAGE(PG8_SB(1, 1), cB + hstepB + kstep, voffB);
        PG8_WAIT_V(6); PG8_BAR;
    } else {
    PG8_STAGE(PG8_SB(0, 0), cB, voffB); PG8_STAGE(PG8_SA(0, 0), cA, voffA0); PG8_STAGE(PG8_SB(0, 1), cB + hstepB, voffB); PG8_STAGE_A1(PG8_SA(0, 1), cA, voffA1);
    if (wr == 1) PG8_BAR;
    PG8_WAIT_V(4); PG8_BAR;
    PG8_STAGE(PG8_SB(1, 0), cB + kstep, voffB); PG8_STAGE(PG8_SA(1, 0), cA + kstep, voffA0); PG8_STAGE(PG8_SB(1, 1), cB + hstepB + kstep, voffB);
    PG8_WAIT_V(6); PG8_BAR;
    }
    for (;;) {
        const bool has_next = S.next(ui + 1, nxt);
        const char* nA = has_next ? op.a_base(nxt) : cA; const char* nB = has_next ? op.b_base(nxt) : cB;
        if constexpr (Op::GATHER) { if (has_next) {
#pragma unroll
            for (int i = 0; i < 2; ++i) { int R, C; stage_rc(tid * 16 + i * 8192, R, C); nvA0[i] = op.a_off_u(nxt, R, C); nvA1[i] = op.a_off_u(nxt, R + HALF, C); } } }
        for (int t = 0; t < nt; t += 2) {
            const bool last = (t == nt - 2);
            if constexpr (Op::GATHER) asm volatile("" : "+v"(voffA1[0]), "+v"(voffA1[1]));
            asm volatile("" : "+v"(voffA0[0]), "+v"(voffA0[1]), "+v"(voffB[0]), "+v"(voffB[1]));
            const char* a1 = cA + (size_t)(t + 1) * kstep;
            const char* a2 = last ? nA : cA + (size_t)(t + 2) * kstep; const char* b2 = last ? nB : cB + (size_t)(t + 2) * kstep;
            const char* a3 = a2 + kstep; const char* b3 = b2 + kstep;
            unsigned sA0[2], sA1[2];
#pragma unroll
            for (int i = 0; i < 2; ++i) { if constexpr (Op::GATHER) { sA0[i] = last ? nvA0[i] : voffA0[i]; sA1[i] = last ? nvA1[i] : voffA1[i]; } else { sA0[i] = voffA0[i]; sA1[i] = voffA1[i]; } }
            if (PG8_SP2) {
            const bool fresh = (t == 0) && (ui > 0);
            PG8_LDB(B0, 0, 0); PG8_LDB(B1, 0, 1); PG8_SCHED; PG8_LDA(At, 0, 0); if (!fresh) PG8_STAGE_A1(PG8_SA(1, 1), a1, voffA1);
            if (!fresh) PG8_WAIT_V(8); PG8_WAIT_L(0); PG8_BAR; PG8_MMAX(0, 0, At, B0); PG8_MMAX(0, 1, At, B1); PG8_BAR; PG8_SCHED;
            PG8_LDA(At, 0, 1); PG8_STAGE(PG8_SB(0, 0), b2, voffB); PG8_STAGE(PG8_SB(0, 1), b2 + hstepB, voffB); PG8_STAGE(PG8_SA(0, 0), a2, sA0);
            if (!fresh) PG8_WAIT_V(8); PG8_WAIT_L(0); PG8_BAR; PG8_MMAX(1, 0, At, B0); PG8_MMAX(1, 1, At, B1); PG8_BAR; PG8_SCHED;
            PG8_LDB(B0, 1, 0); PG8_LDB(B1, 1, 1); PG8_SCHED; PG8_LDA(At, 1, 0); PG8_STAGE_A1(PG8_SA(0, 1), a2, sA1);
            if (!fresh) PG8_WAIT_V(8); PG8_WAIT_L(0); PG8_BAR; PG8_MMAX(0, 0, At, B0); PG8_MMAX(0, 1, At, B1); PG8_BAR; PG8_SCHED;
            PG8_LDA(At, 1, 1); PG8_STAGE(PG8_SB(1, 0), b3, voffB); PG8_STAGE(PG8_SB(1, 1), b3 + hstepB, voffB); PG8_STAGE(PG8_SA(1, 0), a3, sA0);
            if (!fresh) PG8_WAIT_V(8); PG8_WAIT_L(0); PG8_BAR; PG8_MMAX(1, 0, At, B0); PG8_MMAX(1, 1, At, B1); PG8_BAR; PG8_SCHED;
            } else {
            PG8_LDB(B0, 0, 0); PG8_SCHED; PG8_LDA(At, 0, 0); PG8_STAGE_A1(PG8_SA(1, 1), a1, voffA1);
            PG8_WAIT_L(8); PG8_BAR; PG8_WAIT_L(0); PG8_MMAX(0, 0, At, B0); PG8_BAR; PG8_SCHED;
            PG8_LDB(B1, 0, 1); PG8_STAGE(PG8_SB(0, 0), b2, voffB);
            PG8_BAR; PG8_WAIT_L(0); PG8_MMAX(0, 1, At, B1); PG8_BAR;
            PG8_LDA(At, 0, 1); PG8_STAGE(PG8_SA(0, 0), a2, sA0);
            PG8_BAR; PG8_WAIT_L(0); PG8_MMAX(1, 0, At, B0); PG8_BAR; PG8_SCHED;
            PG8_STAGE(PG8_SB(0, 1), b2 + hstepB, voffB);
            PG8_WAIT_V(6); PG8_BAR; PG8_MMAX(1, 1, At, B1); PG8_BAR;
            PG8_LDB(B0, 1, 0); PG8_SCHED; PG8_LDA(At, 1, 0); PG8_STAGE_A1(PG8_SA(0, 1), a2, sA1);
            PG8_WAIT_L(8); PG8_BAR; PG8_WAIT_L(0); PG8_MMAX(0, 0, At, B0); PG8_BAR; PG8_SCHED;
            PG8_LDB(B1, 1, 1); PG8_STAGE(PG8_SB(1, 0), b3, voffB);
            PG8_BAR; PG8_WAIT_L(0); PG8_MMAX(0, 1, At, B1); PG8_BAR;
            PG8_LDA(At, 1, 1); PG8_STAGE(PG8_SA(1, 0), a3, sA0);
            PG8_BAR; PG8_WAIT_L(0); PG8_MMAX(1, 0, At, B0); PG8_BAR; PG8_SCHED;
            PG8_STAGE(PG8_SB(1, 1), b3 + hstepB, voffB);
            PG8_WAIT_V(6); PG8_BAR; PG8_MMAX(1, 1, At, B1); PG8_BAR;
            }
        }
        if constexpr (Op::FP8) asm volatile("s_nop 15\n\ts_nop 15" ::: "memory");
        if (PG8_ALIGN_EPI) { if (wr == 0) PG8_BAR; }
        if (PG8_SP2 && PG8_ALIGN_EPI && has_next) {
            if constexpr (Op::GATHER) { PG8_STAGE_A1(PG8_SA(1, 1), nA + kstep, nvA1); } else { PG8_STAGE_A1(PG8_SA(1, 1), nA + kstep, voffA1); } }
        {
          int lane_e = (int)__builtin_amdgcn_mbcnt_hi(~0u, __builtin_amdgcn_mbcnt_lo(~0u, 0u)); asm volatile("" : "+v"(lane_e));
          const int src_ = ((((lane_e & 3) << 4) | (lane_e >> 2)) << 2);
#pragma unroll
          for (int a = 0; a < 2; ++a)
#pragma unroll
              for (int b = 0; b < 2; ++b)
#pragma unroll
                  for (int m = 0; m < 4; ++m)
#pragma unroll
                      for (int n = 0; n < 2; ++n)
#pragma unroll
                          for (int j = 0; j < 4; ++j) acc[a][b][m][n][j] = __int_as_float(__builtin_amdgcn_ds_bpermute(src_, __float_as_int(acc[a][b][m][n][j])));
          if (PG8_SP2 && PG8_ALIGN_EPI) PG8_WAIT_V(0);
          op.epi(acc, cur, wr, wc, lane_e >> 2, lane_e & 3); }
        if (!has_next) break;
#pragma unroll
        for (int a = 0; a < 2; ++a)
#pragma unroll
            for (int b = 0; b < 2; ++b)
#pragma unroll
                for (int m = 0; m < 4; ++m)
#pragma unroll
                    for (int n = 0; n < 2; ++n) acc[a][b][m][n] = (f32x4){0.f, 0.f, 0.f, 0.f};
        cur = nxt; cA = nA; cB = nB; ++ui;
        if constexpr (Op::GATHER) {
#pragma unroll
            for (int i = 0; i < 2; ++i) { voffA0[i] = nvA0[i]; voffA1[i] = nvA1[i]; } }
        if (PG8_ALIGN_EPI) { if (wr == 1) PG8_BAR; }
    }
    PG8_WAIT_V(0);
    if (!PG8_ALIGN_EPI) { if (wr == 0) PG8_BAR; }
    PG8_BAR;
#undef PG8_SA
#undef PG8_SB
#undef PG8_STAGE
#undef PG8_LDA
#undef PG8_STAGE_A1
#undef PG8_LDB
#undef PG8_MMA
#undef PG8_MMA8
#undef PG8_MMAX
#undef PG8_WAIT_V
#undef PG8_WAIT_L
#undef PG8_BAR
#undef PG8_SCHED
}
}
using pg8::Unit;
typedef f32x4 Acc[2][2][4][2];

struct RopeCS { f32x4 c0, c1, s0, s1; };
__device__ __forceinline__ RopeCS rope_load(const float* cosT, const float* sinT, int row, int fq) { const int i0 = 8 * (fq & 1); RopeCS r;
    r.c0 = *(const f32x4*)(cosT + (size_t)row * 16 + i0); r.c1 = *(const f32x4*)(cosT + (size_t)row * 16 + i0 + 4); r.s0 = *(const f32x4*)(sinT + (size_t)row * 16 + i0); r.s1 = *(const f32x4*)(sinT + (size_t)row * 16 + i0 + 4); return r; }
__device__ __forceinline__ void rope_apply(f32x4& v0, f32x4& v1, const RopeCS& r, int fq) {
    f32x4 p0, p1;
#pragma unroll
    for (int j = 0; j < 4; ++j) { p0[j] = __shfl_xor(v0[j], 2); p1[j] = __shfl_xor(v1[j], 2); }
    if (fq < 2) { v0 = v0 * r.c0 - p0 * r.s0; v1 = v1 * r.c1 - p1 * r.s1; } else { v0 = v0 * r.c0 + p0 * r.s0; v1 = v1 * r.c1 + p1 * r.s1; }
}
__device__ __forceinline__ void rope8(f32x4& v0, f32x4& v1, const float* cosT, const float* sinT, int row, int fq) {
    f32x4 p0, p1;
#pragma unroll
    for (int j = 0; j < 4; ++j) { p0[j] = __shfl_xor(v0[j], 2); p1[j] = __shfl_xor(v1[j], 2); }
    const int i0 = 8 * (fq & 1);
    const f32x4 c0 = *(const f32x4*)(cosT + (size_t)row * 16 + i0), c1 = *(const f32x4*)(cosT + (size_t)row * 16 + i0 + 4);
    const f32x4 s0 = *(const f32x4*)(sinT + (size_t)row * 16 + i0), s1 = *(const f32x4*)(sinT + (size_t)row * 16 + i0 + 4);
    if (fq < 2) { v0 = v0 * c0 - p0 * s0; v1 = v1 * c1 - p1 * s1; }
    else        { v0 = v0 * c0 + p0 * s0; v1 = v1 * c1 + p1 * s1; }
}
__device__ __forceinline__ float ssq8(const f32x4 v0, const f32x4 v1) { return (v0[0] * v0[0] + v0[1] * v0[1]) + (v0[2] * v0[2] + v0[3] * v0[3]) + (v1[0] * v1[0] + v1[1] * v1[1]) + (v1[2] * v1[2] + v1[3] * v1[3]); }
typedef unsigned long long u64;
constexpr float FX_SCALE = 16777216.0f, FX_INV = 1.0f / 16777216.0f;
__device__ __forceinline__ void row_atomic_add(u64* p, float s, int fq) { s += __shfl_xor(s, 1); s += __shfl_xor(s, 2); if (fq == 0) __hip_atomic_fetch_add(p, (u64)(s * FX_SCALE + 0.5f), RLX_AGENT); }
__device__ __forceinline__ float fx_load(const u64* p) { return (float)(*p) * FX_INV; }

#ifndef EPI_FENCE
#define EPI_FENCE
#endif
#define RT_(ai, m) ((ai) * 128 + wr * 64 + (m) * 16 + fr)
#define FOR_AI _Pragma("unroll") for (int ai = 0; ai < 2; ++ai)
#define FOR_M _Pragma("unroll") for (int m = 0; m < 4; ++m)
#define FOR_BJ _Pragma("unroll") for (int bj = 0; bj < 2; ++bj)
__device__ __forceinline__ void unpack8(const u32x4 w, f32x4& v0, f32x4& v1) { v0 = (f32x4){bf_lo(w.x), bf_hi(w.x), bf_lo(w.y), bf_hi(w.y)}; v1 = (f32x4){bf_lo(w.z), bf_hi(w.z), bf_lo(w.w), bf_hi(w.w)}; }
#define EPI_ROWS(...) _Pragma("unroll") for (int ai = 0; ai < 2; ++ai) _Pragma("unroll") for (int m = 0; m < 4; ++m) { const int rt = ai * 128 + wr * 64 + m * 16 + fr; __VA_ARGS__ EPI_FENCE }

template <bool F8> struct OpInT {
    static constexpr bool PERM = true, GATHER = false, FP8 = F8;
    const bf16_t* A; const bf16_t* Bt; int K, lda, ldb;
    bf16_t *QLb, *KVLb, *KRb, *U, *GA, *GB; u64 *ssq_q, *ssq_kv; const float *cosT, *sinT;
    __device__ __forceinline__ unsigned a_off(int r, int c) const { return (unsigned)(r * lda + c) * 2u; }
    __device__ __forceinline__ const char* a_base(const Unit& u) const { return (const char*)(A + (size_t)u.pm * 256 * lda); }
    __device__ __forceinline__ const char* b_base(const Unit& u) const { return (const char*)(Bt + (size_t)u.pn * 256 * ldb); }
    __device__ __forceinline__ void epi(const Acc& acc, const Unit& u, int wr, int wc, int fr, int fq) const {
        const int row0 = u.pm * 256, col = 32 * wc + 8 * fq;
#pragma unroll
        for (int bj = 0; bj < 2; ++bj) {
            const int hc = u.pn * 2 + bj;
            if (hc < 5) {
                u64* ssq = hc < 3 ? ssq_q : ssq_kv;
                if constexpr (F8) {
                    unsigned char* dst = hc < 3 ? (unsigned char*)QLb + hc * 128 : (unsigned char*)KVLb + (hc - 3) * 128; const int pitch = hc < 3 ? 512 : 256;
                    EPI_ROWS( const int row = row0 + rt; const f32x4 v0 = acc[ai][bj][m][0], v1 = acc[ai][bj][m][1];
                        row_atomic_add(ssq + row, ssq8(v0, v1), fq); store8_fp8(dst + (size_t)row * pitch + col, v0, v1);
                        if (hc == 2) *(u32x2*)(dst + (size_t)row * pitch + col + 128) = (u32x2){0u, 0u}; )
                } else {
                bf16_t* dst = hc < 3 ? QLb + hc * 128 : KVLb + (hc - 3) * 128; const int pitch = hc < 3 ? QLORA : KVLORA;
                EPI_ROWS( const int row = row0 + rt; const f32x4 v0 = acc[ai][bj][m][0], v1 = acc[ai][bj][m][1];
                    row_atomic_add(ssq + row, ssq8(v0, v1), fq); store8(dst + (size_t)row * pitch + col, v0, v1); )
                }
            } else if (hc == 5) {
                if (wc == 0) { FOR_AI { RopeCS cs[4]; FOR_M cs[m] = rope_load(cosT, sinT, row0 + RT_(ai, m), fq);
                    FOR_M { const int row = row0 + RT_(ai, m); f32x4 v0 = acc[ai][bj][m][0], v1 = acc[ai][bj][m][1]; rope_apply(v0, v1, cs[m], fq);
                        if constexpr (F8) store8_fp8((unsigned char*)KRb + (size_t)row * ROPE + col, v0, v1);
                        else store8(KRb + (size_t)row * ROPE + col, v0, v1); } } }
            } else if (hc < 10) {
                bf16_t* dst = U + (hc - 6) * 128;
                EPI_ROWS( const int row = row0 + rt; store8(dst + (size_t)row * POOLW + col, acc[ai][bj][m][0], acc[ai][bj][m][1]); )
            } else {
                bf16_t* dst = hc < 18 ? GA + (hc - 10) * 128 : GB + (hc - 18) * 128;
                EPI_ROWS( const int row = row0 + rt; f32x4 v0 = acc[ai][bj][m][0], v1 = acc[ai][bj][m][1];
                    _Pragma("unroll") for (int j = 0; j < 4; ++j) { v0[j] = sigmoidf_(v0[j]); v1[j] = sigmoidf_(v1[j]); }
                    store8(dst + (size_t)row * DM + col, v0, v1); )
            }
        }
    }
};
typedef OpInT<false> OpIn; typedef OpInT<true> OpIn8;
struct OpGate8 {
    static constexpr bool PERM = true, GATHER = false, FP8 = true;
    const bf16_t* A; const bf16_t* Bt; int K, lda, ldb;
    bf16_t *GA, *GB;
    __device__ __forceinline__ unsigned a_off(int r, int c) const { return (unsigned)(r * lda + c) * 2u; }
    __device__ __forceinline__ const char* a_base(const Unit& u) const { return (const char*)(A + (size_t)u.pm * 256 * lda); }
    __device__ __forceinline__ const char* b_base(const Unit& u) const { return (const char*)(Bt + (size_t)u.pn * 256 * ldb); }
    __device__ __forceinline__ void epi(const Acc& acc, const Unit& u, int wr, int wc, int fr, int fq) const {
        const size_t off = (size_t)u.pm * 256 * DM + ((u.pn - 5) & 3) * 256 + 32 * wc + 8 * fq;
        FOR_AI FOR_M FOR_BJ { f32x4 v0 = acc[ai][bj][m][0], v1 = acc[ai][bj][m][1];
            _Pragma("unroll") for (int j = 0; j < 4; ++j) { v0[j] = sigmoidf_(v0[j]); v1[j] = sigmoidf_(v1[j]); }
            if (u.pn < 9) store8_fp8((unsigned char*)GA + off + (size_t)RT_(ai, m) * DM + bj * 128, v0 * 256.f, v1 * 256.f);
            else store8(GB + off + (size_t)RT_(ai, m) * DM + bj * 128, v0, v1); }
    }
};
struct OffsetOrder { pg8::StaticOrder s; int off; __device__ __forceinline__ bool next(int i, Unit& u) const { if (!s.next(i, u)) return false; u.pn += off; return true; } };
struct OpPlain {
    static constexpr bool PERM = true, GATHER = false, FP8 = false;
    const bf16_t* A; const bf16_t* Bt; int K, lda, ldb;
    bf16_t* O; int ldo;
    __device__ __forceinline__ unsigned a_off(int r, int c) const { return (unsigned)(r * lda + c) * 2u; }
    __device__ __forceinline__ const char* a_base(const Unit& u) const { return (const char*)(A + (size_t)u.pm * 256 * lda); }
    __device__ __forceinline__ const char* b_base(const Unit& u) const { return (const char*)(Bt + (size_t)u.pn * 256 * ldb); }
    __device__ __forceinline__ void epi(const Acc& acc, const Unit& u, int wr, int wc, int fr, int fq) const {
        bf16_t* base = O + (size_t)u.pm * 256 * ldo + u.pn * 256 + 32 * wc + 8 * fq;
        EPI_ROWS( _Pragma("unroll") for (int bj = 0; bj < 2; ++bj) store8(base + (size_t)rt * ldo + bj * 128, acc[ai][bj][m][0], acc[ai][bj][m][1]); )
    }
};
__device__ __forceinline__ int key_of_slot(int sl) { const int hi = sl >> 5, j = sl & 31, jj = j & 15; return ((j >> 4) << 5) + (jj & 3) + 8 * (jj >> 2) + 4 * hi; }
struct OpQ {
    static constexpr bool PERM = true, GATHER = false, FP8 = true;
    const bf16_t* A; const bf16_t* Bt; int K, lda, ldb;
    unsigned char* Q  ; const u64* ssq_q; const float *cosT, *sinT;
    __device__ __forceinline__ unsigned a_off(int r, int c) const { return (unsigned)(r * lda + c) * 2u; }
    __device__ __forceinline__ const char* a_base(const Unit& u) const { return (const char*)(A + (size_t)u.pm * 256 * lda); }
    __device__ __forceinline__ const char* b_base(const Unit& u) const { return (const char*)(Bt + (size_t)u.pn * 256 * ldb); }
    __device__ __forceinline__ void epi(const Acc& acc, const Unit& u, int wr, int wc, int fr, int fq) const {
        float rs[2][4]; FOR_AI FOR_M rs[ai][m] = fx_load(ssq_q + u.pm * 256 + RT_(ai, m));
        FOR_AI FOR_M rs[ai][m] = 16.f * C2Q * __builtin_amdgcn_rsqf(rs[ai][m] * (1.0f / QLORA) + EPS);
        const int g0 = u.pn * 8 + wc; const bool rp0 = (g0 % 3 == 2), rp1 = ((g0 + 4) % 3 == 2);
        FOR_AI _Pragma("unroll") for (int m0 = 0; m0 < 4; m0 += 2) { RopeCS cs[2]; if (rp0 || rp1) { _Pragma("unroll") for (int mi = 0; mi < 2; ++mi) cs[mi] = rope_load(cosT, sinT, u.pm * 256 + RT_(ai, m0 + mi), fq); }
            _Pragma("unroll") for (int mi = 0; mi < 2; ++mi) { const int m = m0 + mi; const int row = u.pm * 256 + RT_(ai, m);
                FOR_BJ { const int g32 = g0 + bj * 4; f32x4 v0 = acc[ai][bj][m][0] * rs[ai][m], v1 = acc[ai][bj][m][1] * rs[ai][m];
                    if (bj == 0 ? rp0 : rp1) rope_apply(v0, v1, cs[mi], fq);
                    unsigned char* qd = Q + (size_t)row * 1024 + (g32 / 3) * 128 + (g32 % 3) * 32 + 8 * fq; store8_fp8(qd, v0, v1); if (bj == 0 ? rp0 : rp1) *(u32x2*)(qd + 32) = (u32x2){0u, 0u}; } } }
    }
};
struct OpK8 {
    static constexpr bool PERM = true, GATHER = false, FP8 = true;
    const bf16_t* A; const bf16_t* Bt; int K, lda, ldb;
    unsigned char* K8; const u64* ssq_kv;
    __device__ __forceinline__ unsigned a_off(int r, int c) const { return (unsigned)(r * lda + c) * 2u; }
    __device__ __forceinline__ const char* a_base(const Unit& u) const { return (const char*)(A + (size_t)u.pm * 256 * lda); }
    __device__ __forceinline__ const char* b_base(const Unit& u) const { return (const char*)(Bt + (size_t)u.pn * 256 * ldb); }
    __device__ __forceinline__ void epi(const Acc& acc, const Unit& u, int wr, int wc, int fr, int fq) const {
        float rs[2][4]; FOR_AI FOR_M rs[ai][m] = fx_load(ssq_kv + u.pm * 256 + RT_(ai, m));
        FOR_AI FOR_M { const int row = u.pm * 256 + RT_(ai, m); const float r_ = __builtin_amdgcn_rsqf(rs[ai][m] * (1.0f / KVLORA) + EPS);
            FOR_BJ { const int col = u.pn * 256 + bj * 128 + 32 * wc + 8 * fq; store8_fp8(K8 + (size_t)row * 512 + col, acc[ai][bj][m][0] * r_, acc[ai][bj][m][1] * r_); } }
    }
};
struct OpVT {
    static constexpr bool PERM = true, GATHER = false, FP8 = true;
    const bf16_t* A; const bf16_t* Bt; int K, lda, ldb;
    unsigned char* VT8; const u64* ssq_kv;
    __device__ __forceinline__ int brow(int c) const { return (c & ~63) + key_of_slot(c & 63); }
    __device__ __forceinline__ unsigned a_off(int r, int c) const { return (unsigned)(r * lda + c) * 2u; }
    __device__ __forceinline__ const char* a_base(const Unit& u) const { return (const char*)(A + (size_t)u.pm * 256 * lda); }
    __device__ __forceinline__ const char* b_base(const Unit& u) const { return (const char*)(Bt + (size_t)u.pn * 256 * ldb); }
    __device__ __forceinline__ void epi(const Acc& acc, const Unit& u, int wr, int wc, int fr, int fq) const {
        float rs[2][2][4];
        FOR_BJ _Pragma("unroll") for (int n = 0; n < 2; ++n) _Pragma("unroll") for (int j = 0; j < 4; ++j) { const int c = bj * 128 + 32 * wc + 8 * fq + 4 * n + j; rs[bj][n][j] = fx_load(ssq_kv + u.pn * 256 + (c & ~63) + key_of_slot(c & 63)); }
        FOR_BJ _Pragma("unroll") for (int n = 0; n < 2; ++n) _Pragma("unroll") for (int j = 0; j < 4; ++j) rs[bj][n][j] = __builtin_amdgcn_rsqf(rs[bj][n][j] * (1.0f / KVLORA) + EPS);
        FOR_AI FOR_M FOR_BJ { f32x4 v0 = acc[ai][bj][m][0], v1 = acc[ai][bj][m][1];
            _Pragma("unroll") for (int j = 0; j < 4; ++j) { v0[j] *= rs[bj][0][j]; v1[j] *= rs[bj][1][j]; }
            const size_t grp = (size_t)u.pn * 4 + 2 * bj + (wc >> 1);
            store8_fp8(VT8 + (grp * 512 + u.pm * 256 + RT_(ai, m)) * 64 + (wc & 1) * 32 + 8 * fq, v0, v1); }
    }
};
struct OpYB {
    static constexpr bool PERM = true, GATHER = false, FP8 = false;
    const bf16_t* A; const bf16_t* Bt; int K, lda, ldb;
    bf16_t* GBM;
    __device__ __forceinline__ unsigned a_off(int r, int c) const { return (unsigned)(r * lda + c) * 2u; }
    __device__ __forceinline__ const char* a_base(const Unit& u) const { return (const char*)(A + (size_t)u.pm * 256 * lda); }
    __device__ __forceinline__ const char* b_base(const Unit& u) const { return (const char*)(Bt + (size_t)u.pn * 256 * ldb); }
    __device__ __forceinline__ void epi(const Acc& acc, const Unit& u, int wr, int wc, int fr, int fq) const {
        bf16_t* base = GBM + (size_t)u.pm * 256 * DM + u.pn * 256 + 32 * wc + 8 * fq;
        u32x4 gb[2][4][2]; FOR_AI FOR_M FOR_BJ gb[ai][m][bj] = *(const u32x4*)(base + (size_t)RT_(ai, m) * DM + bj * 128);
        FOR_AI FOR_M FOR_BJ { f32x4 g0, g1; unpack8(gb[ai][m][bj], g0, g1); store8(base + (size_t)RT_(ai, m) * DM + bj * 128, g0 * acc[ai][bj][m][0], g1 * acc[ai][bj][m][1]); }
    }
};
struct OpYA {
    static constexpr bool PERM = true, GATHER = false, FP8 = true;
    const bf16_t* A; const bf16_t* Bt; int K, lda, ldb;
    const bf16_t* GA; bf16_t* MB; unsigned char* M8;
    __device__ __forceinline__ unsigned a_off(int r, int c) const { return (unsigned)(r * lda + c) * 2u; }
    __device__ __forceinline__ const char* a_base(const Unit& u) const { return (const char*)(A + (size_t)u.pm * 256 * lda); }
    __device__ __forceinline__ const char* b_base(const Unit& u) const { return (const char*)(Bt + (size_t)u.pn * 256 * ldb); }
    __device__ __forceinline__ void epi(const Acc& acc, const Unit& u, int wr, int wc, int fr, int fq) const {
        const size_t off0 = (size_t)u.pm * 256 * DM + u.pn * 256 + 32 * wc + 8 * fq;
        FOR_AI { u32x2 ga[4][2]; u32x4 mb[4][2]; FOR_M FOR_BJ { const size_t off = off0 + (size_t)RT_(ai, m) * DM + bj * 128; ga[m][bj] = *(const u32x2*)((const unsigned char*)GA + off); mb[m][bj] = *(const u32x4*)(MB + off); }
            FOR_M FOR_BJ { const size_t off = off0 + (size_t)RT_(ai, m) * DM + bj * 128; f32x4 g0, g1, b0, b1; unpack8_fp8(ga[m][bj], g0, g1); unpack8(mb[m][bj], b0, b1);
                store8_fp8(M8 + off, (g0 * (acc[ai][bj][m][0] * (0.0625f / 256.f)) + b0) * 4.f, (g1 * (acc[ai][bj][m][1] * (0.0625f / 256.f)) + b1) * 4.f); } }
    }
};
template <bool BASE_F32, bool F8 = false> struct OpRes {
    static constexpr bool PERM = true, GATHER = false, FP8 = F8;
    const bf16_t* A; const bf16_t* Bt; int K, lda, ldb;
    const void* base; bf16_t* Hout; u64* ssq; size_t bbatch;
    unsigned char* H8; float ascale;
    __device__ __forceinline__ unsigned a_off(int r, int c) const { return (unsigned)(r * lda + c) * 2u; }
    __device__ __forceinline__ const char* a_base(const Unit& u) const { return (const char*)(A + (size_t)u.pm * 256 * lda); }
    __device__ __forceinline__ const char* b_base(const Unit& u) const { return (const char*)(Bt + (size_t)(u.pm >> 4) * bbatch + (size_t)u.pn * 256 * ldb); }
    __device__ __forceinline__ void epi(const Acc& acc, const Unit& u, int wr, int wc, int fr, int fq) const {
        const size_t off0 = (size_t)u.pm * 256 * DM + u.pn * 256 + 32 * wc + 8 * fq;
        constexpr int MB_ = BASE_F32 ? 2 : 4;
        FOR_AI _Pragma("unroll") for (int m0 = 0; m0 < 4; m0 += MB_) { f32x4 bv[MB_][2][2];
            _Pragma("unroll") for (int mi = 0; mi < MB_; ++mi) FOR_BJ { const size_t off = off0 + (size_t)RT_(ai, m0 + mi) * DM + bj * 128;
                if (BASE_F32) { bv[mi][bj][0] = *(const f32x4*)((const float*)base + off); bv[mi][bj][1] = *(const f32x4*)((const float*)base + off + 4); } else load8((const bf16_t*)base + off, bv[mi][bj][0], bv[mi][bj][1]); }
            _Pragma("unroll") for (int mi = 0; mi < MB_; ++mi) { const int m = m0 + mi; float s = 0.f;
                FOR_BJ { const size_t off = off0 + (size_t)RT_(ai, m) * DM + bj * 128; const f32x4 h0 = bv[mi][bj][0] + acc[ai][bj][m][0] * ascale, h1 = bv[mi][bj][1] + acc[ai][bj][m][1] * ascale; s += ssq8(h0, h1); store8(Hout + off, h0, h1); if (H8) store8_fp8(H8 + off, h0, h1); }
                row_atomic_add(ssq + u.pm * 256 + RT_(ai, m), s, fq); }
            asm volatile("" ::: "memory"); }
    }
};
struct OpPre {
    static constexpr bool PERM = true, GATHER = false, FP8 = false;
    const bf16_t* KVM; const bf16_t* W; int K, lda, ldb; unsigned char* O; int mode;
    __device__ __forceinline__ unsigned a_off(int r, int c) const { return (unsigned)(r * lda + c) * 2u; }
    __device__ __forceinline__ const char* a_base(const Unit& u) const { return mode == 0 ? (const char*)(KVM + (size_t)(u.pm >> 2) * 256 * 2048 + (u.pm & 3) * 256) : (const char*)(W + (size_t)(u.pm & 3) * 256 * DM + u.pn * 256); }
    __device__ __forceinline__ const char* b_base(const Unit& u) const { return mode == 0 ? (const char*)(W + (size_t)u.pn * 256 * DM + (u.pm & 3) * 256) : (const char*)(KVM + (size_t)(u.pm >> 2) * 256 * 2048 + DM + u.pn * 256); }
    __device__ __forceinline__ void epi(const Acc& acc, const Unit& u, int wr, int wc, int fr, int fq) const {
        unsigned char* base = O + (size_t)u.pm * 256 * DM + u.pn * 256 + 32 * wc + 8 * fq;
        FOR_AI FOR_M FOR_BJ store8_fp8(base + (size_t)RT_(ai, m) * DM + bj * 128, acc[ai][bj][m][0] * 32.f, acc[ai][bj][m][1] * 32.f);
    }
};
struct OpSX {
    static constexpr bool PERM = true, GATHER = false, FP8 = true;
    const bf16_t* A; const bf16_t* BQK; int K, lda, ldb;
    unsigned char* P; const u64* ssq1; LAS f32x4* ps;
    __device__ __forceinline__ unsigned a_off(int r, int c) const { return (unsigned)(r * lda + c) * 2u; }
    __device__ __forceinline__ const char* a_base(const Unit& u) const { return (const char*)(A + (size_t)u.pm * 256 * lda); }
    __device__ __forceinline__ const char* b_base(const Unit& u) const { return (const char*)(BQK + ((size_t)(u.pm >> 4) * DM + u.pn * 256) * ldb); }
    __device__ __forceinline__ void epi(Acc& acc, const Unit& u, int wr, int wc, int fr, int fq) const {
        float rs[2][4]; FOR_AI FOR_M rs[ai][m] = fx_load(ssq1 + u.pm * 256 + RT_(ai, m));
        FOR_AI FOR_M { const float r_ = C2X * __builtin_amdgcn_rsqf(rs[ai][m] * (1.0f / DM) + EPS); float s = 0.f;
            FOR_BJ { _Pragma("unroll") for (int n = 0; n < 2; ++n) _Pragma("unroll") for (int j = 0; j < 4; ++j) { const float e = fast_exp2(acc[ai][bj][m][n][j] * r_); acc[ai][bj][m][n][j] = e; s += e; } }
            s += __shfl_xor(s, 1); s += __shfl_xor(s, 2);
            if (fq == 0) ((LAS float*)(ps + RT_(ai, m)))[wc] = s; }
        asm volatile("s_waitcnt lgkmcnt(0)\n\ts_barrier" ::: "memory");
        unsigned char* base = P + (size_t)u.pm * 256 * DM + u.pn * 256 + 32 * wc + 8 * fq;
        FOR_AI FOR_M { const f32x4 q = ps[RT_(ai, m)]; const float inv = 256.f * __builtin_amdgcn_rcpf((q[0] + q[1]) + (q[2] + q[3]));
            FOR_BJ store8_fp8(base + (size_t)RT_(ai, m) * DM + bj * 128, acc[ai][bj][m][0] * inv, acc[ai][bj][m][1] * inv); }
    }
};
struct OpR {
    static constexpr bool PERM = false, GATHER = false, FP8 = false;
    const bf16_t* A; const bf16_t* Bt; int K, lda, ldb;
    float* LG; const u64* ssq2;
    __device__ __forceinline__ unsigned a_off(int r, int c) const { return (unsigned)(r * lda + c) * 2u; }
    __device__ __forceinline__ const char* a_base(const Unit& u) const { return (const char*)(A + (size_t)u.pm * 256 * lda); }
    __device__ __forceinline__ const char* b_base(const Unit& u) const { return (const char*)(Bt + (size_t)u.pn * 256 * ldb); }
    __device__ __forceinline__ void epi(const Acc& acc, const Unit& u, int wr, int wc, int fr, int fq) const {
        if (wc > 1) return;
        float rs[2][4]; FOR_AI FOR_M rs[ai][m] = fx_load(ssq2 + u.pm * 256 + RT_(ai, m));
        FOR_AI FOR_M { const int row = u.pm * 256 + RT_(ai, m); const float r_ = __builtin_amdgcn_rsqf(rs[ai][m] * (1.0f / DM) + EPS); float* lg = LG + (size_t)row * 40;
            if (wc == 0) { *(f32x4*)(lg + 4 * fq) = acc[ai][0][m][0] * r_; *(f32x4*)(lg + 16 + 4 * fq) = acc[ai][0][m][1] * r_; }
            else if (fq == 0) { *(f32x4*)(lg + 32) = acc[ai][0][m][0] * r_; } }
    }
};
struct MoeTab { const LAS int* tileE; const LAS int* tbase; const LAS int* cntL; };
template <int NPN> struct MoeOrder {
    int nunits, G, c;
    __device__ __forceinline__ bool next(int i, Unit& u) const { const int L = i * G + c; if (L >= nunits) return false; u.pm = L / NPN; u.pn = L - u.pm * NPN; return true; }
};
struct OpGU {
    static constexpr bool PERM = true, GATHER = true, FP8 = true;
    const bf16_t* A; const bf16_t* WGUp; int K, lda, ldb;
    unsigned char* HID  ; const int* LIST; const float* WL; const float* RSL; MoeTab tb;
    __device__ __forceinline__ unsigned a_off_u(const Unit& u, int r, int c) const { const int e = tb.tileE[u.pm]; const int p = (u.pm - tb.tbase[e]) * 256 + r;
        const int tok = p < tb.cntL[e] ? (LIST[(size_t)e * NTOK + p] >> 1) : 0; return (unsigned)(tok * lda + c) * 2u; }
    __device__ __forceinline__ const char* a_base(const Unit&) const { return (const char*)A; }
    __device__ __forceinline__ const char* b_base(const Unit& u) const { return (const char*)(WGUp + ((size_t)tb.tileE[u.pm] * 512 + u.pn * 256) * ldb); }
    __device__ __forceinline__ void epi(const Acc& acc, const Unit& u, int wr, int wc, int fr, int fq) const {
        const int e = tb.tileE[u.pm], row0 = (u.pm - tb.tbase[e]) * 256, ce = tb.cntL[e]; const size_t lb = (size_t)e * NTOK + row0;
        float cw[2][4], rs[2][4];
        FOR_AI FOR_M { const int r = RT_(ai, m); const bool v = row0 + r < ce; cw[ai][m] = v ? WL[lb + r] : 0.f; rs[ai][m] = v ? RSL[lb + r] : 0.f; }
        unsigned char* base = HID + (size_t)u.pm * 256 * EFF + u.pn * 128 + 32 * wc + 8 * fq;
        FOR_AI FOR_M { const float r_ = rs[ai][m], c_ = cw[ai][m]; f32x4 h0, h1;
#pragma unroll
            for (int j = 0; j < 4; ++j) { const float g0 = acc[ai][0][m][0][j] * r_, u0 = acc[ai][1][m][0][j] * r_, g1 = acc[ai][0][m][1][j] * r_, u1 = acc[ai][1][m][1][j] * r_;
                h0[j] = g0 * sigmoidf_(g0) * u0 * c_ * 16.f; h1[j] = g1 * sigmoidf_(g1) * u1 * c_ * 16.f; }
            store8_fp8(base + (size_t)RT_(ai, m) * EFF, h0, h1); }
    }
};
struct OpDN {
    static constexpr bool PERM = true, GATHER = false, FP8 = true;
    const bf16_t* HID; const bf16_t* WDp; int K, lda, ldb;
    unsigned char* Y  ; const int* LIST; MoeTab tb;
    __device__ __forceinline__ unsigned a_off(int r, int c) const { return (unsigned)(r * lda + c) * 2u; }
    __device__ __forceinline__ const char* a_base(const Unit& u) const { return (const char*)(HID + (size_t)u.pm * 256 * lda); }
    __device__ __forceinline__ const char* b_base(const Unit& u) const { return (const char*)(WDp + ((size_t)tb.tileE[u.pm] * DM + u.pn * 256) * ldb); }
    __device__ __forceinline__ void epi(const Acc& acc, const Unit& u, int wr, int wc, int fr, int fq) const {
        const int e = tb.tileE[u.pm], row0 = (u.pm - tb.tbase[e]) * 256, ce = tb.cntL[e]; const size_t lb = (size_t)e * NTOK + row0;
        int ent[2][4];
        FOR_AI FOR_M { const int r = RT_(ai, m); ent[ai][m] = row0 + r < ce ? LIST[lb + r] : -1; }
        FOR_AI FOR_M { const int en = ent[ai][m];
            if (en >= 0) { unsigned char* p = Y + ((size_t)(en & 1) * NTOK + (size_t)(en >> 1)) * DM + u.pn * 256 + 32 * wc + 8 * fq;
                FOR_BJ store8_fp8(p + bj * 128, acc[ai][bj][m][0], acc[ai][bj][m][1]); } }
    }
};
__device__ __forceinline__ int moe_build_tables(const unsigned* cnt, LAS int* cntL, LAS int* tbase, LAS int* tileE, int tid) {
    if (tid < NEXP) cntL[tid] = (int)__hip_atomic_load(cnt + tid, RLX_AGENT);
    __syncthreads();
    if (tid == 0) { int acc_ = 0; for (int e = 0; e < NEXP; ++e) { tbase[e] = acc_; acc_ += (cntL[e] + 255) >> 8; } tbase[NEXP] = acc_; }
    __syncthreads();
    const int nt = tbase[NEXP];
    for (int t = tid; t < nt; t += 512) { int e = 0; for (int k = 1; k < NEXP; ++k) e += (tbase[k] <= t) ? 1 : 0; tileE[t] = e; }
    __syncthreads();
    return __builtin_amdgcn_readfirstlane(nt);
}

namespace mla {
constexpr int KSLOT = 4096, RSLOT = 2048, VSLOT = 4096, NSLOT = 8;
constexpr int L_K = 0, L_R = NSLOT * KSLOT, L_V = L_R + NSLOT * RSLOT, L_WS = L_V + NSLOT * VSLOT, L_OST = L_WS + 8 * 256, L_DUM = L_OST + 8 * 4096, L_END = L_DUM + 8 * 1024;
static_assert(L_END <= RING_BYTES, "attention LDS");
constexpr float THR = 6.0f;
__device__ __forceinline__ int crow(int r, int hi) { return (r & 3) + 8 * (r >> 2) + 4 * hi; }
__device__ __forceinline__ void glds16(const void* gsrc, unsigned lds_dst) { unsigned keep;
    asm volatile("s_mov_b32 %0, m0\n\ts_mov_b32 m0, %2\n\ts_nop 0\n\tglobal_load_lds_dwordx4 %1, off\n\ts_mov_b32 m0, %0" : "=&s"(keep) : "v"(gsrc), "s"(lds_dst) : "memory"); }
#define MX3(a, b, c) __builtin_fmaxf(__builtin_fmaxf((a), (b)), (c))
__device__ __forceinline__ float rowmax(const f32x16& p0, const f32x16& p1) {
    float a = MX3(p0[0], p0[1], p1[0]), b = MX3(p0[2], p0[3], p1[1]); a = MX3(a, p1[2], p1[3]);
#pragma unroll
    for (int r = 4; r < 16; r += 4) { a = MX3(a, p0[r], p0[r + 1]); b = MX3(b, p0[r + 2], p0[r + 3]); a = MX3(a, p1[r], p1[r + 1]); b = MX3(b, p1[r + 2], p1[r + 3]); }
    a = __builtin_fmaxf(a, b);
    auto rr = __builtin_amdgcn_permlane32_swap(__float_as_uint(a), __float_as_uint(a), false, false);
    return __builtin_fmaxf(__uint_as_float(rr[0]), __uint_as_float(rr[1]));
}
#define MLA_SC1 0x7F7F7F7F
#define MLA_SCQ 0x7B7B7B7B
template <bool GA> __device__ __forceinline__ void attn_unit(int b, int h, int qb, const unsigned char* Q8, const unsigned char* K8, const unsigned char* KR8, const unsigned char* VT8, bf16_t* O, LAS unsigned char* shm, const int wv_) {
    int tid = wv_ * 64 + lane_mb(); asm volatile("" : "+v"(tid));
    const int lane = tid & 63, r32 = lane & 31, hi = lane >> 5; const int wid = __builtin_amdgcn_readfirstlane(tid >> 6);
    const long rowbase = (long)b * SEQ; const int q0 = qb * 256;
    const unsigned lds0 = (unsigned)(uintptr_t)shm;
    LAS float* wsf = (LAS float*)(shm + L_WS) + wid * 64;
    const int sw1 = (lane & 3) ^ ((lane >> 4) & 3);
    const unsigned char* src1 = wid < 4 ? K8 + (rowbase + wid * 16 + (lane >> 2)) * 512 + h * 64 + sw1 * 16
                                        : VT8 + ((size_t)(rowbase >> 6) * 512 + h * 64 + (wid - 4) * 16 + (lane >> 2)) * 64 + sw1 * 16;
    const long step1 = wid < 4 ? 64 * 512 : 512 * 64;
    const unsigned dst1 = wid < 4 ? lds0 + L_K + wid * 1024 : lds0 + L_V + (wid - 4) * 1024; const unsigned slot1 = wid < 4 ? KSLOT : VSLOT;
    const unsigned char* src2 = wid < 2 ? KR8 + (rowbase + wid * 32 + (lane >> 1)) * ROPE + ((lane & 1) ^ ((lane >> 4) & 1)) * 16 : src1;
    const long step2 = wid < 2 ? 64 * ROPE : step1;
    const unsigned dst2 = wid < 2 ? lds0 + L_R + wid * 1024 : lds0 + L_DUM + wid * 1024; const unsigned slot2 = wid < 2 ? RSLOT : 0;
#define MLA_DMA(t, s) do { glds16(src1 + (long)(t) * step1, (unsigned)__builtin_amdgcn_readfirstlane(dst1 + (s) * slot1)); \
        glds16(src2 + (long)(t) * step2, (unsigned)__builtin_amdgcn_readfirstlane(dst2 + (s) * slot2)); } while (0)
    const int NT = 4 * qb + 4, nvis = 4 * qb + (wid >> 1) + 1;
    v8i_t qf[2];
    { const unsigned char* qp = Q8 + (rowbase + q0 + wid * 32 + r32) * 1024 + h * 128 + hi * 32;
#pragma unroll
      for (int st = 0; st < 2; ++st) qf[st] = __builtin_shufflevector(*(const v4i_t*)(qp + st * 64), *(const v4i_t*)(qp + st * 64 + 16), 0, 1, 2, 3, 4, 5, 6, 7); }
    asm volatile("" ::: "memory");
    MLA_DMA(0, 0); MLA_DMA(1, 1); MLA_DMA(2, 2); MLA_DMA(3, 3);
    float mrun = 0.f; f32x16 o[2], lacc;
#pragma unroll
    for (int r = 0; r < 16; ++r) { float z0, z1, z2; asm volatile("v_mov_b32 %0, 0\n\tv_mov_b32 %1, 0\n\tv_mov_b32 %2, 0" : "=v"(z0), "=v"(z1), "=v"(z2)); o[0][r] = z0; o[1][r] = z1; lacc[r] = z2; }
    f32x16 negm;
#pragma unroll
    for (int r = 0; r < 16; ++r) { float z_; asm volatile("v_mov_b32 %0, 0" : "=v"(z_)); negm[r] = z_; }
    v8i_t kn0, kn1, kr0, kr1, p8;
    const int swr = (r32 >> 2) & 3, k64a = ((2 * hi) ^ swr) * 16, k64b = ((2 * hi + 1) ^ swr) * 16, k32a = ((r32 >> 3) & 1) * 16;
#define MLA_KLD(sl_) do { const LAS unsigned char* kp = shm + L_K + (sl_) * KSLOT + r32 * 64; const LAS unsigned char* rp = shm + L_R + (sl_) * RSLOT + r32 * 32; \
        kn0 = __builtin_shufflevector(*(const LAS v4i_t*)(kp + k64a), *(const LAS v4i_t*)(kp + k64b), 0, 1, 2, 3, 4, 5, 6, 7); \
        kn1 = __builtin_shufflevector(*(const LAS v4i_t*)(kp + 2048 + k64a), *(const LAS v4i_t*)(kp + 2048 + k64b), 0, 1, 2, 3, 4, 5, 6, 7); \
        kr0 = __builtin_shufflevector(*(const LAS v4i_t*)(rp + k32a), *(const LAS v4i_t*)(rp + (k32a ^ 16)), 0, 1, 2, 3, 4, 5, 6, 7);      \
        kr1 = __builtin_shufflevector(*(const LAS v4i_t*)(rp + 1024 + k32a), *(const LAS v4i_t*)(rp + 1024 + (k32a ^ 16)), 0, 1, 2, 3, 4, 5, 6, 7); } while (0)
#define MLA_VLD(sl_) do { const LAS unsigned char* vp = shm + L_V + (sl_) * VSLOT + r32 * 64; \
        vf0 = __builtin_shufflevector(*(const LAS v4i_t*)(vp + k64a), *(const LAS v4i_t*)(vp + k64b), 0, 1, 2, 3, 4, 5, 6, 7); \
        vf1 = __builtin_shufflevector(*(const LAS v4i_t*)(vp + 2048 + k64a), *(const LAS v4i_t*)(vp + 2048 + k64b), 0, 1, 2, 3, 4, 5, 6, 7); } while (0)
#define MLA_MF(a_, b_, c_, sa_, sb_) __builtin_amdgcn_mfma_scale_f32_32x32x64_f8f6f4(a_, b_, c_, 0, 0, 0, sa_, 0, sb_)
#define MLA_QK(P0, P1) do { \
        P0 = MLA_MF(kn0, qf[0], negm, MLA_SC1, MLA_SCQ); P1 = MLA_MF(kn1, qf[0], negm, MLA_SC1, MLA_SCQ); \
        P0 = MLA_MF(kr0, qf[1], P0, MLA_SC1, MLA_SCQ); P1 = MLA_MF(kr1, qf[1], P1, MLA_SC1, MLA_SCQ); } while (0)
#define MLA_PV() do { o[0] = MLA_MF(p8, vf0, o[0], MLA_SC1, MLA_SC1); o[1] = MLA_MF(p8, vf1, o[1], MLA_SC1, MLA_SC1); { v8i_t ones; _Pragma("unroll") for (int i = 0; i < 8; ++i) { int w_; asm volatile("v_mov_b32 %0, 0x38383838" : "=v"(w_)); ones[i] = w_; }        \
          lacc = MLA_MF(p8, ones, lacc, MLA_SC1, MLA_SC1); } } while (0)
#define MLA_SM(PA0, PA1, PB0, PB1, t, ADJB) do { \
            const float rm = rowmax(PA0, PA1); \
            if (__any(rm > THR)) { const float dl = __builtin_fmaxf(rm, 0.f); mrun += dl; \
                _Pragma("unroll") for (int r = 0; r < 16; ++r) { PA0[r] -= dl; PA1[r] -= dl; } \
                if (ADJB && (t) + 1 < nvis) { _Pragma("unroll") for (int r = 0; r < 16; ++r) { PB0[r] -= dl; PB1[r] -= dl; } } \
                _Pragma("unroll") for (int r = 0; r < 16; ++r) negm[r] = -mrun; \
                asm volatile("" : "+v"(negm)); \
                const float f = fast_exp2(-dl); if (hi == 0) wsf[r32] = f; LDS_WAIT(); \
                _Pragma("unroll") for (int r = 0; r < 16; ++r) { const float fr_ = wsf[crow(r, hi)]; o[0][r] *= fr_; o[1][r] *= fr_; lacc[r] *= fr_; } \
                LDS_WAIT(); } \
            _Pragma("unroll") for (int r = 0; r < 16; ++r) { PA0[r] = fast_exp2(PA0[r]); PA1[r] = fast_exp2(PA1[r]); } \
            _Pragma("unroll") for (int i = 0; i < 4; ++i) { p8[i] = (int)cvt4_fp8(PA0[4 * i], PA0[4 * i + 1], PA0[4 * i + 2], PA0[4 * i + 3]); p8[4 + i] = (int)cvt4_fp8(PA1[4 * i], PA1[4 * i + 1], PA1[4 * i + 2], PA1[4 * i + 3]); } \
        } while (0)
#define MLA_STEP(PA0, PA1, PB0, PB1, t) do { \
        if ((t) + 2 < NT) { if ((t) + 3 < NT) asm volatile("s_waitcnt vmcnt(2) lgkmcnt(0)\n\ts_barrier" ::: "memory"); else asm volatile("s_waitcnt vmcnt(0) lgkmcnt(0)\n\ts_barrier" ::: "memory"); } \
        if ((t) + 4 < NT) MLA_DMA((t) + 4, ((t) + 4) & 7); \
        v8i_t vf0, vf1;                                                       \
        if constexpr (GA) { \
            const bool pv_ = (t) >= 1 && (t) - 1 < nvis; \
            if (pv_) MLA_VLD(((t) - 1) & 7); \
            if ((t) + 1 < nvis) MLA_QK(PB0, PB1); \
            if (pv_) MLA_PV(); \
            if ((t) < nvis) MLA_SM(PA0, PA1, PB0, PB1, t, true); \
            __builtin_amdgcn_sched_barrier(0); \
            if ((t) + 2 < nvis) MLA_KLD(((t) + 2) & 7); \
        } else { \
            if ((t) < nvis) { \
                MLA_VLD((t) & 7); \
                if ((t) + 1 < nvis) MLA_KLD(((t) + 1) & 7); \
                MLA_SM(PA0, PA1, PB0, PB1, t, false); \
                __builtin_amdgcn_sched_barrier(0); \
                if ((t) + 1 < nvis) MLA_QK(PB0, PB1); \
                MLA_PV(); } \
        } \
    } while (0)
    asm volatile("s_waitcnt vmcnt(4) lgkmcnt(0)\n\ts_barrier" ::: "memory");
    f32x16 pA0, pA1, pB0, pB1;
    MLA_KLD(0); MLA_QK(pA0, pA1);
    { const float rm = rowmax(pA0, pA1); mrun = rm;
#pragma unroll
        for (int r = 0; r < 16; ++r) { pA0[r] -= rm; pA1[r] -= rm; negm[r] = -rm; }
        asm volatile("" : "+v"(negm)); }
    if (GA && 1 < nvis) MLA_KLD(1);
    for (int t = 0; t < NT; t += 2) {
        MLA_STEP(pA0, pA1, pB0, pB1, t);
        MLA_STEP(pB0, pB1, pA0, pA1, t + 1);
    }
    if (GA && nvis == NT) { v8i_t vf0, vf1; MLA_VLD((NT - 1) & 7); MLA_PV(); }
#undef MLA_SM
#undef MLA_VLD
#undef MLA_MF
#undef MLA_PV
#undef MLA_KLD
#undef MLA_QK
#undef MLA_STEP
    float rli[16];
#pragma unroll
    for (int r = 0; r < 16; ++r) rli[r] = __builtin_amdgcn_rcpf(lacc[r]);
    unsigned char* Ow = (unsigned char*)O + (rowbase + q0 + wid * 32) * 512 + h * 64;
    { LAS unsigned char* stg = (LAS unsigned char*)(shm + L_OST) + wid * 4096;
#pragma unroll
        for (int r = 0; r < 16; ++r) { const int orow = crow(r, hi); const unsigned w = cvt4_fp8(o[0][r] * rli[r] * 16.f, o[1][r] * rli[r] * 16.f, 0.f, 0.f);
            stg[orow * 64 + r32] = (unsigned char)(w & 0xffu); stg[orow * 64 + 32 + r32] = (unsigned char)((w >> 8) & 0xffu); }
        LDS_WAIT();
#pragma unroll
        for (int i = 0; i < 2; ++i) { const int row = i * 16 + (lane >> 2), ch = lane & 3; const u32x4 v = *(const LAS u32x4*)(stg + row * 64 + ch * 16); *(u32x4*)(Ow + (long)row * 512 + ch * 16) = v; } }
    asm volatile("s_waitcnt lgkmcnt(0)\n\ts_barrier" ::: "memory");
#undef MLA_DMA
#undef MX3
}
}

#define XB_TMO      128
#define XB_XCNT(j)  (256  + 64 * (j))
#define XB_XSUB(j)  (1280 + 64 * (j))
#define XB_XGEN(j)  (2304 + 64 * (j))
#define XB_TOP      3328
#define XB_TOPGEN   3392
#define XCD_BAR_WORDS 3456
#define XB_SPIN_CAP (1u << 18)
__device__ __forceinline__ unsigned xb_ld(unsigned* p)              { return __hip_atomic_load(p, __ATOMIC_RELAXED, __HIP_MEMORY_SCOPE_AGENT); }
__device__ __forceinline__ unsigned xb_add(unsigned* p, unsigned v) { return __hip_atomic_fetch_add(p, v, __ATOMIC_RELAXED, __HIP_MEMORY_SCOPE_AGENT); }
__device__ __forceinline__ unsigned xb_xcc_id() { return (unsigned)__builtin_amdgcn_s_getreg((3 << 11) | 20) & 0xFu; }
#define XB_SPIN(cond, bar) do { unsigned _sp = 0; while (cond) { __builtin_amdgcn_s_sleep(1); \
    if ((++_sp & 255u) == 0u) { if (xb_ld(&(bar)[XB_TMO])) break; if (_sp > XB_SPIN_CAP) { atomicAdd(&(bar)[XB_TMO], 1u); break; } } } } while (0)
struct XcdBarrier { unsigned* bar; unsigned x; volatile LAS unsigned* st; int w; };
__device__ __forceinline__ XcdBarrier xcd_barrier_post(unsigned* bar, volatile LAS unsigned* st) {
    XcdBarrier b; b.bar = bar; b.x = xb_xcc_id(); b.st = st;
    if (threadIdx.x == 0) (void)xb_add(&bar[XB_XCNT(b.x)], 1u);
    return b;
}
__device__ __forceinline__ void xcd_barrier_complete(unsigned* bar, unsigned x, unsigned& nloc, unsigned& nx) {
    const unsigned G = gridDim.x * gridDim.y * gridDim.z;
    unsigned sum, cnt, mine, sp = 0u;
    for (;;) {
        sum = 0u; cnt = 0u; mine = 0u;
#pragma unroll
        for (unsigned j = 0; j < 16; ++j) { const unsigned c = xb_ld(&bar[XB_XCNT(j)]); sum += c; cnt += (c > 0u) ? 1u : 0u; mine = (j == x) ? c : mine; }
        if (sum == G) break;
        __builtin_amdgcn_s_sleep(1);
        if ((++sp & 255u) == 0u) { if (xb_ld(&bar[XB_TMO])) break; if (sp > XB_SPIN_CAP) { atomicAdd(&bar[XB_TMO], 1u); break; } }
    }
    nloc = mine > 0u ? mine : 1u; nx = cnt > 0u ? cnt : 1u;
}
__device__ __forceinline__ void xcd_barrier(const XcdBarrier& b) {
    asm volatile("s_waitcnt vmcnt(0)" ::: "memory");
    __syncthreads();
    if (b.w == 0 && lane_mb() == 0) {
        unsigned* bar = b.bar;
        __builtin_amdgcn_s_waitcnt(0);
        unsigned nloc = b.st[0], nx = b.st[1];
        if (nloc == 0u) { xcd_barrier_complete(bar, b.x, nloc, nx); b.st[0] = nloc; b.st[1] = nx; }
        const unsigned old = xb_add(&bar[XB_XSUB(b.x)], 1u);
        const unsigned gen = old / nloc;
        if (old + 1u == (gen + 1u) * nloc) {
            __builtin_amdgcn_fence(__ATOMIC_RELEASE, "agent");
            asm volatile("s_waitcnt vmcnt(0)" ::: "memory");
            const unsigned og = xb_add(&bar[XB_TOP], 1u);
            const unsigned tg = og / nx;
            if (og + 1u == (tg + 1u) * nx) xb_add(&bar[XB_TOPGEN], 1u);
            else XB_SPIN(xb_ld(&bar[XB_TOPGEN]) == tg, bar);
            __builtin_amdgcn_fence(__ATOMIC_ACQUIRE, "agent");
            xb_add(&bar[XB_XGEN(b.x)], 1u);
            asm volatile("s_waitcnt vmcnt(0)" ::: "memory");
        } else {
            XB_SPIN(xb_ld(&bar[XB_XGEN(b.x)]) == gen, bar);
            __builtin_amdgcn_fence(__ATOMIC_ACQUIRE, "agent");
            asm volatile("s_waitcnt vmcnt(0)" ::: "memory");
        }
    }
    __syncthreads();
}

__device__ __forceinline__ void transpose_block(const float* src, int ldw, const float* gain, bf16_t* dst  , int ldt, LAS float* scr, int lane, unsigned char* dst8 = nullptr, int ldt8 = 0, float sc8 = 1.f) {
    float tv[32];
#pragma unroll
    for (int i = 0; i < 32; ++i) { const int kk = 2 * i + (lane >> 5); tv[i] = src ? src[(size_t)kk * ldw + (lane & 31)] : 0.f; }
#pragma unroll
    for (int i = 0; i < 32; ++i) { const int kk = 2 * i + (lane >> 5); float v = tv[i]; if (gain) v *= gain[kk]; scr[kk * 33 + (lane & 31)] = v; }
    LDS_WAIT(); asm volatile("" ::: "memory");
    const int c = lane & 7;
#pragma unroll
    for (int j = 0; j < 4; ++j) { const int n = (lane >> 3) + 8 * j; const LAS float* s = scr + (8 * c) * 33 + n;
        u32x4 o; o.x = cvt_pk_bf16(s[0 * 33], s[1 * 33]); o.y = cvt_pk_bf16(s[2 * 33], s[3 * 33]); o.z = cvt_pk_bf16(s[4 * 33], s[5 * 33]); o.w = cvt_pk_bf16(s[6 * 33], s[7 * 33]);
        if (dst) *(u32x4*)(dst + (size_t)n * ldt + 8 * c) = o;
        if (dst8) { u32x2 o8; o8.x = cvt4_fp8(s[0 * 33] * sc8, s[1 * 33] * sc8, s[2 * 33] * sc8, s[3 * 33] * sc8); o8.y = cvt4_fp8(s[4 * 33] * sc8, s[5 * 33] * sc8, s[6 * 33] * sc8, s[7 * 33] * sc8);
            *(u32x2*)(dst8 + (size_t)n * ldt8 + 8 * c) = o8; } }
    LDS_WAIT(); asm volatile("" ::: "memory");
}
__device__ __forceinline__ void rms_row_to_bf16(const float* xrow, const float* g, bf16_t* orow, int lane) {
    const f32x4* xr = (const f32x4*)xrow + lane; const f32x4* gr = (const f32x4*)g + lane;
    f32x4 v[4]; float s = 0.f;
#pragma unroll
    for (int j = 0; j < 4; ++j) { v[j] = xr[64 * j]; s += (v[j].x * v[j].x + v[j].y * v[j].y) + (v[j].z * v[j].z + v[j].w * v[j].w); }
    const float rstd = 1.0f / sqrtf(wave_sum(s) * (1.f / DM) + EPS);
    u32x2* o8 = (u32x2*)orow + lane;
#pragma unroll
    for (int j = 0; j < 4; ++j) { const f32x4 gg = gr[64 * j]; u32x2 w; w.x = cvt_pk_bf16(v[j].x * rstd * gg.x, v[j].y * rstd * gg.y); w.y = cvt_pk_bf16(v[j].z * rstd * gg.z, v[j].w * rstd * gg.w); o8[64 * j] = w; }
}

__device__ __forceinline__ void rms_row2_to_bf16(const float* xrow, const float* g, bf16_t* orow, int lane, unsigned char* orow8 = nullptr) {
    const f32x4* xr = (const f32x4*)xrow + lane; const f32x4* gr = (const f32x4*)g + lane;
    f32x4 v[2][4]; float s[2] = {0.f, 0.f};
#pragma unroll
    for (int r = 0; r < 2; ++r)
#pragma unroll
        for (int j = 0; j < 4; ++j) v[r][j] = xr[r * 256 + 64 * j];
#pragma unroll
    for (int r = 0; r < 2; ++r)
#pragma unroll
        for (int j = 0; j < 4; ++j) s[r] += (v[r][j].x * v[r][j].x + v[r][j].y * v[r][j].y) + (v[r][j].z * v[r][j].z + v[r][j].w * v[r][j].w);
#pragma unroll
    for (int r = 0; r < 2; ++r) { const float rstd = 1.0f / sqrtf(wave_sum(s[r]) * (1.f / DM) + EPS); u32x2* o8 = (u32x2*)(orow + (size_t)r * DM) + lane;
#pragma unroll
        for (int j = 0; j < 4; ++j) { const f32x4 gg = gr[64 * j]; u32x2 w; w.x = cvt_pk_bf16(v[r][j].x * rstd * gg.x, v[r][j].y * rstd * gg.y); w.y = cvt_pk_bf16(v[r][j].z * rstd * gg.z, v[r][j].w * rstd * gg.w); o8[64 * j] = w;
            if (orow8) ((unsigned*)(orow8 + (size_t)r * DM))[lane + 64 * j] = cvt4_fp8(v[r][j].x * rstd * gg.x, v[r][j].y * rstd * gg.y, v[r][j].z * rstd * gg.z, v[r][j].w * rstd * gg.w); } }
}
struct Args { const void* in[28]; float* out; unsigned char* ws; int ph_lo, ph_hi; };
constexpr int NPHASE = 12;

#define CAS __attribute__((address_space(4)))
#define PHASE_PTRS const CAS char* ka_ = (const CAS char*)__builtin_amdgcn_kernarg_segment_ptr(); asm volatile("" : "+s"(ka_)); unsigned char* ws = *(unsigned char* const CAS*)(ka_ + 232); float* outp = *(float* const CAS*)(ka_ + 224); const float* x = *(const float* const CAS*)(ka_ + 0); const float* mem = *(const float* const CAS*)(ka_ + 8); const int* positions = *(const int* const CAS*)(ka_ + 16); const float* mix_norm_g = *(const float* const CAS*)(ka_ + 24); const float* w_in = *(const float* const CAS*)(ka_ + 32); const float* q_norm_g = *(const float* const CAS*)(ka_ + 40); const float* w_q_up = *(const float* const CAS*)(ka_ + 48); const float* kv_norm_g = *(const float* const CAS*)(ka_ + 56); const float* w_kv_up = *(const float* const CAS*)(ka_ + 64); const float* w_attn_branch = *(const float* const CAS*)(ka_ + 72); const float* pool_w = *(const float* const CAS*)(ka_ + 80); const float* pool_scale = *(const float* const CAS*)(ka_ + 88); const float* w_pool_branch = *(const float* const CAS*)(ka_ + 96); const float* w_mix_out = *(const float* const CAS*)(ka_ + 104); const float* xattn_norm_g = *(const float* const CAS*)(ka_ + 112); const float* mem_norm_g = *(const float* const CAS*)(ka_ + 120); const float* w_xq = *(const float* const CAS*)(ka_ + 128); const float* w_xkv = *(const float* const CAS*)(ka_ + 136); const float* w_xo = *(const float* const CAS*)(ka_ + 144); const float* ffn_norm_g = *(const float* const CAS*)(ka_ + 152); const float* w_rg = *(const float* const CAS*)(ka_ + 160); const float* b_rg = *(const float* const CAS*)(ka_ + 168); const float* w_re = *(const float* const CAS*)(ka_ + 176); const float* b_re = *(const float* const CAS*)(ka_ + 184); const float* w_eg = *(const float* const CAS*)(ka_ + 192); const float* w_eu = *(const float* const CAS*)(ka_ + 200); const float* w_ed = *(const float* const CAS*)(ka_ + 208); const float* final_g = *(const float* const CAS*)(ka_ + 216); u64* ssq_q = (u64*)(ws + OFF_SSQQ); u64* ssq_kv = (u64*)(ws + OFF_SSQKV); u64* ssq1 = (u64*)(ws + OFF_SSQ1); u64* ssq2 = (u64*)(ws + OFF_SSQ2); unsigned* cnt = (unsigned*)(ws + OFF_CNT); float* cosT = (float*)(ws + WS_COS); float* sinT = (float*)(ws + WS_SIN); unsigned char* WIN8 = ws + WS_WIN8; unsigned char* HN8 = ws + WS_S6;     bf16_t* WIN = (bf16_t*)(ws + WS_WIN); unsigned char* WQ8 = ws + WS_WQ; unsigned char* WKVU8 = ws + WS_WKVU; unsigned char* WA8 = ws + WS_WA; bf16_t* WPB = (bf16_t*)(ws + WS_WPB); unsigned char* WMO8 = ws + WS_WMO; unsigned char* M8 = ws + WS_S1; bf16_t* WXKV = (bf16_t*)(ws + WS_WXKV); bf16_t* WXO = (bf16_t*)(ws + WS_WXO); bf16_t* WR = (bf16_t*)(ws + WS_WR); unsigned char* WGU8 = ws + WS_WGU; unsigned char* H28 = ws + WS_S5; unsigned char* WD8 = ws + WS_WD; bf16_t* MEMN = (bf16_t*)(ws + WS_MEMN); bf16_t* KVM = (bf16_t*)(ws + WS_KVM); bf16_t* WXQN = (bf16_t*)(ws + WS_WXQN); unsigned char* BQK = ws + WS_BQK; unsigned char* BVO = ws + WS_BVO; unsigned char* H18 = ws + WS_S5; unsigned char* P8 = ws + WS_S1; float* LG = (float*)(ws + WS_LG); bf16_t* HN = (bf16_t*)(ws + WS_S0); bf16_t* Qb = (bf16_t*)(ws + WS_S0); bf16_t* H1 = (bf16_t*)(ws + WS_S0); bf16_t* GA = (bf16_t*)(ws + WS_S1); bf16_t* XQ = (bf16_t*)(ws + WS_S1); bf16_t* Y = (bf16_t*)(ws + WS_S1); bf16_t* GBM = (bf16_t*)(ws + WS_S2); bf16_t* QLb = (bf16_t*)(ws + WS_QLB); bf16_t* KVLb = (bf16_t*)(ws + WS_KVLB); bf16_t* KRb = (bf16_t*)(ws + WS_KRB); bf16_t* H2 = (bf16_t*)(ws + WS_S3); bf16_t* U = (bf16_t*)(ws + WS_U); bf16_t* DP = (bf16_t*)(ws + WS_DP); unsigned char* HID = ws + WS_HID; int* LIST = (int*)(ws + WS_LIST); float* WL = (float*)(ws + WS_WL); float* RSL = (float*)(ws + WS_RSL); unsigned char* K8 = ws + WS_S5; unsigned char* VT8 = ws + WS_S5 + 64 * MiB; unsigned char* Q8 = ws + WS_S0; bf16_t* ATT = (bf16_t*)(ws + WS_ATT); (void)outp; int tidp_ = wave * 64 + lane_mb(); asm volatile("" : "+v"(tidp_)); const int tid = tidp_, lane = tid & 63, gt = bx * 512 + tid; (void)lane; (void)gt;
__global__ void __launch_bounds__(512, 2) fwd_kernel(Args args) {
    extern __shared__ __attribute__((aligned(16))) unsigned char lds_raw[];
    LAS unsigned char* lds = (LAS unsigned char*)lds_raw;
    LAS unsigned char* misc = lds + MISC_OFF;
    const int tid = threadIdx.x, lane = tid & 63, wave = __builtin_amdgcn_readfirstlane(tid >> 6);
    const int G = gridDim.x, bx = blockIdx.x;
    const int vcu = (G % 8 == 0) ? (bx % 8) * (G / 8) + bx / 8 : bx;
    for (int u = tid; u < (LDS_BYTES - MISC_OFF) / 4; u += 512) ((LAS unsigned*)misc)[u] = 0u;
    __syncthreads();
    unsigned* barw = (unsigned*)(args.ws + WS_CTL);
    XcdBarrier bar; bar.bar = barw; bar.x = 0; bar.st = nullptr; bar.w = wave;
    if (MK_N_LAUNCHES == 1) { bar = xcd_barrier_post(barw, (volatile LAS unsigned*)(misc + MO_BAR)); bar.w = wave; }
#define GRID_BAR() do { if (MK_N_LAUNCHES == 1) xcd_barrier(bar); } while (0)
    const int lo = args.ph_lo, hi = args.ph_hi;
#ifndef PH_MASK
#define PH_MASK 0xfff
#endif
#define IN(k) ((((PH_MASK) >> (k)) & 1) && lo <= (k) && (k) < hi)
#define BOTH(k) (IN(k) && IN((k) + 1))
    const int gw = vcu * 8 + wave, NGW = G * 8;
    const int gt = bx * 512 + tid, NGT = G * 512;

    if (IN(0)) {
        PHASE_PTRS
        for (int i = gt; i < (int)(SMALL_ZERO_BYTES / 4); i += NGT) ((unsigned*)(ws + WS_SMALL))[i] = 0u;
        for (int i = gt; i < NTOK * 16; i += NGT) { const int row = i >> 4, k = i & 15;
            const float inv = (float)exp2(-(double)k * (13.287712379549449 / 16.0)); const float ang = (float)positions[row] * inv;
            const double rev = (double)ang * 0.15915494309189535; const float fr_ = (float)(rev - rint(rev));
            cosT[i] = __builtin_amdgcn_cosf(fr_); sinT[i] = __builtin_amdgcn_sinf(fr_); }
        for (int i = gt; i < POOLW * DM; i += NGT) { const int n = i & (DM - 1), k = i >> 10, g = k >> 7; const float* pw = pool_w + (size_t)k * 128; const float* sc = pool_scale + g * 128; const float* wb = w_pool_branch + (size_t)g * 128 * DM + n;
            float s = 0.f;
            for (int e = 0; e < 128; ++e) s += pw[e] * sc[e] * wb[(size_t)e * DM];
            WPB[(size_t)n * POOLW + k] = (bf16_t)(cvt_pk_bf16(s, 0.f) & 0xffffu); }
        for (int i = gt; i < DM * DM / 8; i += NGT) { const int k = i >> 7; const float g_ = xattn_norm_g[k]; const f32x4 a0 = *(const f32x4*)(w_xq + (size_t)i * 8), a1 = *(const f32x4*)(w_xq + (size_t)i * 8 + 4); store8(WXQN + (size_t)i * 8, a0 * g_, a1 * g_); }
        for (int i = gt; i < 256 * DM; i += NGT) { const int n = i >> 10, k = i & (DM - 1); float v = 0.f;
            if (n < 32) v = w_re[k * 32 + n] * ffn_norm_g[k]; else if (n < 36) v = w_rg[k * 4 + (n - 32)] * ffn_norm_g[k];
            WR[i] = (bf16_t)(cvt_pk_bf16(v, 0.f) & 0xffffu); }
        {
            LAS float* scr = (LAS float*)(lds + wave * 16384);
            constexpr int I_IN = 16 * 104, I_Q = 8 * 24, I_KV = 4 * 32, I_A = 8 * 32, I_SQ = 16 * 32, I_XKV = 16 * 64, I_GU = 32 * 16 * 16, I_D = 32 * 4 * 32;
            constexpr int NITEMS = I_IN + I_Q + I_KV + I_A + 2 * I_SQ + I_XKV + I_GU + I_D;
            for (int it = gw; it < NITEMS; it += NGW) {
                int r = it;
                if (r < I_IN) { const int kb = r / 104, nb = r % 104, n0 = nb * 32; const int sn = n0 < 672 ? n0 : (n0 < 768 ? -1 : n0 - 96);
                    transpose_block(sn >= 0 ? w_in + (size_t)kb * 64 * IN_COLS + sn : nullptr, IN_COLS, nullptr, WIN + (size_t)n0 * DM + kb * 64, DM, scr, lane, (n0 >= 1280 || n0 < 768) ? WIN8 + (size_t)n0 * DM + kb * 64 : nullptr, DM, 32.f); continue; } r -= I_IN;
                if (r < I_Q) { const int kb = r / 24, nb = r % 24; transpose_block(kb < 6 ? w_q_up + (size_t)kb * 64 * 768 + nb * 32 : nullptr, 768, kb < 6 ? q_norm_g + kb * 64 : nullptr, nullptr, 512, scr, lane, WQ8 + (size_t)nb * 32 * 512 + kb * 64, 512, 32.f); continue; } r -= I_Q;
                if (r < I_KV) { const int kb = r / 32, nb = r % 32, n0 = nb * 32; const int nn = n0 & 511, sn = (nn >> 6) * 128 + (n0 >= 512 ? 64 : 0) + (nn & 63);
                    transpose_block(w_kv_up + (size_t)kb * 64 * 1024 + sn, 1024, kv_norm_g + kb * 64, nullptr, KVLORA, scr, lane, WKVU8 + (size_t)n0 * KVLORA + kb * 64, KVLORA, 32.f); continue; } r -= I_KV;
                if (r < I_A) { const int kb = r / 32, nb = r % 32; transpose_block(w_attn_branch + (size_t)kb * 64 * DM + nb * 32, DM, nullptr, nullptr, 512, scr, lane, WA8 + (size_t)nb * 32 * 512 + kb * 64, 512, 32.f); continue; } r -= I_A;
                if (r < I_SQ) { const int kb = r / 32, nb = r % 32; transpose_block(w_mix_out + (size_t)kb * 64 * DM + nb * 32, DM, nullptr, nullptr, DM, scr, lane, WMO8 + (size_t)nb * 32 * DM + kb * 64, DM, 32.f); continue; } r -= I_SQ;
                if (r < I_SQ) { const int kb = r / 32, nb = r % 32; transpose_block(w_xo + (size_t)kb * 64 * DM + nb * 32, DM, nullptr, WXO + (size_t)nb * 32 * DM + kb * 64, DM, scr, lane); continue; } r -= I_SQ;
                if (r < I_XKV) { const int kb = r / 64, nb = r % 64; transpose_block(w_xkv + (size_t)kb * 64 * 2048 + nb * 32, 2048, nullptr, WXKV + (size_t)nb * 32 * DM + kb * 64, DM, scr, lane); continue; } r -= I_XKV;
                if (r < I_GU) { const int e = r / 256, q = r % 256, kb = q / 16, nb = q % 16, n0 = nb * 32;
                    const int pn = n0 >> 8, j = n0 & 255; const float* srcm = (j < 128 ? w_eg : w_eu) + (size_t)e * DM * EFF; const int sc = pn * 128 + (j & 127);
                    transpose_block(srcm + (size_t)kb * 64 * EFF + sc, EFF, ffn_norm_g + kb * 64, nullptr, DM, scr, lane, WGU8 + ((size_t)e * 512 + n0) * DM + kb * 64, DM, 32.f); continue; } r -= I_GU;
                { const int e = r / 128, q = r % 128, kb = q / 32, nb = q % 32;
                    transpose_block(w_ed + (size_t)e * EFF * DM + (size_t)kb * 64 * DM + nb * 32, DM, nullptr, nullptr, EFF, scr, lane, WD8 + ((size_t)e * DM + nb * 32) * EFF + kb * 64, EFF, 32.f); }
            }
        }
        for (int m = gw * 2; m < NTOK; m += NGW * 2) rms_row2_to_bf16(x + (size_t)m * DM, mix_norm_g, HN + (size_t)m * DM, lane, HN8 + (size_t)m * DM);
        for (int m = gw; m < NMEM; m += NGW) rms_row_to_bf16(mem + (size_t)m * DM, mem_norm_g, MEMN + (size_t)m * DM, lane);
        if (BOTH(0)) GRID_BAR();
    }

    if (IN(1)) {
        PHASE_PTRS
        { OpIn op{HN, WIN, DM, DM, DM, QLb, KVLb, KRb, U, GA, GBM, ssq_q, ssq_kv, cosT, sinT}; OffsetOrder S; S.s.init(NTOK, 512, G, bx); S.off = 3; pg8::gemm_phase(lds, op, S, wave); }
        { OpPlain op{MEMN, WXKV, DM, DM, DM, KVM, 2 * DM}; pg8::StaticOrder S; S.init(NMEM, 2 * DM, G, bx); pg8::gemm_phase(lds, op, S, wave); }
    }
    if (IN(1)) {
        PHASE_PTRS
        { OpIn8 op{(const bf16_t*)HN8, (const bf16_t*)WIN8, DM / 2, DM / 2, DM / 2, QLb, KVLb, KRb, U, GA, GBM, ssq_q, ssq_kv, cosT, sinT}; pg8::StaticOrder S; S.init(NTOK, 768, G, bx); pg8::gemm_phase(lds, op, S, wave); }
        { OpGate8 op{(const bf16_t*)HN8, (const bf16_t*)WIN8, DM / 2, DM / 2, DM / 2, GA, GBM};
          OffsetOrder S; S.s.init(NTOK, 2048, G, bx); S.off = 5; pg8::gemm_phase(lds, op, S, wave); }
        if (BOTH(1)) GRID_BAR();
    }

    if (IN(2)) {
        PHASE_PTRS
        { OpPre op{KVM, WXQN, 256, 2 * DM, DM, BQK, 0}; pg8::StaticOrder S; S.init(16 * DM, DM, G, bx); pg8::gemm_phase(lds, op, S, wave); }
        { OpPre op{KVM, WXO, 256, DM, 2 * DM, BVO, 1}; pg8::StaticOrder S; S.init(16 * DM, DM, G, bx); pg8::gemm_phase(lds, op, S, wave); }
        { OpQ op{QLb, (const bf16_t*)WQ8, 256, 256, 256, Q8, ssq_q, cosT, sinT}; pg8::StaticOrder S; S.init(NTOK, NHEAD * QKD, G, bx); pg8::gemm_phase(lds, op, S, wave); }
        { OpK8 op{KVLb, (const bf16_t*)WKVU8, KVLORA / 2, KVLORA / 2, KVLORA / 2, K8, ssq_kv}; pg8::StaticOrder S; S.init(NTOK, 512, G, bx); pg8::gemm_phase(lds, op, S, wave); }
        { OpVT op{(const bf16_t*)(WKVU8 + 512 * KVLORA), KVLb, KVLORA / 2, KVLORA / 2, KVLORA / 2, VT8, ssq_kv}; pg8::StaticOrder S; S.init(512, NTOK, G, bx); pg8::gemm_phase(lds, op, S, wave); }
        { RELANE
        static_assert((4 * (NTOK / 4)) % 2 == 0, "item pairs");
        for (int it = gw; it < 4 * (NTOK / 4); it += 2 * NGW) { const int g = it & 3, ch = g * 16 + (lane & 15); const bool two_ = it + NGW < 4 * (NTOK / 4);
            const int rowA = (it >> 2) * 4 + (lane >> 4), rowB = two_ ? ((it + NGW) >> 2) * 4 + (lane >> 4) : rowA, tA = rowA & (SEQ - 1), tB = rowB & (SEQ - 1);
            const bf16_t* pA = U + (size_t)rowA * POOLW + ch * 8; const bf16_t* pB = U + (size_t)rowB * POOLW + ch * 8;
            f32x4 a0, a1, ua0, ua1, b0, b1, ub0, ub1; load8(pA, ua0, ua1); load8(pB, ub0, ub1); a0 = ua0; a1 = ua1; b0 = ub0; b1 = ub1;
#define DP_WIN(W) { u32x4 wa_[W - 1], wb_[W - 1]; \
                    _Pragma("unroll") for (int j = 1; j < W; ++j) { wa_[j - 1] = *(const u32x4*)(pA - (size_t)(j <= tA ? j : 0) * POOLW); wb_[j - 1] = *(const u32x4*)(pB - (size_t)(j <= tB ? j : 0) * POOLW); } \
                    _Pragma("unroll") for (int j = 1; j < W; ++j) { const u32x4 w = wa_[j - 1]; const float k_ = (j <= tA) ? 1.f : 0.f; a0 += (f32x4){bf_lo(w.x), bf_hi(w.x), bf_lo(w.y), bf_hi(w.y)} * k_; a1 += (f32x4){bf_lo(w.z), bf_hi(w.z), bf_lo(w.w), bf_hi(w.w)} * k_; } \
                    _Pragma("unroll") for (int j = 1; j < W; ++j) { const u32x4 w = wb_[j - 1]; const float k_ = (j <= tB) ? 1.f : 0.f; b0 += (f32x4){bf_lo(w.x), bf_hi(w.x), bf_lo(w.y), bf_hi(w.y)} * k_; b1 += (f32x4){bf_lo(w.z), bf_hi(w.z), bf_lo(w.w), bf_hi(w.w)} * k_; } }
            if (g == 0) DP_WIN(2) else if (g == 1) DP_WIN(4) else if (g == 2) DP_WIN(8) else DP_WIN(16)
#undef DP_WIN
            const int w = 2 << g, nA = (tA + 1 < w) ? tA + 1 : w, nB = (tB + 1 < w) ? tB + 1 : w; const float invA = 1.0f / (float)nA, invB = 1.0f / (float)nB;
            store8(DP + (size_t)rowA * POOLW + ch * 8, a0 * invA - ua0, a1 * invA - ua1);
            if (two_) store8(DP + (size_t)rowB * POOLW + ch * 8, b0 * invB - ub0, b1 * invB - ub1); }
        }
        if (BOTH(2)) GRID_BAR();
    }

    if (IN(3)) {
        PHASE_PTRS
        { OpYB op{DP, WPB, POOLW, POOLW, POOLW, GBM}; pg8::StaticOrder S; S.init(NTOK, DM, G, bx); pg8::gemm_phase(lds, op, S, wave); }
        { const int bh = vcu >> 1, half = vcu & 1;
          if (bh < NBATCH * NHEAD) for (int i = 0; i < 8; ++i) { const int pr = i >> 1, od = i & 1; const int qb = 4 * pr + (od ? (half ? 2 : 3) : (half ? 1 : 0));
              if (wave < 4) mla::attn_unit<true>(bh >> 3, bh & 7, qb, Q8, K8, (const unsigned char*)KRb, VT8, ATT, lds, wave); else mla::attn_unit<false>(bh >> 3, bh & 7, qb, Q8, K8, (const unsigned char*)KRb, VT8, ATT, lds, wave); } }
        if (BOTH(3)) GRID_BAR();
    }

    if (IN(4)) {
        PHASE_PTRS
        { OpYA op{ATT, (const bf16_t*)WA8, 256, 256, 256, GA, GBM, M8}; pg8::StaticOrder S; S.init(NTOK, DM, G, bx); pg8::gemm_phase(lds, op, S, wave); }
        if (BOTH(4)) GRID_BAR();
    }

    if (IN(5)) {
        PHASE_PTRS
        { OpRes<true, true> op{(const bf16_t*)M8, (const bf16_t*)WMO8, DM / 2, DM / 2, DM / 2, x, H1, ssq1, 0, H18, 0.25f}; pg8::StaticOrder S; S.init(NTOK, DM, G, bx); pg8::gemm_phase(lds, op, S, wave); }
        if (BOTH(5)) GRID_BAR();
    }

    if (IN(6)) {
        PHASE_PTRS
        { OpSX op{(const bf16_t*)H18, (const bf16_t*)BQK, DM / 2, DM / 2, DM / 2, P8, ssq1, (LAS f32x4*)(misc + MO_PS)}; pg8::StaticOrder S; S.init(NTOK, DM, G, bx); pg8::gemm_phase(lds, op, S, wave); }
        if (BOTH(6)) GRID_BAR();
    }

    if (IN(7)) {
        PHASE_PTRS
        { OpRes<false, true> op{(const bf16_t*)P8, (const bf16_t*)BVO, DM / 2, DM / 2, DM / 2, H1, H2, ssq2, (size_t)DM * DM / 2, H28, 1.0f / 256.f}; pg8::StaticOrder S; S.init(NTOK, DM, G, bx); pg8::gemm_phase(lds, op, S, wave); }
        if (BOTH(7)) GRID_BAR();
    }

    if (IN(8)) {
        PHASE_PTRS
        pg8::StaticOrder S; S.init(NTOK, 256, G, bx);
        { OpR op{H2, WR, DM, DM, DM, LG, ssq2}; pg8::gemm_phase(lds, op, S, wave); }
        { RELANE
        VM_WAIT(); __syncthreads(); __builtin_amdgcn_fence(__ATOMIC_ACQUIRE, "agent"); VM_WAIT(); __syncthreads();
        LAS unsigned* hist = (LAS unsigned*)(misc + MO_HIST); LAS unsigned* basee = (LAS unsigned*)(misc + MO_BASE);
        pg8::StaticOrder S2; S2.init(NTOK, 256, G, bx);
        for (int i = 0; i < (256 + G - 1) / G; ++i) { Unit u; if (!S2.next(i, u)) break;
            if (tid < 32) hist[tid] = 0u;
            __syncthreads();
            int e1 = 0, e2 = 0; float w1 = 0.f, w2 = 0.f; unsigned r1 = 0, r2 = 0; const int row = u.pm * 256 + tid;
            if (tid < 256) {
                const float* lg = LG + (size_t)row * 40;
                float gl[4]; int gi = 0;
#pragma unroll
                for (int j = 0; j < 4; ++j) gl[j] = lg[32 + j] + b_rg[j];
                float gm = gl[0];
#pragma unroll
                for (int j = 1; j < 4; ++j) if (gl[j] > gm) { gm = gl[j]; gi = j; }
                float gs = 0.f;
#pragma unroll
                for (int j = 0; j < 4; ++j) gs += __expf(gl[j] - gm);
                const float gwt = 1.0f / gs;
                float el[8];
#pragma unroll
                for (int j = 0; j < 8; ++j) el[j] = lg[gi * 8 + j] + b_re[gi * 8 + j];
                int i1 = 0; float m1 = el[0];
#pragma unroll
                for (int j = 1; j < 8; ++j) if (el[j] > m1) { m1 = el[j]; i1 = j; }
                int i2 = -1; float m2 = -3.0e38f;
#pragma unroll
                for (int j = 0; j < 8; ++j) if (j != i1 && el[j] > m2) { m2 = el[j]; i2 = j; }
                const float p2 = __expf(m2 - m1);
                w1 = gwt / (1.0f + p2); w2 = gwt * p2 / (1.0f + p2);
                e1 = gi * 8 + i1; e2 = gi * 8 + i2;
                r1 = __hip_atomic_fetch_add(&hist[e1], 1u, __ATOMIC_RELAXED, __HIP_MEMORY_SCOPE_WORKGROUP); r2 = __hip_atomic_fetch_add(&hist[e2], 1u, __ATOMIC_RELAXED, __HIP_MEMORY_SCOPE_WORKGROUP);
            }
            __syncthreads();
            if (tid < 32) basee[tid] = hist[tid] ? __hip_atomic_fetch_add(cnt + tid, hist[tid], RLX_AGENT) : 0u;
            __syncthreads();
            if (tid < 256) { const size_t p1 = (size_t)e1 * NTOK + basee[e1] + r1, p2 = (size_t)e2 * NTOK + basee[e2] + r2;
                const float rs_ = __builtin_amdgcn_rsqf(fx_load(ssq2 + row) * (1.0f / DM) + EPS);
                LIST[p1] = row * 2; WL[p1] = w1; RSL[p1] = rs_; LIST[p2] = row * 2 + 1; WL[p2] = w2; RSL[p2] = rs_; }
            __syncthreads();
        }
        }
        if (BOTH(8)) GRID_BAR();
    }

    if (IN(9)) {
        PHASE_PTRS
        LAS int* cntL = (LAS int*)(misc + MO_CNTL); LAS int* tbase = (LAS int*)(misc + MO_TBASE); LAS int* tileE = (LAS int*)(misc + MO_TILEE);
        const int ntile = moe_build_tables(cnt, cntL, tbase, tileE, tid);
        { OpGU op{(const bf16_t*)H28, (const bf16_t*)WGU8, DM / 2, DM / 2, DM / 2, HID, LIST, WL, RSL, MoeTab{tileE, tbase, cntL}}; MoeOrder<2> S{ntile * 2, G, vcu}; pg8::gemm_phase(lds, op, S, wave); }
        if (BOTH(9)) GRID_BAR();
    }

    if (IN(10)) {
        PHASE_PTRS
        LAS int* cntL = (LAS int*)(misc + MO_CNTL); LAS int* tbase = (LAS int*)(misc + MO_TBASE); LAS int* tileE = (LAS int*)(misc + MO_TILEE);
        const int ntile = moe_build_tables(cnt, cntL, tbase, tileE, tid);
        { OpDN op{(const bf16_t*)HID, (const bf16_t*)WD8, EFF / 2, EFF / 2, EFF / 2, (unsigned char*)Y, LIST, MoeTab{tileE, tbase, cntL}}; MoeOrder<4> S{ntile * 4, G, vcu}; pg8::gemm_phase(lds, op, S, wave); }
        if (BOTH(10)) GRID_BAR();
    }

    if (IN(11)) {
        PHASE_PTRS
        const f32x4 g00 = *(const f32x4*)(final_g + lane * 8), g01 = *(const f32x4*)(final_g + lane * 8 + 4), g10 = *(const f32x4*)(final_g + 512 + lane * 8), g11 = *(const f32x4*)(final_g + 512 + lane * 8 + 4);
        for (int m = gw * 2; m < NTOK; m += NGW * 2) {
            u32x4 w[2][2]; u32x2 y8[2][2][2]; const unsigned char* Y8 = (const unsigned char*)Y;
#pragma unroll
            for (int r = 0; r < 2; ++r)
#pragma unroll
                for (int hf = 0; hf < 2; ++hf) { const size_t o = (size_t)(m + r) * DM + hf * 512 + lane * 8; w[r][hf] = *(const u32x4*)(H2 + o); y8[r][hf][0] = *(const u32x2*)(Y8 + o); y8[r][hf][1] = *(const u32x2*)(Y8 + (size_t)NTOK * DM + o); }
#pragma unroll
            for (int r = 0; r < 2; ++r) { f32x4 v[2][2]; float s = 0.f;
#pragma unroll
                for (int hf = 0; hf < 2; ++hf) { f32x4 a0, a1, b0, b1, c0, c1; unpack8(w[r][hf], a0, a1); unpack8_fp8(y8[r][hf][0], b0, b1); unpack8_fp8(y8[r][hf][1], c0, c1);
                    a0 += (b0 + c0) * 0.0625f; a1 += (b1 + c1) * 0.0625f; v[hf][0] = a0; v[hf][1] = a1; s += ssq8(a0, a1); }
                const float rstd = 1.0f / sqrtf(wave_sum(s) * (1.f / DM) + EPS); float* op_ = outp + (size_t)(m + r) * DM + lane * 8;
                *(f32x4*)(op_) = v[0][0] * rstd * g00; *(f32x4*)(op_ + 4) = v[0][1] * rstd * g01; *(f32x4*)(op_ + 512) = v[1][0] * rstd * g10; *(f32x4*)(op_ + 516) = v[1][1] * rstd * g11; }
        }
    }
#undef IN
#undef BOTH
#undef GRID_BAR
}

extern "C" void kernel_launch(void* const* d_in, const int* in_sizes, int n_in, void* d_out, int out_size, void* d_ws, size_t ws_size, hipStream_t stream) {
    static int grid = 0;
    if (grid == 0) {
        if (n_in != 28 || in_sizes[0] != NTOK * DM || out_size != NTOK * DM || ws_size < WS_END) { fprintf(stderr, "kernel_launch: unexpected shapes (n_in %d, in0 %d, out %d, ws %zu); nothing launched\n", n_in, n_in > 0 ? in_sizes[0] : -1, out_size, ws_size); grid = -1; return; }
        int dev = 0, cus = 0, per_cu = 0;
        if (hipGetDevice(&dev) != hipSuccess || hipDeviceGetAttribute(&cus, hipDeviceAttributeMultiprocessorCount, dev) != hipSuccess) { fprintf(stderr, "kernel_launch: device query failed\n"); grid = -1; return; }
        if (hipFuncSetAttribute((const void*)fwd_kernel, hipFuncAttributeMaxDynamicSharedMemorySize, LDS_BYTES) != hipSuccess) { fprintf(stderr, "kernel_launch: hipFuncSetAttribute failed\n"); grid = -1; return; }
        if (hipOccupancyMaxActiveBlocksPerMultiprocessor(&per_cu, (const void*)fwd_kernel, 512, LDS_BYTES) != hipSuccess || per_cu < 1) { fprintf(stderr, "kernel_launch: occupancy query reports %d blocks per CU\n", per_cu); }
        (void)hipGetLastError();
        grid = cus;
        if (grid > 256) grid = 256;
    }
    if (grid < 0) return;
    (void)hipMemsetAsync((char*)d_ws + WS_CTL, 0, CTL_ZERO_BYTES, stream);
    Args a{};
    for (int i = 0; i < 28; ++i) a.in[i] = d_in[i];
    a.out = (float*)d_out; a.ws = (unsigned char*)d_ws;
    if (MK_N_LAUNCHES == 1) { a.ph_lo = 0; a.ph_hi = NPHASE; hipLaunchKernelGGL(fwd_kernel, dim3(grid), dim3(512), LDS_BYTES, stream, a); }
    else for (int p = 0; p < NPHASE; ++p) { a.ph_lo = p; a.ph_hi = p + 1; hipLaunchKernelGGL(fwd_kernel, dim3(grid), dim3(512), LDS_BYTES, stream, a); }
    const hipError_t le = hipPeekAtLastError();
    if (le != hipSuccess) fprintf(stderr, "kernel_launch: launch failed: %s\n", hipGetErrorName(le));
}
```

```cpp
#include <hip/hip_runtime.h>
#include <cstdio>
#include <cstdint>
#include <type_traits>
#include <utility>

#ifndef PG8_SP2
#define PG8_SP2 1
#endif
#ifndef PG8_ALIGN_EPI
#define PG8_ALIGN_EPI 1
#endif
#ifndef MK_N_LAUNCHES
#define MK_N_LAUNCHES 1
#endif

#define GAS __attribute__((address_space(1)))
#define LAS __attribute__((address_space(3)))
typedef unsigned short bf16_t;
typedef short bf16x8 __attribute__((ext_vector_type(8)));
typedef short s16x4 __attribute__((ext_vector_type(4)));
typedef float f32x2 __attribute__((ext_vector_type(2)));
typedef float f32x4 __attribute__((ext_vector_type(4)));
typedef float f32x16 __attribute__((ext_vector_type(16)));
typedef unsigned u32x4 __attribute__((ext_vector_type(4)));
typedef unsigned u32x2 __attribute__((ext_vector_type(2)));
typedef int v4i_t __attribute__((ext_vector_type(4)));
typedef int v8i_t __attribute__((ext_vector_type(8)));
typedef GAS unsigned gu32;
#define RLX_AGENT __ATOMIC_RELAXED, __HIP_MEMORY_SCOPE_AGENT
#define LDS_WAIT() asm volatile("s_waitcnt lgkmcnt(0)" ::: "memory")
#define VM_WAIT() asm volatile("s_waitcnt vmcnt(0)" ::: "memory")

constexpr int DM = 1024, NBATCH = 16, SEQ = 4096, NTOK = NBATCH * SEQ;
constexpr int QLORA = 384, KVLORA = 256, ROPE = 32, POOLW = 512, NHEAD = 8, QKD = 96, VD = 64;
constexpr int MEMLEN = 256, NMEM = NBATCH * MEMLEN;
constexpr int NEXP = 32, EFF = 256;
constexpr int IN_COLS = 3232, IN_PAD = 3328;
constexpr float EPS = 1e-6f;
constexpr float C2Q = 0.10206207261596577f * 1.4426950408889634f;
constexpr float C2X = 0.0625f * 1.4426950408889634f;

constexpr size_t MiB = 1u << 20;
constexpr size_t WS_CTL = 0, CTL_ZERO_BYTES = 64 * 1024;
constexpr size_t WS_SMALL = 1 * MiB;
constexpr size_t OFF_SSQQ = WS_SMALL, OFF_SSQKV = OFF_SSQQ + 524288, OFF_SSQ1 = OFF_SSQKV + 524288, OFF_SSQ2 = OFF_SSQ1 + 524288, OFF_CNT = OFF_SSQ2 + 524288;
constexpr size_t SMALL_ZERO_BYTES = 4 * 524288 + 4096;
constexpr size_t WS_COS = 4 * MiB, WS_SIN = 8 * MiB;
constexpr size_t WS_WIN = 12 * MiB;
constexpr size_t WS_WQ = 19 * MiB;
constexpr size_t WS_WKVU = 20 * MiB;
constexpr size_t WS_WA = 21 * MiB, WS_WPB = 22 * MiB;
constexpr size_t WS_WMO = 23 * MiB, WS_WXKV = 27 * MiB, WS_WXO = 31 * MiB;
constexpr size_t WS_WR = 33 * MiB;
constexpr size_t WS_WGU = 34 * MiB;
constexpr size_t WS_WD = 66 * MiB;
constexpr size_t WS_MEMN = 82 * MiB, WS_KVM = 90 * MiB;
constexpr size_t WS_WIN8 = 122 * MiB;
constexpr size_t WS_WXQN = 120 * MiB;
constexpr size_t WS_BQK = 960 * MiB, WS_BVO = 992 * MiB;
constexpr size_t WS_LG = 106 * MiB;
constexpr size_t WS_S0 = 128 * MiB;
constexpr size_t WS_S1 = 256 * MiB;
constexpr size_t WS_S2 = 384 * MiB;
constexpr size_t WS_S3 = 512 * MiB;
constexpr size_t WS_S4 = 640 * MiB;
constexpr size_t WS_S5 = 768 * MiB;
constexpr size_t WS_S6 = 896 * MiB;
constexpr size_t WS_END = 1024 * MiB;
constexpr size_t WS_QLB = WS_S3, WS_KVLB = WS_S3 + 48 * MiB, WS_KRB = WS_S3 + 80 * MiB;
constexpr size_t WS_U = WS_S4, WS_DP = WS_S4 + 64 * MiB;
constexpr size_t WS_HID = WS_S4, WS_LIST = WS_S4 + 80 * MiB, WS_WL = WS_S4 + 88 * MiB, WS_RSL = WS_S4 + 96 * MiB;
constexpr size_t WS_KN = WS_S5, WS_V = WS_S5 + 64 * MiB;
constexpr size_t WS_ATT = WS_S6;

constexpr int RING_BYTES = 131072;
constexpr int MISC_OFF = RING_BYTES;
constexpr int LDS_BYTES = RING_BYTES + 24576;
constexpr int MO_BAR = 0;
constexpr int MO_HIST = 64, MO_BASE = 64 + 128;
constexpr int MO_CNTL = 1024, MO_TBASE = 1024 + 128, MO_TILEE = 2048;
constexpr int MAX_TILES = 544;
constexpr int MO_PS = 8192;

typedef __bf16 bf16x2_t __attribute__((ext_vector_type(2)));
__device__ __forceinline__ unsigned cvt_pk_bf16(float lo, float hi) { const f32x2 v = {lo, hi}; const bf16x2_t b = __builtin_convertvector(v, bf16x2_t); return __builtin_bit_cast(unsigned, b); }
__device__ __forceinline__ float bf_lo(unsigned w) { return __uint_as_float(w << 16); }
__device__ __forceinline__ float bf_hi(unsigned w) { return __uint_as_float(w & 0xffff0000u); }
__device__ __forceinline__ int lane_mb() { int l; asm volatile("v_mbcnt_lo_u32_b32 %0, -1, 0\n\tv_mbcnt_hi_u32_b32 %0, -1, %0" : "=v"(l)); return l; }
#define RELANE int tidq_ = wave * 64 + lane_mb(); asm volatile("" : "+v"(tidq_)); const int tid = tidq_, lane = tid & 63; (void)lane;
__device__ __forceinline__ void store8(bf16_t* p, const f32x4 v0, const f32x4 v1) {
    u32x4 w; w.x = cvt_pk_bf16(v0[0], v0[1]); w.y = cvt_pk_bf16(v0[2], v0[3]); w.z = cvt_pk_bf16(v1[0], v1[1]); w.w = cvt_pk_bf16(v1[2], v1[3]);
    *(u32x4*)p = w; }
__device__ __forceinline__ unsigned cvt4_fp8(float a, float b, float c, float d) { unsigned w = __float_as_uint(a);      w = __builtin_amdgcn_cvt_pk_fp8_f32(a, b, w, false); w = __builtin_amdgcn_cvt_pk_fp8_f32(c, d, w, true); return w; }
__device__ __forceinline__ void store8_fp8(unsigned char* p, const f32x4 v0, const f32x4 v1) { u32x2 w; w.x = cvt4_fp8(v0[0], v0[1], v0[2], v0[3]); w.y = cvt4_fp8(v1[0], v1[1], v1[2], v1[3]); *(u32x2*)p = w; }
__device__ __forceinline__ void unpack8_fp8(const u32x2 w, f32x4& v0, f32x4& v1) { const f32x2 a = __builtin_amdgcn_cvt_pk_f32_fp8((int)w.x, false), b = __builtin_amdgcn_cvt_pk_f32_fp8((int)w.x, true), c = __builtin_amdgcn_cvt_pk_f32_fp8((int)w.y, false), d = __builtin_amdgcn_cvt_pk_f32_fp8((int)w.y, true);
    v0 = (f32x4){a.x, a.y, b.x, b.y}; v1 = (f32x4){c.x, c.y, d.x, d.y}; }
__device__ __forceinline__ void load8(const bf16_t* p, f32x4& v0, f32x4& v1) {
    const u32x4 w = *(const u32x4*)p; v0 = (f32x4){bf_lo(w.x), bf_hi(w.x), bf_lo(w.y), bf_hi(w.y)}; v1 = (f32x4){bf_lo(w.z), bf_hi(w.z), bf_lo(w.w), bf_hi(w.w)}; }
__device__ __forceinline__ float fast_exp2(float x) { return __builtin_amdgcn_exp2f(x); }
__device__ __forceinline__ float sigmoidf_(float x) { return __builtin_amdgcn_rcpf(1.0f + fast_exp2(-1.4426950408889634f * x)); }
__device__ __forceinline__ float wave_sum(float v) {
#pragma unroll
    for (int o = 1; o < 64; o <<= 1) v += __shfl_xor(v, o);
    return v;
}

namespace pg8 {
#ifndef PG8_WGM
#define PG8_WGM 8
#endif
constexpr int BM = 256, BK = 64, HALF = 128, HTB = HALF * BK * 2, NXCD = 8, WGM = PG8_WGM;
__host__ __device__ __forceinline__ int lds_byte(int r, int c) { const int st = (r >> 4) * 2 + (c >> 5), rr = r & 15, cc = c & 31, ob = rr * 64 + cc * 2; return st * 1024 + (ob ^ (((ob >> 9) & 1) << 5)); }
__host__ __device__ __forceinline__ void stage_rc(int b, int& R, int& C) { const int st = b / 1024, sb = b % 1024, swz = sb ^ (((sb >> 9) & 1) << 5); R = (st >> 1) * 16 + swz / 64; C = (st & 1) * 32 + (swz % 64) / 2; }
__host__ __device__ __forceinline__ int perm32(int rho) { const int n = rho >> 4, i = rho & 15; return 8 * (i >> 2) + 4 * n + (i & 3); }
struct Unit { int pm, pn; };
struct StaticOrder {
    int nM, nN, nwg, G, c;
    __host__ __device__ __forceinline__ void init(int M, int N, int G_, int c_) { nM = M / BM; nN = N / BM; nwg = nM * nN; G = G_; c = c_; }
    __host__ __device__ __forceinline__ bool next(int i, Unit& u) const {
        const long L = (long)i * G + c; if (L >= nwg) return false;
        int wgid = (int)L; { const int q = nwg / NXCD, r = nwg % NXCD, xcd = wgid % NXCD, off = wgid / NXCD; wgid = (xcd < r ? xcd * (q + 1) : r * (q + 1) + (xcd - r) * q) + off; }
        const int nig = WGM * nN, gid = wgid / nig, fm = gid * WGM, gsz = (nM - fm) < WGM ? (nM - fm) : WGM;
        u.pm = fm + ((wgid % nig) % gsz); u.pn = (wgid % nig) / gsz; return true;
    }
};
struct ListOrder {
    int pm, n;
    __device__ __forceinline__ bool next(int i, Unit& u) const { if (i >= n) return false; u.pm = pm; u.pn = i; return true; }
};
template <class T, class = void> struct HasBrow : std::false_type {};
template <class T> struct HasBrow<T, std::void_t<decltype(std::declval<const T&>().brow(0))>> : std::true_type {};
template <class Op, class Sched>
__device__ __forceinline__ void gemm_phase(LAS unsigned char* lds, const Op& op, const Sched& S, const int wv_) {
    int tid_ = wv_ * 64 + lane_mb(); asm volatile("" : "+v"(tid_));
    const int tid = tid_, wid = __builtin_amdgcn_readfirstlane(tid >> 6), lane = tid & 63, wr = wid >> 2, wc = wid & 3, fr = lane & 15, fq = lane >> 4;
    const int K = op.K, nt = K / BK;
    unsigned voffA0[2], voffA1[2], voffB[2];
#pragma unroll
    for (int i = 0; i < 2; ++i) { int R, C; stage_rc(tid * 16 + i * 8192, R, C); int Rb = Op::PERM ? ((R & ~31) + perm32(R & 31)) : R; if constexpr (HasBrow<Op>::value) Rb = op.brow(Rb);
        if constexpr (!Op::GATHER) { voffA0[i] = op.a_off(R, C); voffA1[i] = 0u; } voffB[i] = (unsigned)(Rb * op.ldb + C) * 2u; }
    const size_t kstep = (size_t)(BK * 2);
    const size_t hstepB = (size_t)HALF * op.ldb * 2;
    size_t hstepA = 0; if constexpr (!Op::GATHER) hstepA = (size_t)op.a_off(HALF, 0);
    const unsigned ldsw = (unsigned)wid * 1024u;
    const int aoff = lds_byte(wr * 64 + fr, fq * 8), boff = lds_byte(wc * 32 + fr, fq * 8);
#define PG8_SA(b, h) (((b) * 2 + (h)) * HTB)
#define PG8_SB(b, h) ((4 + (b) * 2 + (h)) * HTB)
#define PG8_STAGE(bufoff, gbase, voff) do { _Pragma("unroll") for (int _i = 0; _i < 2; ++_i) \
        __builtin_amdgcn_global_load_lds((const unsigned*)((const char*)(gbase) + (voff)[_i]), (LAS unsigned*)(lds + (bufoff) + ldsw + _i * 8192), 16, 0, 0); } while (0)
#define PG8_STAGE_A1(bufoff, gbase, vg) do { if constexpr (Op::GATHER) PG8_STAGE(bufoff, gbase, vg); else PG8_STAGE(bufoff, (gbase) + hstepA, voffA0); } while (0)
#define PG8_LDA(dst, b, h) do { if constexpr (Op::FP8) { _Pragma("unroll") for (int m = 0; m < 4; ++m) dst##8[m] = __builtin_shufflevector(*(const LAS v4i_t*)(lds + PG8_SA(b, h) + aoff + m * 2048), *(const LAS v4i_t*)(lds + PG8_SA(b, h) + aoff + m * 2048 + 1024), 0, 1, 2, 3, 4, 5, 6, 7); } \
        else { _Pragma("unroll") for (int m = 0; m < 4; ++m) _Pragma("unroll") for (int k = 0; k < 2; ++k) dst[m][k] = *(const LAS bf16x8*)(lds + PG8_SA(b, h) + aoff + m * 2048 + k * 1024); } } while (0)
#define PG8_LDB(dst, b, h) do { if constexpr (Op::FP8) { _Pragma("unroll") for (int n = 0; n < 2; ++n) dst##8[n] = __builtin_shufflevector(*(const LAS v4i_t*)(lds + PG8_SB(b, h) + boff + n * 2048), *(const LAS v4i_t*)(lds + PG8_SB(b, h) + boff + n * 2048 + 1024), 0, 1, 2, 3, 4, 5, 6, 7); } \
        else { _Pragma("unroll") for (int n = 0; n < 2; ++n) _Pragma("unroll") for (int k = 0; k < 2; ++k) dst[n][k] = *(const LAS bf16x8*)(lds + PG8_SB(b, h) + boff + n * 2048 + k * 1024); } } while (0)
#define PG8_MMA(ai, bj, At, Bt) do { __builtin_amdgcn_s_setprio(1); _Pragma("unroll") for (int m = 0; m < 4; ++m) _Pragma("unroll") for (int n = 0; n < 2; ++n) _Pragma("unroll") for (int k = 0; k < 2; ++k) \
        acc[ai][bj][m][n] = __builtin_amdgcn_mfma_f32_16x16x32_bf16(Bt[n][k], At[m][k], acc[ai][bj][m][n], 0, 0, 0); __builtin_amdgcn_s_setprio(0); } while (0)
#define PG8_MMA8(ai, bj, At, Bt) do { __builtin_amdgcn_s_setprio(1); _Pragma("unroll") for (int m = 0; m < 4; ++m) _Pragma("unroll") for (int n = 0; n < 2; ++n) \
        asm volatile("v_mfma_scale_f32_16x16x128_f8f6f4 %0, %1, %2, %0, %3, %4 op_sel_hi:[0,0,0]" : "+v"(acc[ai][bj][m][n]) : "v"(Bt##8[n]), "v"(At##8[m]), "v"(sclW), "v"(sclA)); \
        __builtin_amdgcn_s_setprio(0); } while (0)
#define PG8_MMAX(ai, bj, At, Bt) do { if constexpr (Op::FP8) PG8_MMA8(ai, bj, At, Bt); else PG8_MMA(ai, bj, At, Bt); } while (0)
#define PG8_WAIT_V(n) asm volatile("s_waitcnt vmcnt(" #n ")" ::: "memory")
#define PG8_WAIT_L(n) asm volatile("s_waitcnt lgkmcnt(" #n ")" ::: "memory")
#define PG8_BAR __builtin_amdgcn_s_barrier()
#define PG8_SCHED __builtin_amdgcn_sched_barrier(0)
    Unit cur, nxt; int ui = 0;
    if (!S.next(0, cur)) return;
    unsigned nvA0[2], nvA1[2];
    if constexpr (Op::GATHER) {
#pragma unroll
        for (int i = 0; i < 2; ++i) { int R, C; stage_rc(tid * 16 + i * 8192, R, C); voffA0[i] = op.a_off_u(cur, R, C); voffA1[i] = op.a_off_u(cur, R + HALF, C); nvA0[i] = voffA0[i]; nvA1[i] = voffA1[i]; } }
    f32x4 acc[2][2][4][2];
#pragma unroll
    for (int a = 0; a < 2; ++a)
#pragma unroll
        for (int b = 0; b < 2; ++b)
#pragma unroll
            for (int m = 0; m < 4; ++m)
#pragma unroll
                for (int n = 0; n < 2; ++n) acc[a][b][m][n] = (f32x4){0.f, 0.f, 0.f, 0.f};
    int sclW = 0x7A7A7A7A, sclA = 0x7F7F7F7F; (void)sclW; (void)sclA;
    bf16x8 At[4][2], B0[2][2], B1[2][2]; v8i_t At8[4], B08[2], B18[2];
    const char* cA = op.a_base(cur); const char* cB = op.b_base(cur);
    if (PG8_SP2) {
        PG8_STAGE(PG8_SB(0, 0), cB, voffB); PG8_STAGE(PG8_SB(0, 1), cB + hstepB, voffB); PG8_STAGE(PG8_SA(0, 0), cA, voffA0); PG8_STAGE_A1(PG8_SA(0, 1), cA, voffA1);
        if (wr == 1) PG8_BAR;
        PG8_WAIT_V(2); PG8_BAR;
        PG8_STAGE(PG8_SB(1, 0), cB + kstep, voffB); PG8_STAGE(PG8_SA(1, 0), cA + kstep, voffA0); PG8_STAGE(PG8_SB(1, 1), cB + hstepB + kstep, voffB);
        PG8_WAIT_V(6); PG8_BAR;
    } else {
    PG8_STAGE(PG8_SB(0, 0), cB, voffB); PG8_STAGE(PG8_SA(0, 0), cA, voffA0); PG8_STAGE(PG8_SB(0, 1), cB + hstepB, voffB); PG8_STAGE_A1(PG8_SA(0, 1), cA, voffA1);
    if (wr == 1) PG8_BAR;
    PG8_WAIT_V(4); PG8_BAR;
    PG8_STAGE(PG8_SB(1, 0), cB + kstep, voffB); PG8_STAGE(PG8_SA(1, 0), cA + kstep, voffA0); PG8_STAGE(PG8_SB(1, 1), cB + hstepB + kstep, voffB);
    PG8_WAIT_V(6); PG8_BAR;
    }
    for (;;) {
        const bool has_next = S.next(ui + 1, nxt);
        const char* nA = has_next ? op.a_base(nxt) : cA; const char* nB = has_next ? op.b_base(nxt) : cB;
        if constexpr (Op::GATHER) { if (has_next) {
#pragma unroll
            for (int i = 0; i < 2; ++i) { int R, C; stage_rc(tid * 16 + i * 8192, R, C); nvA0[i] = op.a_off_u(nxt, R, C); nvA1[i] = op.a_off_u(nxt, R + HALF, C); } } }
        for (int t = 0; t < nt; t += 2) {
            const bool last = (t == nt - 2);
            if constexpr (Op::GATHER) asm volatile("" : "+v"(voffA1[0]), "+v"(voffA1[1]));
            asm volatile("" : "+v"(voffA0[0]), "+v"(voffA0[1]), "+v"(voffB[0]), "+v"(voffB[1]));
            const char* a1 = cA + (size_t)(t + 1) * kstep;
            const char* a2 = last ? nA : cA + (size_t)(t + 2) * kstep; const char* b2 = last ? nB : cB + (size_t)(t + 2) * kstep;
            const char* a3 = a2 + kstep; const char* b3 = b2 + kstep;
            unsigned sA0[2], sA1[2];
#pragma unroll
            for (int i = 0; i < 2; ++i) { if constexpr (Op::GATHER) { sA0[i] = last ? nvA0[i] : voffA0[i]; sA1[i] = last ? nvA1[i] : voffA1[i]; } else { sA0[i] = voffA0[i]; sA1[i] = voffA1[i]; } }
            if (PG8_SP2) {
            const bool fresh = (t == 0) && (ui > 0);
            PG8_LDB(B0, 0, 0); PG8_LDB(B1, 0, 1); PG8_SCHED; PG8_LDA(At, 0, 0); if (!fresh) PG8_STAGE_A1(PG8_SA(1, 1), a1, voffA1);
            if (!fresh) PG8_WAIT_V(8); PG8_WAIT_L(0); PG8_BAR; PG8_MMAX(0, 0, At, B0); PG8_MMAX(0, 1, At, B1); PG8_BAR; PG8_SCHED;
            PG8_LDA(At, 0, 1); PG8_STAGE(PG8_SB(0, 0), b2, voffB); PG8_STAGE(PG8_SB(0, 1), b2 + hstepB, voffB); PG8_STAGE(PG8_SA(0, 0), a2, sA0);
            if (!fresh) PG8_WAIT_V(8); PG8_WAIT_L(0); PG8_BAR; PG8_MMAX(1, 0, At, B0); PG8_MMAX(1, 1, At, B1); PG8_BAR; PG8_SCHED;
            PG8_LDB(B0, 1, 0); PG8_LDB(B1, 1, 1); PG8_SCHED; PG8_LDA(At, 1, 0); PG8_STAGE_A1(PG8_SA(0, 1), a2, sA1);
            if (!fresh) PG8_WAIT_V(8); PG8_WAIT_L(0); PG8_BAR; PG8_MMAX(0, 0, At, B0); PG8_MMAX(0, 1, At, B1); PG8_BAR; PG8_SCHED;
            PG8_LDA(At, 1, 1); PG8_STAGE(PG8_SB(1, 0), b3, voffB); PG8_STAGE(PG8_SB(1, 1), b3 + hstepB, voffB); PG8_STAGE(PG8_SA(1, 0), a3, sA0);
            if (!fresh) PG8_WAIT_V(8); PG8_WAIT_L(0); PG8_BAR; PG8_MMAX(1, 0, At, B0); PG8_MMAX(1, 1, At, B1); PG8_BAR; PG8_SCHED;
            } else {
            PG8_LDB(B0, 0, 0); PG8_SCHED; PG8_LDA(At, 0, 0); PG8_STAGE_A1(PG8_SA(1, 1), a1, voffA1);
            PG8_WAIT_L(8); PG8_BAR; PG8_WAIT_L(0); PG8_MMAX(0, 0, At, B0); PG8_BAR; PG8_SCHED;
            PG8_LDB(B1, 0, 1); PG8_STAGE(PG8_SB(0, 0), b2, voffB);
            PG8_BAR; PG8_WAIT_L(0); PG8_MMAX(0, 1, At, B1); PG8_BAR;
            PG8_LDA(At, 0, 1); PG8_STAGE(PG8_SA(0, 0), a2, sA0);
            PG8_BAR; PG8_WAIT_L(0); PG8_MMAX(1, 0, At, B0); PG8_BAR; PG8_SCHED;
            PG8_STAGE(PG8_SB(0, 1), b2 + hstepB, voffB);
            PG8_WAIT_V(6); PG8_BAR; PG8_MMAX(1, 1, At, B1); PG8_BAR;
            PG8_LDB(B0, 1, 0); PG8_SCHED; PG8_LDA(At, 1, 0); PG8_STAGE_A1(PG8_SA(0, 1), a2, sA1);
            PG8_WAIT_L(8); PG8_BAR; PG8_WAIT_L(0); PG8_MMAX(0, 0, At, B0); PG8_BAR; PG8_SCHED;
            PG8_LDB(B1, 1, 1); PG8_STAGE(PG8_SB(1, 0), b3, voffB);
            PG8_BAR; PG8_WAIT_L(0); PG8_MMAX(0, 1, At, B1); PG8_BAR;
            PG8_LDA(At, 1, 1); PG8_STAGE(PG8_SA(1, 0), a3, sA0);
            PG8_BAR; PG8_WAIT_L(0); PG8_MMAX(1, 0, At, B0); PG8_BAR; PG8_SCHED;
            PG8_STAGE(PG8_SB(1, 1), b3 + hstepB, voffB);
            PG8_WAIT_V(6); PG8_BAR; PG8_MMAX(1, 1, At, B1); PG8_BAR;
            }
        }
        if constexpr (Op::FP8) asm volatile("s_nop 15\n\ts_nop 15" ::: "memory");
        if (PG8_ALIGN_EPI) { if (wr == 0) PG8_BAR; }
        if (PG8_SP2 && PG8_ALIGN_EPI && has_next) {
            if constexpr (Op::GATHER) { PG8_STAGE_A1(PG8_SA(1, 1), nA + kstep, nvA1); } else { PG8_STAGE_A1(PG8_SA(1, 1), nA + kstep, voffA1); } }
        {
          int lane_e = (int)__builtin_amdgcn_mbcnt_hi(~0u, __builtin_amdgcn_mbcnt_lo(~0u, 0u)); asm volatile("" : "+v"(lane_e));
          const int src_ = ((((lane_e & 3) << 4) | (lane_e >> 2)) << 2);
#pragma unroll
          for (int a = 0; a < 2; ++a)
#pragma unroll
              for (int b = 0; b < 2; ++b)
#pragma unroll
                  for (int m = 0; m < 4; ++m)
#pragma unroll
                      for (int n = 0; n < 2; ++n)
#pragma unroll
                          for (int j = 0; j < 4; ++j) acc[a][b][m][n][j] = __int_as_float(__builtin_amdgcn_ds_bpermute(src_, __float_as_int(acc[a][b][m][n][j])));
          if (PG8_SP2 && PG8_ALIGN_EPI) PG8_WAIT_V(0);
          op.epi(acc, cur, wr, wc, lane_e >> 2, lane_e & 3); }
        if (!has_next) break;
#pragma unroll
        for (int a = 0; a < 2; ++a)
#pragma unroll
            for (int b = 0; b < 2; ++b)
#pragma unroll
                for (int m = 0; m < 4; ++m)
#pragma unroll
                    for (int n = 0; n < 2; ++n) acc[a][b][m][n] = (f32x4){0.f, 0.f, 0.f, 0.f};
        cur = nxt; cA = nA; cB = nB; ++ui;
        if constexpr (Op::GATHER) {
#pragma unroll
            for (int i = 0; i < 2; ++i) { voffA0[i] = nvA0[i]; voffA1[i] = nvA1[i]; } }
        if (PG8_ALIGN_EPI) { if (wr == 1) PG8_BAR; }
    }
    PG8_WAIT_V(0);
    if (!PG8_ALIGN_EPI) { if (wr == 0) PG8_BAR; }
    PG8_BAR;
#undef PG8_SA
#undef PG8_SB
#undef PG8_STAGE
#undef PG8_LDA
#undef PG8_STAGE_A1
#undef PG8_LDB
#undef PG8_MMA
#undef PG8_MMA8
#undef PG8_MMAX
#undef PG8_WAIT_V
#undef PG8_WAIT_L
#undef PG8_BAR
#undef PG8_SCHED
}
}
using pg8::Unit;
typedef f32x4 Acc[2][2][4][2];

struct RopeCS { f32x4 c0, c1, s0, s1; };
__device__ __forceinline__ RopeCS rope_load(const float* cosT, const float* sinT, int row, int fq) { const int i0 = 8 * (fq & 1); RopeCS r;
    r.c0 = *(const f32x4*)(cosT + (size_t)row * 16 + i0); r.c1 = *(const f32x4*)(cosT + (size_t)row * 16 + i0 + 4); r.s0 = *(const f32x4*)(sinT + (size_t)row * 16 + i0); r.s1 = *(const f32x4*)(sinT + (size_t)row * 16 + i0 + 4); return r; }
__device__ __forceinline__ void rope_apply(f32x4& v0, f32x4& v1, const RopeCS& r, int fq) {
    f32x4 p0, p1;
#pragma unroll
    for (int j = 0; j < 4; ++j) { p0[j] = __shfl_xor(v0[j], 2); p1[j] = __shfl_xor(v1[j], 2); }
    if (fq < 2) { v0 = v0 * r.c0 - p0 * r.s0; v1 = v1 * r.c1 - p1 * r.s1; } else { v0 = v0 * r.c0 + p0 * r.s0; v1 = v1 * r.c1 + p1 * r.s1; }
}
__device__ __forceinline__ void rope8(f32x4& v0, f32x4& v1, const float* cosT, const float* sinT, int row, int fq) {
    f32x4 p0, p1;
#pragma unroll
    for (int j = 0; j < 4; ++j) { p0[j] = __shfl_xor(v0[j], 2); p1[j] = __shfl_xor(v1[j], 2); }
    const int i0 = 8 * (fq & 1);
    const f32x4 c0 = *(const f32x4*)(cosT + (size_t)row * 16 + i0), c1 = *(const f32x4*)(cosT + (size_t)row * 16 + i0 + 4);
    const f32x4 s0 = *(const f32x4*)(sinT + (size_t)row * 16 + i0), s1 = *(const f32x4*)(sinT + (size_t)row * 16 + i0 + 4);
    if (fq < 2) { v0 = v0 * c0 - p0 * s0; v1 = v1 * c1 - p1 * s1; }
    else        { v0 = v0 * c0 + p0 * s0; v1 = v1 * c1 + p1 * s1; }
}
__device__ __forceinline__ float ssq8(const f32x4 v0, const f32x4 v1) { return (v0[0] * v0[0] + v0[1] * v0[1]) + (v0[2] * v0[2] + v0[3] * v0[3]) + (v1[0] * v1[0] + v1[1] * v1[1]) + (v1[2] * v1[2] + v1[3] * v1[3]); }
typedef unsigned long long u64;
constexpr float FX_SCALE = 16777216.0f, FX_INV = 1.0f / 16777216.0f;
__device__ __forceinline__ void row_atomic_add(u64* p, float s, int fq) { s += __shfl_xor(s, 1); s += __shfl_xor(s, 2); if (fq == 0) __hip_atomic_fetch_add(p, (u64)(s * FX_SCALE + 0.5f), RLX_AGENT); }
__device__ __forceinline__ float fx_load(const u64* p) { return (float)(*p) * FX_INV; }

#ifndef EPI_FENCE
#define EPI_FENCE
#endif
#define RT_(ai, m) ((ai) * 128 + wr * 64 + (m) * 16 + fr)
#define FOR_AI _Pragma("unroll") for (int ai = 0; ai < 2; ++ai)
#define FOR_M _Pragma("unroll") for (int m = 0; m < 4; ++m)
#define FOR_BJ _Pragma("unroll") for (int bj = 0; bj < 2; ++bj)
__device__ __forceinline__ void unpack8(const u32x4 w, f32x4& v0, f32x4& v1) { v0 = (f32x4){bf_lo(w.x), bf_hi(w.x), bf_lo(w.y), bf_hi(w.y)}; v1 = (f32x4){bf_lo(w.z), bf_hi(w.z), bf_lo(w.w), bf_hi(w.w)}; }
#define EPI_ROWS(...) _Pragma("unroll") for (int ai = 0; ai < 2; ++ai) _Pragma("unroll") for (int m = 0; m < 4; ++m) { const int rt = ai * 128 + wr * 64 + m * 16 + fr; __VA_ARGS__ EPI_FENCE }

template <bool F8> struct OpInT {
    static constexpr bool PERM = true, GATHER = false, FP8 = F8;
    const bf16_t* A; const bf16_t* Bt; int K, lda, ldb;
    bf16_t *QLb, *KVLb, *KRb, *U, *GA, *GB; u64 *ssq_q, *ssq_kv; const float *cosT, *sinT;
    __device__ __forceinline__ unsigned a_off(int r, int c) const { return (unsigned)(r * lda + c) * 2u; }
    __device__ __forceinline__ const char* a_base(const Unit& u) const { return (const char*)(A + (size_t)u.pm * 256 * lda); }
    __device__ __forceinline__ const char* b_base(const Unit& u) const { return (const char*)(Bt + (size_t)u.pn * 256 * ldb); }
    __device__ __forceinline__ void epi(const Acc& acc, const Unit& u, int wr, int wc, int fr, int fq) const {
        const int row0 = u.pm * 256, col = 32 * wc + 8 * fq;
#pragma unroll
        for (int bj = 0; bj < 2; ++bj) {
            const int hc = u.pn * 2 + bj;
            if (hc < 5) {
                u64* ssq = hc < 3 ? ssq_q : ssq_kv;
                if constexpr (F8) {
                    unsigned char* dst = hc < 3 ? (unsigned char*)QLb + hc * 128 : (unsigned char*)KVLb + (hc - 3) * 128; const int pitch = hc < 3 ? 512 : 256;
                    EPI_ROWS( const int row = row0 + rt; const f32x4 v0 = acc[ai][bj][m][0], v1 = acc[ai][bj][m][1];
                        row_atomic_add(ssq + row, ssq8(v0, v1), fq); store8_fp8(dst + (size_t)row * pitch + col, v0, v1);
                        if (hc == 2) *(u32x2*)(dst + (size_t)row * pitch + col + 128) = (u32x2){0u, 0u}; )
                } else {
                bf16_t* dst = hc < 3 ? QLb + hc * 128 : KVLb + (hc - 3) * 128; const int pitch = hc < 3 ? QLORA : KVLORA;
                EPI_ROWS( const int row = row0 + rt; const f32x4 v0 = acc[ai][bj][m][0], v1 = acc[ai][bj][m][1];
                    row_atomic_add(ssq + row, ssq8(v0, v1), fq); store8(dst + (size_t)row * pitch + col, v0, v1); )
                }
            } else if (hc == 5) {
                if (wc == 0) { FOR_AI { RopeCS cs[4]; FOR_M cs[m] = rope_load(cosT, sinT, row0 + RT_(ai, m), fq);
                    FOR_M { const int row = row0 + RT_(ai, m); f32x4 v0 = acc[ai][bj][m][0], v1 = acc[ai][bj][m][1]; rope_apply(v0, v1, cs[m], fq);
                        if constexpr (F8) store8_fp8((unsigned char*)KRb + (size_t)row * ROPE + col, v0, v1);
                        else store8(KRb + (size_t)row * ROPE + col, v0, v1); } } }
            } else if (hc < 10) {
                bf16_t* dst = U + (hc - 6) * 128;
                EPI_ROWS( const int row = row0 + rt; store8(dst + (size_t)row * POOLW + col, acc[ai][bj][m][0], acc[ai][bj][m][1]); )
            } else {
                bf16_t* dst = hc < 18 ? GA + (hc - 10) * 128 : GB + (hc - 18) * 128;
                EPI_ROWS( const int row = row0 + rt; f32x4 v0 = acc[ai][bj][m][0], v1 = acc[ai][bj][m][1];
                    _Pragma("unroll") for (int j = 0; j < 4; ++j) { v0[j] = sigmoidf_(v0[j]); v1[j] = sigmoidf_(v1[j]); }
                    store8(dst + (size_t)row * DM + col, v0, v1); )
            }
        }
    }
};
typedef OpInT<false> OpIn; typedef OpInT<true> OpIn8;
struct OpGate8 {
    static constexpr bool PERM = true, GATHER = false, FP8 = true;
    const bf16_t* A; const bf16_t* Bt; int K, lda, ldb;
    bf16_t *GA, *GB;
    __device__ __forceinline__ unsigned a_off(int r, int c) const { return (unsigned)(r * lda + c) * 2u; }
    __device__ __forceinline__ const char* a_base(const Unit& u) const { return (const char*)(A + (size_t)u.pm * 256 * lda); }
    __device__ __forceinline__ const char* b_base(const Unit& u) const { return (const char*)(Bt + (size_t)u.pn * 256 * ldb); }
    __device__ __forceinline__ void epi(const Acc& acc, const Unit& u, int wr, int wc, int fr, int fq) const {
        const size_t off = (size_t)u.pm * 256 * DM + ((u.pn - 5) & 3) * 256 + 32 * wc + 8 * fq;
        FOR_AI FOR_M FOR_BJ { f32x4 v0 = acc[ai][bj][m][0], v1 = acc[ai][bj][m][1];
            _Pragma("unroll") for (int j = 0; j < 4; ++j) { v0[j] = sigmoidf_(v0[j]); v1[j] = sigmoidf_(v1[j]); }
            if (u.pn < 9) store8_fp8((unsigned char*)GA + off + (size_t)RT_(ai, m) * DM + bj * 128, v0 * 256.f, v1 * 256.f);
            else store8(GB + off + (size_t)RT_(ai, m) * DM + bj * 128, v0, v1); }
    }
};
struct OffsetOrder { pg8::StaticOrder s; int off; __device__ __forceinline__ bool next(int i, Unit& u) const { if (!s.next(i, u)) return false; u.pn += off; return true; } };
struct OpPlain {
    static constexpr bool PERM = true, GATHER = false, FP8 = false;
    const bf16_t* A; const bf16_t* Bt; int K, lda, ldb;
    bf16_t* O; int ldo;
    __device__ __forceinline__ unsigned a_off(int r, int c) const { return (unsigned)(r * lda + c) * 2u; }
    __device__ __forceinline__ const char* a_base(const Unit& u) const { return (const char*)(A + (size_t)u.pm * 256 * lda); }
    __device__ __forceinline__ const char* b_base(const Unit& u) const { return (const char*)(Bt + (size_t)u.pn * 256 * ldb); }
    __device__ __forceinline__ void epi(const Acc& acc, const Unit& u, int wr, int wc, int fr, int fq) const {
        bf16_t* base = O + (size_t)u.pm * 256 * ldo + u.pn * 256 + 32 * wc + 8 * fq;
        EPI_ROWS( _Pragma("unroll") for (int bj = 0; bj < 2; ++bj) store8(base + (size_t)rt * ldo + bj * 128, acc[ai][bj][m][0], acc[ai][bj][m][1]); )
    }
};
__device__ __forceinline__ int key_of_slot(int sl) { const int hi = sl >> 5, j = sl & 31, jj = j & 15; return ((j >> 4) << 5) + (jj & 3) + 8 * (jj >> 2) + 4 * hi; }
struct OpQ {
    static constexpr bool PERM = true, GATHER = false, FP8 = true;
    const bf16_t* A; const bf16_t* Bt; int K, lda, ldb;
    unsigned char* Q  ; const u64* ssq_q; const float *cosT, *sinT;
    __device__ __forceinline__ unsigned a_off(int r, int c) const { return (unsigned)(r * lda + c) * 2u; }
    __device__ __forceinline__ const char* a_base(const Unit& u) const { return (const char*)(A + (size_t)u.pm * 256 * lda); }
    __device__ __forceinline__ const char* b_base(const Unit& u) const { return (const char*)(Bt + (size_t)u.pn * 256 * ldb); }
    __device__ __forceinline__ void epi(const Acc& acc, const Unit& u, int wr, int wc, int fr, int fq) const {
        float rs[2][4]; FOR_AI FOR_M rs[ai][m] = fx_load(ssq_q + u.pm * 256 + RT_(ai, m));
        FOR_AI FOR_M rs[ai][m] = 16.f * C2Q * __builtin_amdgcn_rsqf(rs[ai][m] * (1.0f / QLORA) + EPS);
        const int g0 = u.pn * 8 + wc; const bool rp0 = (g0 % 3 == 2), rp1 = ((g0 + 4) % 3 == 2);
        FOR_AI _Pragma("unroll") for (int m0 = 0; m0 < 4; m0 += 2) { RopeCS cs[2]; if (rp0 || rp1) { _Pragma("unroll") for (int mi = 0; mi < 2; ++mi) cs[mi] = rope_load(cosT, sinT, u.pm * 256 + RT_(ai, m0 + mi), fq); }
            _Pragma("unroll") for (int mi = 0; mi < 2; ++mi) { const int m = m0 + mi; const int row = u.pm * 256 + RT_(ai, m);
                FOR_BJ { const int g32 = g0 + bj * 4; f32x4 v0 = acc[ai][bj][m][0] * rs[ai][m], v1 = acc[ai][bj][m][1] * rs[ai][m];
                    if (bj == 0 ? rp0 : rp1) rope_apply(v0, v1, cs[mi], fq);
                    unsigned char* qd = Q + (size_t)row * 1024 + (g32 / 3) * 128 + (g32 % 3) * 32 + 8 * fq; store8_fp8(qd, v0, v1); if (bj == 0 ? rp0 : rp1) *(u32x2*)(qd + 32) = (u32x2){0u, 0u}; } } }
    }
};
struct OpK8 {
    static constexpr bool PERM = true, GATHER = false, FP8 = true;
    const bf16_t* A; const bf16_t* Bt; int K, lda, ldb;
    unsigned char* K8; const u64* ssq_kv;
    __device__ __forceinline__ unsigned a_off(int r, int c) const { return (unsigned)(r * lda + c) * 2u; }
    __device__ __forceinline__ const char* a_base(const Unit& u) const { return (const char*)(A + (size_t)u.pm * 256 * lda); }
    __device__ __forceinline__ const char* b_base(const Unit& u) const { return (const char*)(Bt + (size_t)u.pn * 256 * ldb); }
    __device__ __forceinline__ void epi(const Acc& acc, const Unit& u, int wr, int wc, int fr, int fq) const {
        float rs[2][4]; FOR_AI FOR_M rs[ai][m] = fx_load(ssq_kv + u.pm * 256 + RT_(ai, m));
        FOR_AI FOR_M { const int row = u.pm * 256 + RT_(ai, m); const float r_ = __builtin_amdgcn_rsqf(rs[ai][m] * (1.0f / KVLORA) + EPS);
            FOR_BJ { const int col = u.pn * 256 + bj * 128 + 32 * wc + 8 * fq; store8_fp8(K8 + (size_t)row * 512 + col, acc[ai][bj][m][0] * r_, acc[ai][bj][m][1] * r_); } }
    }
};
struct OpVT {
    static constexpr bool PERM = true, GATHER = false, FP8 = true;
    const bf16_t* A; const bf16_t* Bt; int K, lda, ldb;
    unsigned char* VT8; const u64* ssq_kv;
    __device__ __forceinline__ int brow(int c) const { return (c & ~63) + key_of_slot(c & 63); }
    __device__ __forceinline__ unsigned a_off(int r, int c) const { return (unsigned)(r * lda + c) * 2u; }
    __device__ __forceinline__ const char* a_base(const Unit& u) const { return (const char*)(A + (size_t)u.pm * 256 * lda); }
    __device__ __forceinline__ const char* b_base(const Unit& u) const { return (const char*)(Bt + (size_t)u.pn * 256 * ldb); }
    __device__ __forceinline__ void epi(const Acc& acc, const Unit& u, int wr, int wc, int fr, int fq) const {
        float rs[2][2][4];
        FOR_BJ _Pragma("unroll") for (int n = 0; n < 2; ++n) _Pragma("unroll") for (int j = 0; j < 4; ++j) { const int c = bj * 128 + 32 * wc + 8 * fq + 4 * n + j; rs[bj][n][j] = fx_load(ssq_kv + u.pn * 256 + (c & ~63) + key_of_slot(c & 63)); }
        FOR_BJ _Pragma("unroll") for (int n = 0; n < 2; ++n) _Pragma("unroll") for (int j = 0; j < 4; ++j) rs[bj][n][j] = __builtin_amdgcn_rsqf(rs[bj][n][j] * (1.0f / KVLORA) + EPS);
        FOR_AI FOR_M FOR_BJ { f32x4 v0 = acc[ai][bj][m][0], v1 = acc[ai][bj][m][1];
            _Pragma("unroll") for (int j = 0; j < 4; ++j) { v0[j] *= rs[bj][0][j]; v1[j] *= rs[bj][1][j]; }
            const size_t grp = (size_t)u.pn * 4 + 2 * bj + (wc >> 1);
            store8_fp8(VT8 + (grp * 512 + u.pm * 256 + RT_(ai, m)) * 64 + (wc & 1) * 32 + 8 * fq, v0, v1); }
    }
};
struct OpYB {
    static constexpr bool PERM = true, GATHER = false, FP8 = false;
    const bf16_t* A; const bf16_t* Bt; int K, lda, ldb;
    bf16_t* GBM;
    __device__ __forceinline__ unsigned a_off(int r, int c) const { return (unsigned)(r * lda + c) * 2u; }
    __device__ __forceinline__ const char* a_base(const Unit& u) const { return (const char*)(A + (size_t)u.pm * 256 * lda); }
    __device__ __forceinline__ const char* b_base(const Unit& u) const { return (const char*)(Bt + (size_t)u.pn * 256 * ldb); }
    __device__ __forceinline__ void epi(const Acc& acc, const Unit& u, int wr, int wc, int fr, int fq) const {
        bf16_t* base = GBM + (size_t)u.pm * 256 * DM + u.pn * 256 + 32 * wc + 8 * fq;
        u32x4 gb[2][4][2]; FOR_AI FOR_M FOR_BJ gb[ai][m][bj] = *(const u32x4*)(base + (size_t)RT_(ai, m) * DM + bj * 128);
        FOR_AI FOR_M FOR_BJ { f32x4 g0, g1; unpack8(gb[ai][m][bj], g0, g1); store8(base + (size_t)RT_(ai, m) * DM + bj * 128, g0 * acc[ai][bj][m][0], g1 * acc[ai][bj][m][1]); }
    }
};
struct OpYA {
    static constexpr bool PERM = true, GATHER = false, FP8 = true;
    const bf16_t* A; const bf16_t* Bt; int K, lda, ldb;
    const bf16_t* GA; bf16_t* MB; unsigned char* M8;
    __device__ __forceinline__ unsigned a_off(int r, int c) const { return (unsigned)(r * lda + c) * 2u; }
    __device__ __forceinline__ const char* a_base(const Unit& u) const { return (const char*)(A + (size_t)u.pm * 256 * lda); }
    __device__ __forceinline__ const char* b_base(const Unit& u) const { return (const char*)(Bt + (size_t)u.pn * 256 * ldb); }
    __device__ __forceinline__ void epi(const Acc& acc, const Unit& u, int wr, int wc, int fr, int fq) const {
        const size_t off0 = (size_t)u.pm * 256 * DM + u.pn * 256 + 32 * wc + 8 * fq;
        FOR_AI { u32x2 ga[4][2]; u32x4 mb[4][2]; FOR_M FOR_BJ { const size_t off = off0 + (size_t)RT_(ai, m) * DM + bj * 128; ga[m][bj] = *(const u32x2*)((const unsigned char*)GA + off); mb[m][bj] = *(const u32x4*)(MB + off); }
            FOR_M FOR_BJ { const size_t off = off0 + (size_t)RT_(ai, m) * DM + bj * 128; f32x4 g0, g1, b0, b1; unpack8_fp8(ga[m][bj], g0, g1); unpack8(mb[m][bj], b0, b1);
                store8_fp8(M8 + off, (g0 * (acc[ai][bj][m][0] * (0.0625f / 256.f)) + b0) * 4.f, (g1 * (acc[ai][bj][m][1] * (0.0625f / 256.f)) + b1) * 4.f); } }
    }
};
template <bool BASE_F32, bool F8 = false> struct OpRes {
    static constexpr bool PERM = true, GATHER = false, FP8 = F8;
    const bf16_t* A; const bf16_t* Bt; int K, lda, ldb;
    const void* base; bf16_t* Hout; u64* ssq; size_t bbatch;
    unsigned char* H8; float ascale;
    __device__ __forceinline__ unsigned a_off(int r, int c) const { return (unsigned)(r * lda + c) * 2u; }
    __device__ __forceinline__ const char* a_base(const Unit& u) const { return (const char*)(A + (size_t)u.pm * 256 * lda); }
    __device__ __forceinline__ const char* b_base(const Unit& u) const { return (const char*)(Bt + (size_t)(u.pm >> 4) * bbatch + (size_t)u.pn * 256 * ldb); }
    __device__ __forceinline__ void epi(const Acc& acc, const Unit& u, int wr, int wc, int fr, int fq) const {
        const size_t off0 = (size_t)u.pm * 256 * DM + u.pn * 256 + 32 * wc + 8 * fq;
        constexpr int MB_ = 4;
        FOR_AI _Pragma("unroll") for (int m0 = 0; m0 < 4; m0 += MB_) { f32x4 bv[MB_][2][2];
            _Pragma("unroll") for (int mi = 0; mi < MB_; ++mi) FOR_BJ { const size_t off = off0 + (size_t)RT_(ai, m0 + mi) * DM + bj * 128;
                if (BASE_F32) { bv[mi][bj][0] = *(const f32x4*)((const float*)base + off); bv[mi][bj][1] = *(const f32x4*)((const float*)base + off + 4); } else load8((const bf16_t*)base + off, bv[mi][bj][0], bv[mi][bj][1]); }
            _Pragma("unroll") for (int mi = 0; mi < MB_; ++mi) { const int m = m0 + mi; float s = 0.f;
                FOR_BJ { const size_t off = off0 + (size_t)RT_(ai, m) * DM + bj * 128; const f32x4 h0 = bv[mi][bj][0] + acc[ai][bj][m][0] * ascale, h1 = bv[mi][bj][1] + acc[ai][bj][m][1] * ascale; s += ssq8(h0, h1); store8(Hout + off, h0, h1); if (H8) store8_fp8(H8 + off, h0, h1); }
                row_atomic_add(ssq + u.pm * 256 + RT_(ai, m), s, fq); }
            asm volatile("" ::: "memory"); }
    }
};
struct OpPre {
    static constexpr bool PERM = true, GATHER = false, FP8 = false;
    const bf16_t* KVM; const bf16_t* W; int K, lda, ldb; unsigned char* O; int mode;
    __device__ __forceinline__ unsigned a_off(int r, int c) const { return (unsigned)(r * lda + c) * 2u; }
    __device__ __forceinline__ const char* a_base(const Unit& u) const { return mode == 0 ? (const char*)(KVM + (size_t)(u.pm >> 2) * 256 * 2048 + (u.pm & 3) * 256) : (const char*)(W + (size_t)(u.pm & 3) * 256 * DM + u.pn * 256); }
    __device__ __forceinline__ const char* b_base(const Unit& u) const { return mode == 0 ? (const char*)(W + (size_t)u.pn * 256 * DM + (u.pm & 3) * 256) : (const char*)(KVM + (size_t)(u.pm >> 2) * 256 * 2048 + DM + u.pn * 256); }
    __device__ __forceinline__ void epi(const Acc& acc, const Unit& u, int wr, int wc, int fr, int fq) const {
        unsigned char* base = O + (size_t)u.pm * 256 * DM + u.pn * 256 + 32 * wc + 8 * fq;
        FOR_AI FOR_M FOR_BJ store8_fp8(base + (size_t)RT_(ai, m) * DM + bj * 128, acc[ai][bj][m][0] * 32.f, acc[ai][bj][m][1] * 32.f);
    }
};
struct OpSX {
    static constexpr bool PERM = true, GATHER = false, FP8 = true;
    const bf16_t* A; const bf16_t* BQK; int K, lda, ldb;
    unsigned char* P; const u64* ssq1; LAS f32x4* ps;
    __device__ __forceinline__ unsigned a_off(int r, int c) const { return (unsigned)(r * lda + c) * 2u; }
    __device__ __forceinline__ const char* a_base(const Unit& u) const { return (const char*)(A + (size_t)u.pm * 256 * lda); }
    __device__ __forceinline__ const char* b_base(const Unit& u) const { return (const char*)(BQK + ((size_t)(u.pm >> 4) * DM + u.pn * 256) * ldb); }
    __device__ __forceinline__ void epi(Acc& acc, const Unit& u, int wr, int wc, int fr, int fq) const {
        float rs[2][4]; FOR_AI FOR_M rs[ai][m] = fx_load(ssq1 + u.pm * 256 + RT_(ai, m));
        FOR_AI FOR_M { const float r_ = C2X * __builtin_amdgcn_rsqf(rs[ai][m] * (1.0f / DM) + EPS); float s = 0.f;
            FOR_BJ { _Pragma("unroll") for (int n = 0; n < 2; ++n) _Pragma("unroll") for (int j = 0; j < 4; ++j) { const float e = fast_exp2(acc[ai][bj][m][n][j] * r_); acc[ai][bj][m][n][j] = e; s += e; } }
            s += __shfl_xor(s, 1); s += __shfl_xor(s, 2);
            if (fq == 0) ((LAS float*)(ps + RT_(ai, m)))[wc] = s; }
        asm volatile("s_waitcnt lgkmcnt(0)\n\ts_barrier" ::: "memory");
        unsigned char* base = P + (size_t)u.pm * 256 * DM + u.pn * 256 + 32 * wc + 8 * fq;
        FOR_AI FOR_M { const f32x4 q = ps[RT_(ai, m)]; const float inv = 256.f * __builtin_amdgcn_rcpf((q[0] + q[1]) + (q[2] + q[3]));
            FOR_BJ store8_fp8(base + (size_t)RT_(ai, m) * DM + bj * 128, acc[ai][bj][m][0] * inv, acc[ai][bj][m][1] * inv); }
    }
};
struct OpR {
    static constexpr bool PERM = false, GATHER = false, FP8 = false;
    const bf16_t* A; const bf16_t* Bt; int K, lda, ldb;
    float* LG; const u64* ssq2;
    __device__ __forceinline__ unsigned a_off(int r, int c) const { return (unsigned)(r * lda + c) * 2u; }
    __device__ __forceinline__ const char* a_base(const Unit& u) const { return (const char*)(A + (size_t)u.pm * 256 * lda); }
    __device__ __forceinline__ const char* b_base(const Unit& u) const { return (const char*)(Bt + (size_t)u.pn * 256 * ldb); }
    __device__ __forceinline__ void epi(const Acc& acc, const Unit& u, int wr, int wc, int fr, int fq) const {
        if (wc > 1) return;
        float rs[2][4]; FOR_AI FOR_M rs[ai][m] = fx_load(ssq2 + u.pm * 256 + RT_(ai, m));
        FOR_AI FOR_M { const int row = u.pm * 256 + RT_(ai, m); const float r_ = __builtin_amdgcn_rsqf(rs[ai][m] * (1.0f / DM) + EPS); float* lg = LG + (size_t)row * 40;
            if (wc == 0) { *(f32x4*)(lg + 4 * fq) = acc[ai][0][m][0] * r_; *(f32x4*)(lg + 16 + 4 * fq) = acc[ai][0][m][1] * r_; }
            else if (fq == 0) { *(f32x4*)(lg + 32) = acc[ai][0][m][0] * r_; } }
    }
};
struct MoeTab { const LAS int* tileE; const LAS int* tbase; const LAS int* cntL; };
template <int NPN> struct MoeOrder {
    int nunits, G, c;
    __device__ __forceinline__ bool next(int i, Unit& u) const { const int L = i * G + c; if (L >= nunits) return false; u.pm = L / NPN; u.pn = L - u.pm * NPN; return true; }
};
struct OpGU {
    static constexpr bool PERM = true, GATHER = true, FP8 = true;
    const bf16_t* A; const bf16_t* WGUp; int K, lda, ldb;
    unsigned char* HID  ; const int* LIST; const float* WL; const float* RSL; MoeTab tb;
    __device__ __forceinline__ unsigned a_off_u(const Unit& u, int r, int c) const { const int e = tb.tileE[u.pm]; const int p = (u.pm - tb.tbase[e]) * 256 + r;
        const int tok = p < tb.cntL[e] ? (LIST[(size_t)e * NTOK + p] >> 1) : 0; return (unsigned)(tok * lda + c) * 2u; }
    __device__ __forceinline__ const char* a_base(const Unit&) const { return (const char*)A; }
    __device__ __forceinline__ const char* b_base(const Unit& u) const { return (const char*)(WGUp + ((size_t)tb.tileE[u.pm] * 512 + u.pn * 256) * ldb); }
    __device__ __forceinline__ void epi(const Acc& acc, const Unit& u, int wr, int wc, int fr, int fq) const {
        const int e = tb.tileE[u.pm], row0 = (u.pm - tb.tbase[e]) * 256, ce = tb.cntL[e]; const size_t lb = (size_t)e * NTOK + row0;
        float cw[2][4], rs[2][4];
        FOR_AI FOR_M { const int r = RT_(ai, m); const bool v = row0 + r < ce; cw[ai][m] = v ? WL[lb + r] : 0.f; rs[ai][m] = v ? RSL[lb + r] : 0.f; }
        unsigned char* base = HID + (size_t)u.pm * 256 * EFF + u.pn * 128 + 32 * wc + 8 * fq;
        FOR_AI FOR_M { const float r_ = rs[ai][m], c_ = cw[ai][m]; f32x4 h0, h1;
#pragma unroll
            for (int j = 0; j < 4; ++j) { const float g0 = acc[ai][0][m][0][j] * r_, u0 = acc[ai][1][m][0][j] * r_, g1 = acc[ai][0][m][1][j] * r_, u1 = acc[ai][1][m][1][j] * r_;
                h0[j] = g0 * sigmoidf_(g0) * u0 * c_ * 16.f; h1[j] = g1 * sigmoidf_(g1) * u1 * c_ * 16.f; }
            store8_fp8(base + (size_t)RT_(ai, m) * EFF, h0, h1); }
    }
};
struct OpDN {
    static constexpr bool PERM = true, GATHER = false, FP8 = true;
    const bf16_t* HID; const bf16_t* WDp; int K, lda, ldb;
    unsigned char* Y  ; const int* LIST; MoeTab tb;
    __device__ __forceinline__ unsigned a_off(int r, int c) const { return (unsigned)(r * lda + c) * 2u; }
    __device__ __forceinline__ const char* a_base(const Unit& u) const { return (const char*)(HID + (size_t)u.pm * 256 * lda); }
    __device__ __forceinline__ const char* b_base(const Unit& u) const { return (const char*)(WDp + ((size_t)tb.tileE[u.pm] * DM + u.pn * 256) * ldb); }
    __device__ __forceinline__ void epi(const Acc& acc, const Unit& u, int wr, int wc, int fr, int fq) const {
        const int e = tb.tileE[u.pm], row0 = (u.pm - tb.tbase[e]) * 256, ce = tb.cntL[e]; const size_t lb = (size_t)e * NTOK + row0;
        int ent[2][4];
        FOR_AI FOR_M { const int r = RT_(ai, m); ent[ai][m] = row0 + r < ce ? LIST[lb + r] : -1; }
        FOR_AI FOR_M { const int en = ent[ai][m];
            if (en >= 0) { unsigned char* p = Y + ((size_t)(en & 1) * NTOK + (size_t)(en >> 1)) * DM + u.pn * 256 + 32 * wc + 8 * fq;
                FOR_BJ store8_fp8(p + bj * 128, acc[ai][bj][m][0], acc[ai][bj][m][1]); } }
    }
};
__device__ __forceinline__ int moe_build_tables(const unsigned* cnt, LAS int* cntL, LAS int* tbase, LAS int* tileE, int tid) {
    if (tid < NEXP) cntL[tid] = (int)__hip_atomic_load(cnt + tid, RLX_AGENT);
    __syncthreads();
    if (tid == 0) { int acc_ = 0; for (int e = 0; e < NEXP; ++e) { tbase[e] = acc_; acc_ += (cntL[e] + 255) >> 8; } tbase[NEXP] = acc_; }
    __syncthreads();
    const int nt = tbase[NEXP];
    for (int t = tid; t < nt; t += 512) { int e = 0; for (int k = 1; k < NEXP; ++k) e += (tbase[k] <= t) ? 1 : 0; tileE[t] = e; }
    __syncthreads();
    return __builtin_amdgcn_readfirstlane(nt);
}

namespace mla {
constexpr int KSLOT = 4096, RSLOT = 2048, VSLOT = 4096, NSLOT = 8;
constexpr int L_K = 0, L_R = NSLOT * KSLOT, L_V = L_R + NSLOT * RSLOT, L_WS = L_V + NSLOT * VSLOT, L_OST = L_WS + 8 * 256, L_DUM = L_OST + 8 * 4096, L_END = L_DUM + 8 * 1024;
static_assert(L_END <= RING_BYTES, "attention LDS");
constexpr float THR = 6.0f;
__device__ __forceinline__ int crow(int r, int hi) { return (r & 3) + 8 * (r >> 2) + 4 * hi; }
__device__ __forceinline__ void glds16(const void* gsrc, unsigned lds_dst) { unsigned keep;
    asm volatile("s_mov_b32 %0, m0\n\ts_mov_b32 m0, %2\n\ts_nop 0\n\tglobal_load_lds_dwordx4 %1, off\n\ts_mov_b32 m0, %0" : "=&s"(keep) : "v"(gsrc), "s"(lds_dst) : "memory"); }
#define MX3(a, b, c) __builtin_fmaxf(__builtin_fmaxf((a), (b)), (c))
__device__ __forceinline__ float rowmax(const f32x16& p0, const f32x16& p1) {
    float a = MX3(p0[0], p0[1], p1[0]), b = MX3(p0[2], p0[3], p1[1]); a = MX3(a, p1[2], p1[3]);
#pragma unroll
    for (int r = 4; r < 16; r += 4) { a = MX3(a, p0[r], p0[r + 1]); b = MX3(b, p0[r + 2], p0[r + 3]); a = MX3(a, p1[r], p1[r + 1]); b = MX3(b, p1[r + 2], p1[r + 3]); }
    a = __builtin_fmaxf(a, b);
    auto rr = __builtin_amdgcn_permlane32_swap(__float_as_uint(a), __float_as_uint(a), false, false);
    return __builtin_fmaxf(__uint_as_float(rr[0]), __uint_as_float(rr[1]));
}
#define MLA_SC1 0x7F7F7F7F
#define MLA_SCQ 0x7B7B7B7B
template <bool GA> __device__ __forceinline__ void attn_unit(int b, int h, int qb, const unsigned char* Q8, const unsigned char* K8, const unsigned char* KR8, const unsigned char* VT8, bf16_t* O, LAS unsigned char* shm, const int wv_) {
    int tid = wv_ * 64 + lane_mb(); asm volatile("" : "+v"(tid));
    const int lane = tid & 63, r32 = lane & 31, hi = lane >> 5; const int wid = __builtin_amdgcn_readfirstlane(tid >> 6);
    const long rowbase = (long)b * SEQ; const int q0 = qb * 256;
    const unsigned lds0 = (unsigned)(uintptr_t)shm;
    LAS float* wsf = (LAS float*)(shm + L_WS) + wid * 64;
    const int sw1 = (lane & 3) ^ ((lane >> 4) & 3);
    const unsigned char* src1 = wid < 4 ? K8 + (rowbase + wid * 16 + (lane >> 2)) * 512 + h * 64 + sw1 * 16
                                        : VT8 + ((size_t)(rowbase >> 6) * 512 + h * 64 + (wid - 4) * 16 + (lane >> 2)) * 64 + sw1 * 16;
    const long step1 = wid < 4 ? 64 * 512 : 512 * 64;
    const unsigned dst1 = wid < 4 ? lds0 + L_K + wid * 1024 : lds0 + L_V + (wid - 4) * 1024; const unsigned slot1 = wid < 4 ? KSLOT : VSLOT;
    const unsigned char* src2 = wid < 2 ? KR8 + (rowbase + wid * 32 + (lane >> 1)) * ROPE + ((lane & 1) ^ ((lane >> 4) & 1)) * 16 : src1;
    const long step2 = wid < 2 ? 64 * ROPE : step1;
    const unsigned dst2 = wid < 2 ? lds0 + L_R + wid * 1024 : lds0 + L_DUM + wid * 1024; const unsigned slot2 = wid < 2 ? RSLOT : 0;
#define MLA_DMA(t, s) do { glds16(src1 + (long)(t) * step1, (unsigned)__builtin_amdgcn_readfirstlane(dst1 + (s) * slot1)); \
        glds16(src2 + (long)(t) * step2, (unsigned)__builtin_amdgcn_readfirstlane(dst2 + (s) * slot2)); } while (0)
    const int NT = 4 * qb + 4, nvis = 4 * qb + (wid >> 1) + 1;
    v8i_t qf[2];
    { const unsigned char* qp = Q8 + (rowbase + q0 + wid * 32 + r32) * 1024 + h * 128 + hi * 32;
#pragma unroll
      for (int st = 0; st < 2; ++st) qf[st] = __builtin_shufflevector(*(const v4i_t*)(qp + st * 64), *(const v4i_t*)(qp + st * 64 + 16), 0, 1, 2, 3, 4, 5, 6, 7); }
    asm volatile("" ::: "memory");
    MLA_DMA(0, 0); MLA_DMA(1, 1); MLA_DMA(2, 2); MLA_DMA(3, 3);
    float mrun = 0.f; f32x16 o[2], lacc;
#pragma unroll
    for (int r = 0; r < 16; ++r) { float z0, z1, z2; asm volatile("v_mov_b32 %0, 0\n\tv_mov_b32 %1, 0\n\tv_mov_b32 %2, 0" : "=v"(z0), "=v"(z1), "=v"(z2)); o[0][r] = z0; o[1][r] = z1; lacc[r] = z2; }
    f32x16 negm;
#pragma unroll
    for (int r = 0; r < 16; ++r) { float z_; asm volatile("v_mov_b32 %0, 0" : "=v"(z_)); negm[r] = z_; }
    v8i_t kn0, kn1, kr0, kr1, p8;
    const int swr = (r32 >> 2) & 3, k64a = ((2 * hi) ^ swr) * 16, k64b = ((2 * hi + 1) ^ swr) * 16, k32a = ((r32 >> 3) & 1) * 16;
#define MLA_KLD(sl_) do { const LAS unsigned char* kp = shm + L_K + (sl_) * KSLOT + r32 * 64; const LAS unsigned char* rp = shm + L_R + (sl_) * RSLOT + r32 * 32; \
        kn0 = __builtin_shufflevector(*(const LAS v4i_t*)(kp + k64a), *(const LAS v4i_t*)(kp + k64b), 0, 1, 2, 3, 4, 5, 6, 7); \
        kn1 = __builtin_shufflevector(*(const LAS v4i_t*)(kp + 2048 + k64a), *(const LAS v4i_t*)(kp + 2048 + k64b), 0, 1, 2, 3, 4, 5, 6, 7); \
        kr0 = __builtin_shufflevector(*(const LAS v4i_t*)(rp + k32a), *(const LAS v4i_t*)(rp + (k32a ^ 16)), 0, 1, 2, 3, 4, 5, 6, 7);      \
        kr1 = __builtin_shufflevector(*(const LAS v4i_t*)(rp + 1024 + k32a), *(const LAS v4i_t*)(rp + 1024 + (k32a ^ 16)), 0, 1, 2, 3, 4, 5, 6, 7); } while (0)
#define MLA_VLD(sl_) do { const LAS unsigned char* vp = shm + L_V + (sl_) * VSLOT + r32 * 64; \
        vf0 = __builtin_shufflevector(*(const LAS v4i_t*)(vp + k64a), *(const LAS v4i_t*)(vp + k64b), 0, 1, 2, 3, 4, 5, 6, 7); \
        vf1 = __builtin_shufflevector(*(const LAS v4i_t*)(vp + 2048 + k64a), *(const LAS v4i_t*)(vp + 2048 + k64b), 0, 1, 2, 3, 4, 5, 6, 7); } while (0)
#define MLA_MF(a_, b_, c_, sa_, sb_) __builtin_amdgcn_mfma_scale_f32_32x32x64_f8f6f4(a_, b_, c_, 0, 0, 0, sa_, 0, sb_)
#define MLA_QK(P0, P1) do { \
        P0 = MLA_MF(kn0, qf[0], negm, MLA_SC1, MLA_SCQ); P1 = MLA_MF(kn1, qf[0], negm, MLA_SC1, MLA_SCQ); \
        P0 = MLA_MF(kr0, qf[1], P0, MLA_SC1, MLA_SCQ); P1 = MLA_MF(kr1, qf[1], P1, MLA_SC1, MLA_SCQ); } while (0)
#define MLA_PV() do { o[0] = MLA_MF(p8, vf0, o[0], MLA_SC1, MLA_SC1); o[1] = MLA_MF(p8, vf1, o[1], MLA_SC1, MLA_SC1); { v8i_t ones; _Pragma("unroll") for (int i = 0; i < 8; ++i) { int w_; asm volatile("v_mov_b32 %0, 0x38383838" : "=v"(w_)); ones[i] = w_; }        \
          lacc = MLA_MF(p8, ones, lacc, MLA_SC1, MLA_SC1); } } while (0)
#define MLA_SM(PA0, PA1, PB0, PB1, t, ADJB) do { \
            const float rm = rowmax(PA0, PA1); \
            if (__any(rm > THR)) { const float dl = __builtin_fmaxf(rm, 0.f); mrun += dl; \
                _Pragma("unroll") for (int r = 0; r < 16; ++r) { PA0[r] -= dl; PA1[r] -= dl; } \
                if (ADJB && (t) + 1 < nvis) { _Pragma("unroll") for (int r = 0; r < 16; ++r) { PB0[r] -= dl; PB1[r] -= dl; } } \
                _Pragma("unroll") for (int r = 0; r < 16; ++r) negm[r] = -mrun; \
                asm volatile("" : "+v"(negm)); \
                const float f = fast_exp2(-dl); if (hi == 0) wsf[r32] = f; LDS_WAIT(); \
                _Pragma("unroll") for (int r = 0; r < 16; ++r) { const float fr_ = wsf[crow(r, hi)]; o[0][r] *= fr_; o[1][r] *= fr_; lacc[r] *= fr_; } \
                LDS_WAIT(); } \
            _Pragma("unroll") for (int r = 0; r < 16; ++r) { PA0[r] = fast_exp2(PA0[r]); PA1[r] = fast_exp2(PA1[r]); } \
            _Pragma("unroll") for (int i = 0; i < 4; ++i) { p8[i] = (int)cvt4_fp8(PA0[4 * i], PA0[4 * i + 1], PA0[4 * i + 2], PA0[4 * i + 3]); p8[4 + i] = (int)cvt4_fp8(PA1[4 * i], PA1[4 * i + 1], PA1[4 * i + 2], PA1[4 * i + 3]); } \
        } while (0)
#define MLA_STEP(PA0, PA1, PB0, PB1, t) do { \
        if ((t) + 2 < NT) { if ((t) + 3 < NT) asm volatile("s_waitcnt vmcnt(2) lgkmcnt(0)\n\ts_barrier" ::: "memory"); else asm volatile("s_waitcnt vmcnt(0) lgkmcnt(0)\n\ts_barrier" ::: "memory"); } \
        if ((t) + 4 < NT) MLA_DMA((t) + 4, ((t) + 4) & 7); \
        v8i_t vf0, vf1;                                                       \
        if constexpr (GA) { \
            const bool pv_ = (t) >= 1 && (t) - 1 < nvis; \
            if (pv_) MLA_VLD(((t) - 1) & 7); \
            if ((t) + 1 < nvis) MLA_QK(PB0, PB1); \
            if (pv_) MLA_PV(); \
            if ((t) < nvis) MLA_SM(PA0, PA1, PB0, PB1, t, true); \
            __builtin_amdgcn_sched_barrier(0); \
            if ((t) + 2 < nvis) MLA_KLD(((t) + 2) & 7); \
        } else { \
            if ((t) < nvis) { \
                MLA_VLD((t) & 7); \
                if ((t) + 1 < nvis) MLA_KLD(((t) + 1) & 7); \
                MLA_SM(PA0, PA1, PB0, PB1, t, false); \
                __builtin_amdgcn_sched_barrier(0); \
                if ((t) + 1 < nvis) MLA_QK(PB0, PB1); \
                MLA_PV(); } \
        } \
    } while (0)
    asm volatile("s_waitcnt vmcnt(4) lgkmcnt(0)\n\ts_barrier" ::: "memory");
    f32x16 pA0, pA1, pB0, pB1;
    MLA_KLD(0); MLA_QK(pA0, pA1);
    { const float rm = rowmax(pA0, pA1); mrun = rm;
#pragma unroll
        for (int r = 0; r < 16; ++r) { pA0[r] -= rm; pA1[r] -= rm; negm[r] = -rm; }
        asm volatile("" : "+v"(negm)); }
    if (GA && 1 < nvis) MLA_KLD(1);
    for (int t = 0; t < NT; t += 2) {
        MLA_STEP(pA0, pA1, pB0, pB1, t);
        MLA_STEP(pB0, pB1, pA0, pA1, t + 1);
    }
    if (GA && nvis == NT) { v8i_t vf0, vf1; MLA_VLD((NT - 1) & 7); MLA_PV(); }
#undef MLA_SM
#undef MLA_VLD
#undef MLA_MF
#undef MLA_PV
#undef MLA_KLD
#undef MLA_QK
#undef MLA_STEP
    float rli[16];
#pragma unroll
    for (int r = 0; r < 16; ++r) rli[r] = __builtin_amdgcn_rcpf(lacc[r]);
    unsigned char* Ow = (unsigned char*)O + (rowbase + q0 + wid * 32) * 512 + h * 64;
    { LAS unsigned char* stg = (LAS unsigned char*)(shm + L_OST) + wid * 4096;
#pragma unroll
        for (int r = 0; r < 16; ++r) { const int orow = crow(r, hi); const unsigned w = cvt4_fp8(o[0][r] * rli[r] * 16.f, o[1][r] * rli[r] * 16.f, 0.f, 0.f);
            stg[orow * 64 + r32] = (unsigned char)(w & 0xffu); stg[orow * 64 + 32 + r32] = (unsigned char)((w >> 8) & 0xffu); }
        LDS_WAIT();
#pragma unroll
        for (int i = 0; i < 2; ++i) { const int row = i * 16 + (lane >> 2), ch = lane & 3; const u32x4 v = *(const LAS u32x4*)(stg + row * 64 + ch * 16); *(u32x4*)(Ow + (long)row * 512 + ch * 16) = v; } }
    asm volatile("s_waitcnt lgkmcnt(0)\n\ts_barrier" ::: "memory");
#undef MLA_DMA
#undef MX3
}
}

#define XB_TMO      128
#define XB_XCNT(j)  (256  + 64 * (j))
#define XB_XSUB(j)  (1280 + 64 * (j))
#define XB_XGEN(j)  (2304 + 64 * (j))
#define XB_TOP      3328
#define XB_TOPGEN   3392
#define XCD_BAR_WORDS 3456
#define XB_SPIN_CAP (1u << 18)
__device__ __forceinline__ unsigned xb_ld(unsigned* p)              { return __hip_atomic_load(p, __ATOMIC_RELAXED, __HIP_MEMORY_SCOPE_AGENT); }
__device__ __forceinline__ unsigned xb_add(unsigned* p, unsigned v) { return __hip_atomic_fetch_add(p, v, __ATOMIC_RELAXED, __HIP_MEMORY_SCOPE_AGENT); }
__device__ __forceinline__ unsigned xb_xcc_id() { return (unsigned)__builtin_amdgcn_s_getreg((3 << 11) | 20) & 0xFu; }
#define XB_SPIN(cond, bar) do { unsigned _sp = 0; while (cond) { __builtin_amdgcn_s_sleep(1); \
    if ((++_sp & 255u) == 0u) { if (xb_ld(&(bar)[XB_TMO])) break; if (_sp > XB_SPIN_CAP) { atomicAdd(&(bar)[XB_TMO], 1u); break; } } } } while (0)
struct XcdBarrier { unsigned* bar; unsigned x; volatile LAS unsigned* st; int w; };
__device__ __forceinline__ XcdBarrier xcd_barrier_post(unsigned* bar, volatile LAS unsigned* st) {
    XcdBarrier b; b.bar = bar; b.x = xb_xcc_id(); b.st = st;
    if (threadIdx.x == 0) (void)xb_add(&bar[XB_XCNT(b.x)], 1u);
    return b;
}
__device__ __forceinline__ void xcd_barrier_complete(unsigned* bar, unsigned x, unsigned& nloc, unsigned& nx) {
    const unsigned G = gridDim.x * gridDim.y * gridDim.z;
    unsigned sum, cnt, mine, sp = 0u;
    for (;;) {
        sum = 0u; cnt = 0u; mine = 0u;
#pragma unroll
        for (unsigned j = 0; j < 16; ++j) { const unsigned c = xb_ld(&bar[XB_XCNT(j)]); sum += c; cnt += (c > 0u) ? 1u : 0u; mine = (j == x) ? c : mine; }
        if (sum == G) break;
        __builtin_amdgcn_s_sleep(1);
        if ((++sp & 255u) == 0u) { if (xb_ld(&bar[XB_TMO])) break; if (sp > XB_SPIN_CAP) { atomicAdd(&bar[XB_TMO], 1u); break; } }
    }
    nloc = mine > 0u ? mine : 1u; nx = cnt > 0u ? cnt : 1u;
}
__device__ __forceinline__ void xcd_barrier(const XcdBarrier& b) {
    asm volatile("s_waitcnt vmcnt(0)" ::: "memory");
    __syncthreads();
    if (b.w == 0 && lane_mb() == 0) {
        unsigned* bar = b.bar;
        __builtin_amdgcn_s_waitcnt(0);
        unsigned nloc = b.st[0], nx = b.st[1];
        if (nloc == 0u) { xcd_barrier_complete(bar, b.x, nloc, nx); b.st[0] = nloc; b.st[1] = nx; }
        const unsigned old = xb_add(&bar[XB_XSUB(b.x)], 1u);
        const unsigned gen = old / nloc;
        if (old + 1u == (gen + 1u) * nloc) {
            __builtin_amdgcn_fence(__ATOMIC_RELEASE, "agent");
            asm volatile("s_waitcnt vmcnt(0)" ::: "memory");
            const unsigned og = xb_add(&bar[XB_TOP], 1u);
            const unsigned tg = og / nx;
            if (og + 1u == (tg + 1u) * nx) xb_add(&bar[XB_TOPGEN], 1u);
            else XB_SPIN(xb_ld(&bar[XB_TOPGEN]) == tg, bar);
            __builtin_amdgcn_fence(__ATOMIC_ACQUIRE, "agent");
            xb_add(&bar[XB_XGEN(b.x)], 1u);
            asm volatile("s_waitcnt vmcnt(0)" ::: "memory");
        } else {
            XB_SPIN(xb_ld(&bar[XB_XGEN(b.x)]) == gen, bar);
            __builtin_amdgcn_fence(__ATOMIC_ACQUIRE, "agent");
            asm volatile("s_waitcnt vmcnt(0)" ::: "memory");
        }
    }
    __syncthreads();
}

__device__ __forceinline__ void transpose_block(const float* src, int ldw, const float* gain, bf16_t* dst  , int ldt, LAS float* scr, int lane, unsigned char* dst8 = nullptr, int ldt8 = 0, float sc8 = 1.f) {
    float tv[32];
#pragma unroll
    for (int i = 0; i < 32; ++i) { const int kk = 2 * i + (lane >> 5); tv[i] = src ? src[(size_t)kk * ldw + (lane & 31)] : 0.f; }
#pragma unroll
    for (int i = 0; i < 32; ++i) { const int kk = 2 * i + (lane >> 5); float v = tv[i]; if (gain) v *= gain[kk]; scr[kk * 33 + (lane & 31)] = v; }
    LDS_WAIT(); asm volatile("" ::: "memory");
    const int c = lane & 7;
#pragma unroll
    for (int j = 0; j < 4; ++j) { const int n = (lane >> 3) + 8 * j; const LAS float* s = scr + (8 * c) * 33 + n;
        u32x4 o; o.x = cvt_pk_bf16(s[0 * 33], s[1 * 33]); o.y = cvt_pk_bf16(s[2 * 33], s[3 * 33]); o.z = cvt_pk_bf16(s[4 * 33], s[5 * 33]); o.w = cvt_pk_bf16(s[6 * 33], s[7 * 33]);
        if (dst) *(u32x4*)(dst + (size_t)n * ldt + 8 * c) = o;
        if (dst8) { u32x2 o8; o8.x = cvt4_fp8(s[0 * 33] * sc8, s[1 * 33] * sc8, s[2 * 33] * sc8, s[3 * 33] * sc8); o8.y = cvt4_fp8(s[4 * 33] * sc8, s[5 * 33] * sc8, s[6 * 33] * sc8, s[7 * 33] * sc8);
            *(u32x2*)(dst8 + (size_t)n * ldt8 + 8 * c) = o8; } }
    LDS_WAIT(); asm volatile("" ::: "memory");
}
__device__ __forceinline__ void rms_row_to_bf16(const float* xrow, const float* g, bf16_t* orow, int lane) {
    const f32x4* xr = (const f32x4*)xrow + lane; const f32x4* gr = (const f32x4*)g + lane;
    f32x4 v[4]; float s = 0.f;
#pragma unroll
    for (int j = 0; j < 4; ++j) { v[j] = xr[64 * j]; s += (v[j].x * v[j].x + v[j].y * v[j].y) + (v[j].z * v[j].z + v[j].w * v[j].w); }
    const float rstd = 1.0f / sqrtf(wave_sum(s) * (1.f / DM) + EPS);
    u32x2* o8 = (u32x2*)orow + lane;
#pragma unroll
    for (int j = 0; j < 4; ++j) { const f32x4 gg = gr[64 * j]; u32x2 w; w.x = cvt_pk_bf16(v[j].x * rstd * gg.x, v[j].y * rstd * gg.y); w.y = cvt_pk_bf16(v[j].z * rstd * gg.z, v[j].w * rstd * gg.w); o8[64 * j] = w; }
}

__device__ __forceinline__ void rms_row2_to_bf16(const float* xrow, const float* g, bf16_t* orow, int lane, unsigned char* orow8 = nullptr) {
    const f32x4* xr = (const f32x4*)xrow + lane; const f32x4* gr = (const f32x4*)g + lane;
    f32x4 v[2][4]; float s[2] = {0.f, 0.f};
#pragma unroll
    for (int r = 0; r < 2; ++r)
#pragma unroll
        for (int j = 0; j < 4; ++j) v[r][j] = xr[r * 256 + 64 * j];
#pragma unroll
    for (int r = 0; r < 2; ++r)
#pragma unroll
        for (int j = 0; j < 4; ++j) s[r] += (v[r][j].x * v[r][j].x + v[r][j].y * v[r][j].y) + (v[r][j].z * v[r][j].z + v[r][j].w * v[r][j].w);
#pragma unroll
    for (int r = 0; r < 2; ++r) { const float rstd = 1.0f / sqrtf(wave_sum(s[r]) * (1.f / DM) + EPS); u32x2* o8 = (u32x2*)(orow + (size_t)r * DM) + lane;
#pragma unroll
        for (int j = 0; j < 4; ++j) { const f32x4 gg = gr[64 * j]; u32x2 w; w.x = cvt_pk_bf16(v[r][j].x * rstd * gg.x, v[r][j].y * rstd * gg.y); w.y = cvt_pk_bf16(v[r][j].z * rstd * gg.z, v[r][j].w * rstd * gg.w); o8[64 * j] = w;
            if (orow8) ((unsigned*)(orow8 + (size_t)r * DM))[lane + 64 * j] = cvt4_fp8(v[r][j].x * rstd * gg.x, v[r][j].y * rstd * gg.y, v[r][j].z * rstd * gg.z, v[r][j].w * rstd * gg.w); } }
}
struct Args { const void* in[28]; float* out; unsigned char* ws; int ph_lo, ph_hi; };
constexpr int NPHASE = 12;

#define CAS __attribute__((address_space(4)))
#define PHASE_PTRS const CAS char* ka_ = (const CAS char*)__builtin_amdgcn_kernarg_segment_ptr(); asm volatile("" : "+s"(ka_)); unsigned char* ws = *(unsigned char* const CAS*)(ka_ + 232); float* outp = *(float* const CAS*)(ka_ + 224); const float* x = *(const float* const CAS*)(ka_ + 0); const float* mem = *(const float* const CAS*)(ka_ + 8); const int* positions = *(const int* const CAS*)(ka_ + 16); const float* mix_norm_g = *(const float* const CAS*)(ka_ + 24); const float* w_in = *(const float* const CAS*)(ka_ + 32); const float* q_norm_g = *(const float* const CAS*)(ka_ + 40); const float* w_q_up = *(const float* const CAS*)(ka_ + 48); const float* kv_norm_g = *(const float* const CAS*)(ka_ + 56); const float* w_kv_up = *(const float* const CAS*)(ka_ + 64); const float* w_attn_branch = *(const float* const CAS*)(ka_ + 72); const float* pool_w = *(const float* const CAS*)(ka_ + 80); const float* pool_scale = *(const float* const CAS*)(ka_ + 88); const float* w_pool_branch = *(const float* const CAS*)(ka_ + 96); const float* w_mix_out = *(const float* const CAS*)(ka_ + 104); const float* xattn_norm_g = *(const float* const CAS*)(ka_ + 112); const float* mem_norm_g = *(const float* const CAS*)(ka_ + 120); const float* w_xq = *(const float* const CAS*)(ka_ + 128); const float* w_xkv = *(const float* const CAS*)(ka_ + 136); const float* w_xo = *(const float* const CAS*)(ka_ + 144); const float* ffn_norm_g = *(const float* const CAS*)(ka_ + 152); const float* w_rg = *(const float* const CAS*)(ka_ + 160); const float* b_rg = *(const float* const CAS*)(ka_ + 168); const float* w_re = *(const float* const CAS*)(ka_ + 176); const float* b_re = *(const float* const CAS*)(ka_ + 184); const float* w_eg = *(const float* const CAS*)(ka_ + 192); const float* w_eu = *(const float* const CAS*)(ka_ + 200); const float* w_ed = *(const float* const CAS*)(ka_ + 208); const float* final_g = *(const float* const CAS*)(ka_ + 216); u64* ssq_q = (u64*)(ws + OFF_SSQQ); u64* ssq_kv = (u64*)(ws + OFF_SSQKV); u64* ssq1 = (u64*)(ws + OFF_SSQ1); u64* ssq2 = (u64*)(ws + OFF_SSQ2); unsigned* cnt = (unsigned*)(ws + OFF_CNT); float* cosT = (float*)(ws + WS_COS); float* sinT = (float*)(ws + WS_SIN); unsigned char* WIN8 = ws + WS_WIN8; unsigned char* HN8 = ws + WS_S6;     bf16_t* WIN = (bf16_t*)(ws + WS_WIN); unsigned char* WQ8 = ws + WS_WQ; unsigned char* WKVU8 = ws + WS_WKVU; unsigned char* WA8 = ws + WS_WA; bf16_t* WPB = (bf16_t*)(ws + WS_WPB); unsigned char* WMO8 = ws + WS_WMO; unsigned char* M8 = ws + WS_S1; bf16_t* WXKV = (bf16_t*)(ws + WS_WXKV); bf16_t* WXO = (bf16_t*)(ws + WS_WXO); bf16_t* WR = (bf16_t*)(ws + WS_WR); unsigned char* WGU8 = ws + WS_WGU; unsigned char* H28 = ws + WS_S5; unsigned char* WD8 = ws + WS_WD; bf16_t* MEMN = (bf16_t*)(ws + WS_MEMN); bf16_t* KVM = (bf16_t*)(ws + WS_KVM); bf16_t* WXQN = (bf16_t*)(ws + WS_WXQN); unsigned char* BQK = ws + WS_BQK; unsigned char* BVO = ws + WS_BVO; unsigned char* H18 = ws + WS_S5; unsigned char* P8 = ws + WS_S1; float* LG = (float*)(ws + WS_LG); bf16_t* HN = (bf16_t*)(ws + WS_S0); bf16_t* Qb = (bf16_t*)(ws + WS_S0); bf16_t* H1 = (bf16_t*)(ws + WS_S0); bf16_t* GA = (bf16_t*)(ws + WS_S1); bf16_t* XQ = (bf16_t*)(ws + WS_S1); bf16_t* Y = (bf16_t*)(ws + WS_S1); bf16_t* GBM = (bf16_t*)(ws + WS_S2); bf16_t* QLb = (bf16_t*)(ws + WS_QLB); bf16_t* KVLb = (bf16_t*)(ws + WS_KVLB); bf16_t* KRb = (bf16_t*)(ws + WS_KRB); bf16_t* H2 = (bf16_t*)(ws + WS_S3); bf16_t* U = (bf16_t*)(ws + WS_U); bf16_t* DP = (bf16_t*)(ws + WS_DP); unsigned char* HID = ws + WS_HID; int* LIST = (int*)(ws + WS_LIST); float* WL = (float*)(ws + WS_WL); float* RSL = (float*)(ws + WS_RSL); unsigned char* K8 = ws + WS_S5; unsigned char* VT8 = ws + WS_S5 + 64 * MiB; unsigned char* Q8 = ws + WS_S0; bf16_t* ATT = (bf16_t*)(ws + WS_ATT); (void)outp; int tidp_ = wave * 64 + lane_mb(); asm volatile("" : "+v"(tidp_)); const int tid = tidp_, lane = tid & 63, gt = bx * 512 + tid; (void)lane; (void)gt;
__global__ void __launch_bounds__(512, 2) fwd_kernel(Args args) {
    extern __shared__ __attribute__((aligned(16))) unsigned char lds_raw[];
    LAS unsigned char* lds = (LAS unsigned char*)lds_raw;
    LAS unsigned char* misc = lds + MISC_OFF;
    const int tid = threadIdx.x, lane = tid & 63, wave = __builtin_amdgcn_readfirstlane(tid >> 6);
    const int G = gridDim.x, bx = blockIdx.x;
    const int vcu = (G % 8 == 0) ? (bx % 8) * (G / 8) + bx / 8 : bx;
    for (int u = tid; u < (LDS_BYTES - MISC_OFF) / 4; u += 512) ((LAS unsigned*)misc)[u] = 0u;
    __syncthreads();
    unsigned* barw = (unsigned*)(args.ws + WS_CTL);
    XcdBarrier bar; bar.bar = barw; bar.x = 0; bar.st = nullptr; bar.w = wave;
    if (MK_N_LAUNCHES == 1) { bar = xcd_barrier_post(barw, (volatile LAS unsigned*)(misc + MO_BAR)); bar.w = wave; }
#define GRID_BAR() do { if (MK_N_LAUNCHES == 1) xcd_barrier(bar); } while (0)
    const int lo = args.ph_lo, hi = args.ph_hi;
#ifndef PH_MASK
#define PH_MASK 0xfff
#endif
#define IN(k) ((((PH_MASK) >> (k)) & 1) && lo <= (k) && (k) < hi)
#define BOTH(k) (IN(k) && IN((k) + 1))
    const int gw = vcu * 8 + wave, NGW = G * 8;
    const int gt = bx * 512 + tid, NGT = G * 512;

    if (IN(0)) {
        PHASE_PTRS
        for (int i = gt; i < (int)(SMALL_ZERO_BYTES / 4); i += NGT) ((unsigned*)(ws + WS_SMALL))[i] = 0u;
        for (int i = gt; i < NTOK * 16; i += NGT) { const int row = i >> 4, k = i & 15;
            const float inv = (float)exp2(-(double)k * (13.287712379549449 / 16.0)); const float ang = (float)positions[row] * inv;
            const double rev = (double)ang * 0.15915494309189535; const float fr_ = (float)(rev - rint(rev));
            cosT[i] = __builtin_amdgcn_cosf(fr_); sinT[i] = __builtin_amdgcn_sinf(fr_); }
        for (int i = gt; i < POOLW * DM; i += NGT) { const int n = i & (DM - 1), k = i >> 10, g = k >> 7; const float* pw = pool_w + (size_t)k * 128; const float* sc = pool_scale + g * 128; const float* wb = w_pool_branch + (size_t)g * 128 * DM + n;
            float s = 0.f;
            for (int e = 0; e < 128; ++e) s += pw[e] * sc[e] * wb[(size_t)e * DM];
            WPB[(size_t)n * POOLW + k] = (bf16_t)(cvt_pk_bf16(s, 0.f) & 0xffffu); }
        for (int i = gt; i < DM * DM / 8; i += NGT) { const int k = i >> 7; const float g_ = xattn_norm_g[k]; const f32x4 a0 = *(const f32x4*)(w_xq + (size_t)i * 8), a1 = *(const f32x4*)(w_xq + (size_t)i * 8 + 4); store8(WXQN + (size_t)i * 8, a0 * g_, a1 * g_); }
        for (int i = gt; i < 256 * DM; i += NGT) { const int n = i >> 10, k = i & (DM - 1); float v = 0.f;
            if (n < 32) v = w_re[k * 32 + n] * ffn_norm_g[k]; else if (n < 36) v = w_rg[k * 4 + (n - 32)] * ffn_norm_g[k];
            WR[i] = (bf16_t)(cvt_pk_bf16(v, 0.f) & 0xffffu); }
        {
            LAS float* scr = (LAS float*)(lds + wave * 16384);
            constexpr int I_IN = 16 * 104, I_Q = 8 * 24, I_KV = 4 * 32, I_A = 8 * 32, I_SQ = 16 * 32, I_XKV = 16 * 64, I_GU = 32 * 16 * 16, I_D = 32 * 4 * 32;
            constexpr int NITEMS = I_IN + I_Q + I_KV + I_A + 2 * I_SQ + I_XKV + I_GU + I_D;
            for (int it = gw; it < NITEMS; it += NGW) {
                int r = it;
                if (r < I_IN) { const int kb = r / 104, nb = r % 104, n0 = nb * 32; const int sn = n0 < 672 ? n0 : (n0 < 768 ? -1 : n0 - 96);
                    transpose_block(sn >= 0 ? w_in + (size_t)kb * 64 * IN_COLS + sn : nullptr, IN_COLS, nullptr, WIN + (size_t)n0 * DM + kb * 64, DM, scr, lane, (n0 >= 1280 || n0 < 768) ? WIN8 + (size_t)n0 * DM + kb * 64 : nullptr, DM, 32.f); continue; } r -= I_IN;
                if (r < I_Q) { const int kb = r / 24, nb = r % 24; transpose_block(kb < 6 ? w_q_up + (size_t)kb * 64 * 768 + nb * 32 : nullptr, 768, kb < 6 ? q_norm_g + kb * 64 : nullptr, nullptr, 512, scr, lane, WQ8 + (size_t)nb * 32 * 512 + kb * 64, 512, 32.f); continue; } r -= I_Q;
                if (r < I_KV) { const int kb = r / 32, nb = r % 32, n0 = nb * 32; const int nn = n0 & 511, sn = (nn >> 6) * 128 + (n0 >= 512 ? 64 : 0) + (nn & 63);
                    transpose_block(w_kv_up + (size_t)kb * 64 * 1024 + sn, 1024, kv_norm_g + kb * 64, nullptr, KVLORA, scr, lane, WKVU8 + (size_t)n0 * KVLORA + kb * 64, KVLORA, 32.f); continue; } r -= I_KV;
                if (r < I_A) { const int kb = r / 32, nb = r % 32; transpose_block(w_attn_branch + (size_t)kb * 64 * DM + nb * 32, DM, nullptr, nullptr, 512, scr, lane, WA8 + (size_t)nb * 32 * 512 + kb * 64, 512, 32.f); continue; } r -= I_A;
                if (r < I_SQ) { const int kb = r / 32, nb = r % 32; transpose_block(w_mix_out + (size_t)kb * 64 * DM + nb * 32, DM, nullptr, nullptr, DM, scr, lane, WMO8 + (size_t)nb * 32 * DM + kb * 64, DM, 32.f); continue; } r -= I_SQ;
                if (r < I_SQ) { const int kb = r / 32, nb = r % 32; transpose_block(w_xo + (size_t)kb * 64 * DM + nb * 32, DM, nullptr, WXO + (size_t)nb * 32 * DM + kb * 64, DM, scr, lane); continue; } r -= I_SQ;
                if (r < I_XKV) { const int kb = r / 64, nb = r % 64; transpose_block(w_xkv + (size_t)kb * 64 * 2048 + nb * 32, 2048, nullptr, WXKV + (size_t)nb * 32 * DM + kb * 64, DM, scr, lane); continue; } r -= I_XKV;
                if (r < I_GU) { const int e = r / 256, q = r % 256, kb = q / 16, nb = q % 16, n0 = nb * 32;
                    const int pn = n0 >> 8, j = n0 & 255; const float* srcm = (j < 128 ? w_eg : w_eu) + (size_t)e * DM * EFF; const int sc = pn * 128 + (j & 127);
                    transpose_block(srcm + (size_t)kb * 64 * EFF + sc, EFF, ffn_norm_g + kb * 64, nullptr, DM, scr, lane, WGU8 + ((size_t)e * 512 + n0) * DM + kb * 64, DM, 32.f); continue; } r -= I_GU;
                { const int e = r / 128, q = r % 128, kb = q / 32, nb = q % 32;
                    transpose_block(w_ed + (size_t)e * EFF * DM + (size_t)kb * 64 * DM + nb * 32, DM, nullptr, nullptr, EFF, scr, lane, WD8 + ((size_t)e * DM + nb * 32) * EFF + kb * 64, EFF, 32.f); }
            }
        }
        for (int m = gw * 2; m < NTOK; m += NGW * 2) rms_row2_to_bf16(x + (size_t)m * DM, mix_norm_g, HN + (size_t)m * DM, lane, HN8 + (size_t)m * DM);
        for (int m = gw; m < NMEM; m += NGW) rms_row_to_bf16(mem + (size_t)m * DM, mem_norm_g, MEMN + (size_t)m * DM, lane);
        if (BOTH(0)) GRID_BAR();
    }

    if (IN(1)) {
        PHASE_PTRS
        { OpIn op{HN, WIN, DM, DM, DM, QLb, KVLb, KRb, U, GA, GBM, ssq_q, ssq_kv, cosT, sinT}; OffsetOrder S; S.s.init(NTOK, 512, G, bx); S.off = 3; pg8::gemm_phase(lds, op, S, wave); }
        { OpPlain op{MEMN, WXKV, DM, DM, DM, KVM, 2 * DM}; pg8::StaticOrder S; S.init(NMEM, 2 * DM, G, bx); pg8::gemm_phase(lds, op, S, wave); }
    }
    if (IN(1)) {
        PHASE_PTRS
        { OpIn8 op{(const bf16_t*)HN8, (const bf16_t*)WIN8, DM / 2, DM / 2, DM / 2, QLb, KVLb, KRb, U, GA, GBM, ssq_q, ssq_kv, cosT, sinT}; pg8::StaticOrder S; S.init(NTOK, 768, G, bx); pg8::gemm_phase(lds, op, S, wave); }
        { OpGate8 op{(const bf16_t*)HN8, (const bf16_t*)WIN8, DM / 2, DM / 2, DM / 2, GA, GBM};
          OffsetOrder S; S.s.init(NTOK, 2048, G, bx); S.off = 5; pg8::gemm_phase(lds, op, S, wave); }
        if (BOTH(1)) GRID_BAR();
    }

    if (IN(2)) {
        PHASE_PTRS
        { OpPre op{KVM, WXQN, 256, 2 * DM, DM, BQK, 0}; pg8::StaticOrder S; S.init(16 * DM, DM, G, bx); pg8::gemm_phase(lds, op, S, wave); }
        { OpPre op{KVM, WXO, 256, DM, 2 * DM, BVO, 1}; pg8::StaticOrder S; S.init(16 * DM, DM, G, bx); pg8::gemm_phase(lds, op, S, wave); }
        { OpQ op{QLb, (const bf16_t*)WQ8, 256, 256, 256, Q8, ssq_q, cosT, sinT}; pg8::StaticOrder S; S.init(NTOK, NHEAD * QKD, G, bx); pg8::gemm_phase(lds, op, S, wave); }
        { OpK8 op{KVLb, (const bf16_t*)WKVU8, KVLORA / 2, KVLORA / 2, KVLORA / 2, K8, ssq_kv}; pg8::StaticOrder S; S.init(NTOK, 512, G, bx); pg8::gemm_phase(lds, op, S, wave); }
        { OpVT op{(const bf16_t*)(WKVU8 + 512 * KVLORA), KVLb, KVLORA / 2, KVLORA / 2, KVLORA / 2, VT8, ssq_kv}; pg8::StaticOrder S; S.init(512, NTOK, G, bx); pg8::gemm_phase(lds, op, S, wave); }
        { RELANE
        static_assert((4 * (NTOK / 4)) % 2 == 0, "item pairs");
        for (int it = gw; it < 4 * (NTOK / 4); it += 2 * NGW) { const int g = it & 3, ch = g * 16 + (lane & 15); const bool two_ = it + NGW < 4 * (NTOK / 4);
            const int rowA = (it >> 2) * 4 + (lane >> 4), rowB = two_ ? ((it + NGW) >> 2) * 4 + (lane >> 4) : rowA, tA = rowA & (SEQ - 1), tB = rowB & (SEQ - 1);
            const bf16_t* pA = U + (size_t)rowA * POOLW + ch * 8; const bf16_t* pB = U + (size_t)rowB * POOLW + ch * 8;
            f32x4 a0, a1, ua0, ua1, b0, b1, ub0, ub1; load8(pA, ua0, ua1); load8(pB, ub0, ub1); a0 = ua0; a1 = ua1; b0 = ub0; b1 = ub1;
#define DP_WIN(W) { u32x4 wa_[W - 1], wb_[W - 1]; \
                    _Pragma("unroll") for (int j = 1; j < W; ++j) { wa_[j - 1] = *(const u32x4*)(pA - (size_t)(j <= tA ? j : 0) * POOLW); wb_[j - 1] = *(const u32x4*)(pB - (size_t)(j <= tB ? j : 0) * POOLW); } \
                    _Pragma("unroll") for (int j = 1; j < W; ++j) { const u32x4 w = wa_[j - 1]; const float k_ = (j <= tA) ? 1.f : 0.f; a0 += (f32x4){bf_lo(w.x), bf_hi(w.x), bf_lo(w.y), bf_hi(w.y)} * k_; a1 += (f32x4){bf_lo(w.z), bf_hi(w.z), bf_lo(w.w), bf_hi(w.w)} * k_; } \
                    _Pragma("unroll") for (int j = 1; j < W; ++j) { const u32x4 w = wb_[j - 1]; const float k_ = (j <= tB) ? 1.f : 0.f; b0 += (f32x4){bf_lo(w.x), bf_hi(w.x), bf_lo(w.y), bf_hi(w.y)} * k_; b1 += (f32x4){bf_lo(w.z), bf_hi(w.z), bf_lo(w.w), bf_hi(w.w)} * k_; } }
            if (g == 0) DP_WIN(2) else if (g == 1) DP_WIN(4) else if (g == 2) DP_WIN(8) else DP_WIN(16)
#undef DP_WIN
            const int w = 2 << g, nA = (tA + 1 < w) ? tA + 1 : w, nB = (tB + 1 < w) ? tB + 1 : w; const float invA = 1.0f / (float)nA, invB = 1.0f / (float)nB;
            store8(DP + (size_t)rowA * POOLW + ch * 8, a0 * invA - ua0, a1 * invA - ua1);
            if (two_) store8(DP + (size_t)rowB * POOLW + ch * 8, b0 * invB - ub0, b1 * invB - ub1); }
        }
        if (BOTH(2)) GRID_BAR();
    }

    if (IN(3)) {
        PHASE_PTRS
        { OpYB op{DP, WPB, POOLW, POOLW, POOLW, GBM}; pg8::StaticOrder S; S.init(NTOK, DM, G, bx); pg8::gemm_phase(lds, op, S, wave); }
        { const int bh = vcu >> 1, half = vcu & 1;
          if (bh < NBATCH * NHEAD) for (int i = 0; i < 8; ++i) { const int pr = i >> 1, od = i & 1; const int qb = 4 * pr + (od ? (half ? 2 : 3) : (half ? 1 : 0));
              if (wave < 4) mla::attn_unit<true>(bh >> 3, bh & 7, qb, Q8, K8, (const unsigned char*)KRb, VT8, ATT, lds, wave); else mla::attn_unit<false>(bh >> 3, bh & 7, qb, Q8, K8, (const unsigned char*)KRb, VT8, ATT, lds, wave); } }
        if (BOTH(3)) GRID_BAR();
    }

    if (IN(4)) {
        PHASE_PTRS
        { OpYA op{ATT, (const bf16_t*)WA8, 256, 256, 256, GA, GBM, M8}; pg8::StaticOrder S; S.init(NTOK, DM, G, bx); pg8::gemm_phase(lds, op, S, wave); }
        if (BOTH(4)) GRID_BAR();
    }

    if (IN(5)) {
        PHASE_PTRS
        { OpRes<true, true> op{(const bf16_t*)M8, (const bf16_t*)WMO8, DM / 2, DM / 2, DM / 2, x, H1, ssq1, 0, H18, 0.25f}; pg8::StaticOrder S; S.init(NTOK, DM, G, bx); pg8::gemm_phase(lds, op, S, wave); }
        if (BOTH(5)) GRID_BAR();
    }

    if (IN(6)) {
        PHASE_PTRS
        { OpSX op{(const bf16_t*)H18, (const bf16_t*)BQK, DM / 2, DM / 2, DM / 2, P8, ssq1, (LAS f32x4*)(misc + MO_PS)}; pg8::StaticOrder S; S.init(NTOK, DM, G, bx); pg8::gemm_phase(lds, op, S, wave); }
        if (BOTH(6)) GRID_BAR();
    }

    if (IN(7)) {
        PHASE_PTRS
        { OpRes<false, true> op{(const bf16_t*)P8, (const bf16_t*)BVO, DM / 2, DM / 2, DM / 2, H1, H2, ssq2, (size_t)DM * DM / 2, H28, 1.0f / 256.f}; pg8::StaticOrder S; S.init(NTOK, DM, G, bx); pg8::gemm_phase(lds, op, S, wave); }
        if (BOTH(7)) GRID_BAR();
    }

    if (IN(8)) {
        PHASE_PTRS
        pg8::StaticOrder S; S.init(NTOK, 256, G, bx);
        { OpR op{H2, WR, DM, DM, DM, LG, ssq2}; pg8::gemm_phase(lds, op, S, wave); }
        { RELANE
        VM_WAIT(); __syncthreads(); __builtin_amdgcn_fence(__ATOMIC_ACQUIRE, "agent"); VM_WAIT(); __syncthreads();
        LAS unsigned* hist = (LAS unsigned*)(misc + MO_HIST); LAS unsigned* basee = (LAS unsigned*)(misc + MO_BASE);
        pg8::StaticOrder S2; S2.init(NTOK, 256, G, bx);
        for (int i = 0; i < (256 + G - 1) / G; ++i) { Unit u; if (!S2.next(i, u)) break;
            if (tid < 32) hist[tid] = 0u;
            __syncthreads();
            int e1 = 0, e2 = 0; float w1 = 0.f, w2 = 0.f; unsigned r1 = 0, r2 = 0; const int row = u.pm * 256 + tid;
            if (tid < 256) {
                const float* lg = LG + (size_t)row * 40;
                float gl[4]; int gi = 0;
#pragma unroll
                for (int j = 0; j < 4; ++j) gl[j] = lg[32 + j] + b_rg[j];
                float gm = gl[0];
#pragma unroll
                for (int j = 1; j < 4; ++j) if (gl[j] > gm) { gm = gl[j]; gi = j; }
                float gs = 0.f;
#pragma unroll
                for (int j = 0; j < 4; ++j) gs += __expf(gl[j] - gm);
                const float gwt = 1.0f / gs;
                float el[8];
#pragma unroll
                for (int j = 0; j < 8; ++j) el[j] = lg[gi * 8 + j] + b_re[gi * 8 + j];
                int i1 = 0; float m1 = el[0];
#pragma unroll
                for (int j = 1; j < 8; ++j) if (el[j] > m1) { m1 = el[j]; i1 = j; }
                int i2 = -1; float m2 = -3.0e38f;
#pragma unroll
                for (int j = 0; j < 8; ++j) if (j != i1 && el[j] > m2) { m2 = el[j]; i2 = j; }
                const float p2 = __expf(m2 - m1);
                w1 = gwt / (1.0f + p2); w2 = gwt * p2 / (1.0f + p2);
                e1 = gi * 8 + i1; e2 = gi * 8 + i2;
                r1 = __hip_atomic_fetch_add(&hist[e1], 1u, __ATOMIC_RELAXED, __HIP_MEMORY_SCOPE_WORKGROUP); r2 = __hip_atomic_fetch_add(&hist[e2], 1u, __ATOMIC_RELAXED, __HIP_MEMORY_SCOPE_WORKGROUP);
            }
            __syncthreads();
            if (tid < 32) basee[tid] = hist[tid] ? __hip_atomic_fetch_add(cnt + tid, hist[tid], RLX_AGENT) : 0u;
            __syncthreads();
            if (tid < 256) { const size_t p1 = (size_t)e1 * NTOK + basee[e1] + r1, p2 = (size_t)e2 * NTOK + basee[e2] + r2;
                const float rs_ = __builtin_amdgcn_rsqf(fx_load(ssq2 + row) * (1.0f / DM) + EPS);
                LIST[p1] = row * 2; WL[p1] = w1; RSL[p1] = rs_; LIST[p2] = row * 2 + 1; WL[p2] = w2; RSL[p2] = rs_; }
            __syncthreads();
        }
        }
        if (BOTH(8)) GRID_BAR();
    }

    if (IN(9)) {
        PHASE_PTRS
        LAS int* cntL = (LAS int*)(misc + MO_CNTL); LAS int* tbase = (LAS int*)(misc + MO_TBASE); LAS int* tileE = (LAS int*)(misc + MO_TILEE);
        const int ntile = moe_build_tables(cnt, cntL, tbase, tileE, tid);
        { OpGU op{(const bf16_t*)H28, (const bf16_t*)WGU8, DM / 2, DM / 2, DM / 2, HID, LIST, WL, RSL, MoeTab{tileE, tbase, cntL}}; MoeOrder<2> S{ntile * 2, G, vcu}; pg8::gemm_phase(lds, op, S, wave); }
        if (BOTH(9)) GRID_BAR();
    }

    if (IN(10)) {
        PHASE_PTRS
        LAS int* cntL = (LAS int*)(misc + MO_CNTL); LAS int* tbase = (LAS int*)(misc + MO_TBASE); LAS int* tileE = (LAS int*)(misc + MO_TILEE);
        const int ntile = moe_build_tables(cnt, cntL, tbase, tileE, tid);
        { OpDN op{(const bf16_t*)HID, (const bf16_t*)WD8, EFF / 2, EFF / 2, EFF / 2, (unsigned char*)Y, LIST, MoeTab{tileE, tbase, cntL}}; MoeOrder<4> S{ntile * 4, G, vcu}; pg8::gemm_phase(lds, op, S, wave); }
        if (BOTH(10)) GRID_BAR();
    }

    if (IN(11)) {
        PHASE_PTRS
        const f32x4 g00 = *(const f32x4*)(final_g + lane * 8), g01 = *(const f32x4*)(final_g + lane * 8 + 4), g10 = *(const f32x4*)(final_g + 512 + lane * 8), g11 = *(const f32x4*)(final_g + 512 + lane * 8 + 4);
        for (int m = gw * 2; m < NTOK; m += NGW * 2) {
            u32x4 w[2][2]; u32x2 y8[2][2][2]; const unsigned char* Y8 = (const unsigned char*)Y;
#pragma unroll
            for (int r = 0; r < 2; ++r)
#pragma unroll
                for (int hf = 0; hf < 2; ++hf) { const size_t o = (size_t)(m + r) * DM + hf * 512 + lane * 8; w[r][hf] = *(const u32x4*)(H2 + o); y8[r][hf][0] = *(const u32x2*)(Y8 + o); y8[r][hf][1] = *(const u32x2*)(Y8 + (size_t)NTOK * DM + o); }
#pragma unroll
            for (int r = 0; r < 2; ++r) { f32x4 v[2][2]; float s = 0.f;
#pragma unroll
                for (int hf = 0; hf < 2; ++hf) { f32x4 a0, a1, b0, b1, c0, c1; unpack8(w[r][hf], a0, a1); unpack8_fp8(y8[r][hf][0], b0, b1); unpack8_fp8(y8[r][hf][1], c0, c1);
                    a0 += (b0 + c0) * 0.0625f; a1 += (b1 + c1) * 0.0625f; v[hf][0] = a0; v[hf][1] = a1; s += ssq8(a0, a1); }
                const float rstd = 1.0f / sqrtf(wave_sum(s) * (1.f / DM) + EPS); float* op_ = outp + (size_t)(m + r) * DM + lane * 8;
                *(f32x4*)(op_) = v[0][0] * rstd * g00; *(f32x4*)(op_ + 4) = v[0][1] * rstd * g01; *(f32x4*)(op_ + 512) = v[1][0] * rstd * g10; *(f32x4*)(op_ + 516) = v[1][1] * rstd * g11; }
        }
    }
#undef IN
#undef BOTH
#undef GRID_BAR
}

extern "C" void kernel_launch(void* const* d_in, const int* in_sizes, int n_in, void* d_out, int out_size, void* d_ws, size_t ws_size, hipStream_t stream) {
    static int grid = 0;
    if (grid == 0) {
        if (n_in != 28 || in_sizes[0] != NTOK * DM || out_size != NTOK * DM || ws_size < WS_END) { fprintf(stderr, "kernel_launch: unexpected shapes (n_in %d, in0 %d, out %d, ws %zu); nothing launched\n", n_in, n_in > 0 ? in_sizes[0] : -1, out_size, ws_size); grid = -1; return; }
        int dev = 0, cus = 0, per_cu = 0;
        if (hipGetDevice(&dev) != hipSuccess || hipDeviceGetAttribute(&cus, hipDeviceAttributeMultiprocessorCount, dev) != hipSuccess) { fprintf(stderr, "kernel_launch: device query failed\n"); grid = -1; return; }
        if (hipFuncSetAttribute((const void*)fwd_kernel, hipFuncAttributeMaxDynamicSharedMemorySize, LDS_BYTES) != hipSuccess) { fprintf(stderr, "kernel_launch: hipFuncSetAttribute failed\n"); grid = -1; return; }
        if (hipOccupancyMaxActiveBlocksPerMultiprocessor(&per_cu, (const void*)fwd_kernel, 512, LDS_BYTES) != hipSuccess || per_cu < 1) { fprintf(stderr, "kernel_launch: occupancy query reports %d blocks per CU\n", per_cu); }
        (void)hipGetLastError();
        grid = cus;
        if (grid > 256) grid = 256;
    }
    if (grid < 0) return;
    (void)hipMemsetAsync((char*)d_ws + WS_CTL, 0, CTL_ZERO_BYTES, stream);
    Args a{};
    for (int i = 0; i < 28; ++i) a.in[i] = d_in[i];
    a.out = (float*)d_out; a.ws = (unsigned char*)d_ws;
    if (MK_N_LAUNCHES == 1) { a.ph_lo = 0; a.ph_hi = NPHASE; hipLaunchKernelGGL(fwd_kernel, dim3(grid), dim3(512), LDS_BYTES, stream, a); }
    else for (int p = 0; p < NPHASE; ++p) { a.ph_lo = p; a.ph_hi = p + 1; hipLaunchKernelGGL(fwd_kernel, dim3(grid), dim3(512), LDS_BYTES, stream, a); }
    const hipError_t le = hipPeekAtLastError();
    if (le != hipSuccess) fprintf(stderr, "kernel_launch: launch failed: %s\n", hipGetErrorName(le));
}
```

```cpp
#include <hip/hip_runtime.h>
#include <cstdio>
#include <cstdint>
#include <type_traits>
#include <utility>

#ifndef PG8_SP2
#define PG8_SP2 1
#endif
#ifndef PG8_ALIGN_EPI
#define PG8_ALIGN_EPI 1
#endif
#ifndef MK_N_LAUNCHES
#define MK_N_LAUNCHES 1
#endif

#define GAS __attribute__((address_space(1)))
#define LAS __attribute__((address_space(3)))
typedef unsigned short bf16_t;
typedef short bf16x8 __attribute__((ext_vector_type(8)));
typedef short s16x4 __attribute__((ext_vector_type(4)));
typedef float f32x2 __attribute__((ext_vector_type(2)));
typedef float f32x4 __attribute__((ext_vector_type(4)));
typedef float f32x16 __attribute__((ext_vector_type(16)));
typedef unsigned u32x4 __attribute__((ext_vector_type(4)));
typedef unsigned u32x2 __attribute__((ext_vector_type(2)));
typedef int v4i_t __attribute__((ext_vector_type(4)));
typedef int v8i_t __attribute__((ext_vector_type(8)));
typedef GAS unsigned gu32;
#define RLX_AGENT __ATOMIC_RELAXED, __HIP_MEMORY_SCOPE_AGENT
#define LDS_WAIT() asm volatile("s_waitcnt lgkmcnt(0)" ::: "memory")
#define VM_WAIT() asm volatile("s_waitcnt vmcnt(0)" ::: "memory")

constexpr int DM = 1024, NBATCH = 16, SEQ = 4096, NTOK = NBATCH * SEQ;
constexpr int QLORA = 384, KVLORA = 256, ROPE = 32, POOLW = 512, NHEAD = 8, QKD = 96, VD = 64;
constexpr int MEMLEN = 256, NMEM = NBATCH * MEMLEN;
constexpr int NEXP = 32, EFF = 256;
constexpr int IN_COLS = 3232, IN_PAD = 3328;
constexpr float EPS = 1e-6f;
constexpr float C2Q = 0.10206207261596577f * 1.4426950408889634f;
constexpr float C2X = 0.0625f * 1.4426950408889634f;

constexpr size_t MiB = 1u << 20;
constexpr size_t WS_CTL = 0, CTL_ZERO_BYTES = 64 * 1024;
constexpr size_t WS_SMALL = 1 * MiB;
constexpr size_t OFF_SSQQ = WS_SMALL, OFF_SSQKV = OFF_SSQQ + 524288, OFF_SSQ1 = OFF_SSQKV + 524288, OFF_SSQ2 = OFF_SSQ1 + 524288, OFF_CNT = OFF_SSQ2 + 524288;
constexpr size_t SMALL_ZERO_BYTES = 4 * 524288 + 4096;
constexpr size_t WS_COS = 4 * MiB, WS_SIN = 8 * MiB;
constexpr size_t WS_WIN = 12 * MiB;
constexpr size_t WS_WQ = 19 * MiB;
constexpr size_t WS_WKVU = 20 * MiB;
constexpr size_t WS_WA = 21 * MiB, WS_WPB = 22 * MiB;
constexpr size_t WS_WMO = 23 * MiB, WS_WXKV = 27 * MiB, WS_WXO = 31 * MiB;
constexpr size_t WS_WR = 33 * MiB;
constexpr size_t WS_WGU = 34 * MiB;
constexpr size_t WS_WD = 66 * MiB;
constexpr size_t WS_MEMN = 82 * MiB, WS_KVM = 90 * MiB;
constexpr size_t WS_WIN8 = 122 * MiB;
constexpr size_t WS_WXQN = 120 * MiB;
constexpr size_t WS_BQK = 960 * MiB, WS_BVO = 992 * MiB;
constexpr size_t WS_LG = 106 * MiB;
constexpr size_t WS_S0 = 128 * MiB;
constexpr size_t WS_S1 = 256 * MiB;
constexpr size_t WS_S2 = 384 * MiB;
constexpr size_t WS_S3 = 512 * MiB;
constexpr size_t WS_S4 = 640 * MiB;
constexpr size_t WS_S5 = 768 * MiB;
constexpr size_t WS_S6 = 896 * MiB;
constexpr size_t WS_END = 1024 * MiB;
constexpr size_t WS_QLB = WS_S3, WS_KVLB = WS_S3 + 48 * MiB, WS_KRB = WS_S3 + 80 * MiB;
constexpr size_t WS_U = WS_S4, WS_DP = WS_S4 + 64 * MiB;
constexpr size_t WS_HID = WS_S4, WS_LIST = WS_S4 + 80 * MiB, WS_WL = WS_S4 + 88 * MiB, WS_RSL = WS_S4 + 96 * MiB;
constexpr size_t WS_KN = WS_S5, WS_V = WS_S5 + 64 * MiB;
constexpr size_t WS_ATT = WS_S6;

constexpr int RING_BYTES = 131072;
constexpr int MISC_OFF = RING_BYTES;
constexpr int LDS_BYTES = RING_BYTES + 24576;
constexpr int MO_BAR = 0;
constexpr int MO_HIST = 64, MO_BASE = 64 + 128;
constexpr int MO_CNTL = 1024, MO_TBASE = 1024 + 128, MO_TILEE = 2048;
constexpr int MAX_TILES = 544;
constexpr int MO_PS = 8192;

typedef __bf16 bf16x2_t __attribute__((ext_vector_type(2)));
__device__ __forceinline__ unsigned cvt_pk_bf16(float lo, float hi) { const f32x2 v = {lo, hi}; const bf16x2_t b = __builtin_convertvector(v, bf16x2_t); return __builtin_bit_cast(unsigned, b); }
__device__ __forceinline__ float bf_lo(unsigned w) { return __uint_as_float(w << 16); }
__device__ __forceinline__ float bf_hi(unsigned w) { return __uint_as_float(w & 0xffff0000u); }
__device__ __forceinline__ int lane_mb() { int l; asm volatile("v_mbcnt_lo_u32_b32 %0, -1, 0\n\tv_mbcnt_hi_u32_b32 %0, -1, %0" : "=v"(l)); return l; }
#define RELANE int tidq_ = wave * 64 + lane_mb(); asm volatile("" : "+v"(tidq_)); const int tid = tidq_, lane = tid & 63; (void)lane;
__device__ __forceinline__ void store8(bf16_t* p, const f32x4 v0, const f32x4 v1) {
    u32x4 w; w.x = cvt_pk_bf16(v0[0], v0[1]); w.y = cvt_pk_bf16(v0[2], v0[3]); w.z = cvt_pk_bf16(v1[0], v1[1]); w.w = cvt_pk_bf16(v1[2], v1[3]);
    *(u32x4*)p = w; }
__device__ __forceinline__ unsigned cvt4_fp8(float a, float b, float c, float d) { unsigned w = __float_as_uint(a);      w = __builtin_amdgcn_cvt_pk_fp8_f32(a, b, w, false); w = __builtin_amdgcn_cvt_pk_fp8_f32(c, d, w, true); return w; }
__device__ __forceinline__ void store8_fp8(unsigned char* p, const f32x4 v0, const f32x4 v1) { u32x2 w; w.x = cvt4_fp8(v0[0], v0[1], v0[2], v0[3]); w.y = cvt4_fp8(v1[0], v1[1], v1[2], v1[3]); *(u32x2*)p = w; }
__device__ __forceinline__ void unpack8_fp8(const u32x2 w, f32x4& v0, f32x4& v1) { const f32x2 a = __builtin_amdgcn_cvt_pk_f32_fp8((int)w.x, false), b = __builtin_amdgcn_cvt_pk_f32_fp8((int)w.x, true), c = __builtin_amdgcn_cvt_pk_f32_fp8((int)w.y, false), d = __builtin_amdgcn_cvt_pk_f32_fp8((int)w.y, true);
    v0 = (f32x4){a.x, a.y, b.x, b.y}; v1 = (f32x4){c.x, c.y, d.x, d.y}; }
__device__ __forceinline__ void load8(const bf16_t* p, f32x4& v0, f32x4& v1) {
    const u32x4 w = *(const u32x4*)p; v0 = (f32x4){bf_lo(w.x), bf_hi(w.x), bf_lo(w.y), bf_hi(w.y)}; v1 = (f32x4){bf_lo(w.z), bf_hi(w.z), bf_lo(w.w), bf_hi(w.w)}; }
__device__ __forceinline__ float fast_exp2(float x) { return __builtin_amdgcn_exp2f(x); }
__device__ __forceinline__ float sigmoidf_(float x) { return __builtin_amdgcn_rcpf(1.0f + fast_exp2(-1.4426950408889634f * x)); }
__device__ __forceinline__ float wave_sum(float v) {
#pragma unroll
    for (int o = 1; o < 64; o <<= 1) v += __shfl_xor(v, o);
    return v;
}

namespace pg8 {
#ifndef PG8_WGM
#define PG8_WGM 8
#endif
constexpr int BM = 256, BK = 64, HALF = 128, HTB = HALF * BK * 2, NXCD = 8, WGM = PG8_WGM;
__host__ __device__ __forceinline__ int lds_byte(int r, int c) { const int st = (r >> 4) * 2 + (c >> 5), rr = r & 15, cc = c & 31, ob = rr * 64 + cc * 2; return st * 1024 + (ob ^ (((ob >> 9) & 1) << 5)); }
__host__ __device__ __forceinline__ void stage_rc(int b, int& R, int& C) { const int st = b / 1024, sb = b % 1024, swz = sb ^ (((sb >> 9) & 1) << 5); R = (st >> 1) * 16 + swz / 64; C = (st & 1) * 32 + (swz % 64) / 2; }
__host__ __device__ __forceinline__ int perm32(int rho) { const int n = rho >> 4, i = rho & 15; return 8 * (i >> 2) + 4 * n + (i & 3); }
struct Unit { int pm, pn; };
struct StaticOrder {
    int nM, nN, nwg, G, c;
    __host__ __device__ __forceinline__ void init(int M, int N, int G_, int c_) { nM = M / BM; nN = N / BM; nwg = nM * nN; G = G_; c = c_; }
    __host__ __device__ __forceinline__ bool next(int i, Unit& u) const {
        const long L = (long)i * G + c; if (L >= nwg) return false;
        int wgid = (int)L; { const int q = nwg / NXCD, r = nwg % NXCD, xcd = wgid % NXCD, off = wgid / NXCD; wgid = (xcd < r ? xcd * (q + 1) : r * (q + 1) + (xcd - r) * q) + off; }
        const int nig = WGM * nN, gid = wgid / nig, fm = gid * WGM, gsz = (nM - fm) < WGM ? (nM - fm) : WGM;
        u.pm = fm + ((wgid % nig) % gsz); u.pn = (wgid % nig) / gsz; return true;
    }
};
struct ListOrder {
    int pm, n;
    __device__ __forceinline__ bool next(int i, Unit& u) const { if (i >= n) return false; u.pm = pm; u.pn = i; return true; }
};
template <class T, class = void> struct HasBrow : std::false_type {};
template <class T> struct HasBrow<T, std::void_t<decltype(std::declval<const T&>().brow(0))>> : std::true_type {};
template <class Op, class Sched>
__device__ __forceinline__ void gemm_phase(LAS unsigned char* lds, const Op& op, const Sched& S, const int wv_) {
    int tid_ = wv_ * 64 + lane_mb(); asm volatile("" : "+v"(tid_));
    const int tid = tid_, wid = __builtin_amdgcn_readfirstlane(tid >> 6), lane = tid & 63, wr = wid >> 2, wc = wid & 3, fr = lane & 15, fq = lane >> 4;
    const int K = op.K, nt = K / BK;
    unsigned voffA0[2], voffA1[2], voffB[2];
#pragma unroll
    for (int i = 0; i < 2; ++i) { int R, C; stage_rc(tid * 16 + i * 8192, R, C); int Rb = Op::PERM ? ((R & ~31) + perm32(R & 31)) : R; if constexpr (HasBrow<Op>::value) Rb = op.brow(Rb);
        if constexpr (!Op::GATHER) { voffA0[i] = op.a_off(R, C); voffA1[i] = 0u; } voffB[i] = (unsigned)(Rb * op.ldb + C) * 2u; }
    const size_t kstep = (size_t)(BK * 2);
    const size_t hstepB = (size_t)HALF * op.ldb * 2;
    size_t hstepA = 0; if constexpr (!Op::GATHER) hstepA = (size_t)op.a_off(HALF, 0);
    const unsigned ldsw = (unsigned)wid * 1024u;
    const int aoff = lds_byte(wr * 64 + fr, fq * 8), boff = lds_byte(wc * 32 + fr, fq * 8);
#define PG8_SA(b, h) (((b) * 2 + (h)) * HTB)
#define PG8_SB(b, h) ((4 + (b) * 2 + (h)) * HTB)
#define PG8_STAGE(bufoff, gbase, voff) do { _Pragma("unroll") for (int _i = 0; _i < 2; ++_i) \
        __builtin_amdgcn_global_load_lds((const unsigned*)((const char*)(gbase) + (voff)[_i]), (LAS unsigned*)(lds + (bufoff) + ldsw + _i * 8192), 16, 0, 0); } while (0)
#define PG8_STAGE_A1(bufoff, gbase, vg) do { if constexpr (Op::GATHER) PG8_STAGE(bufoff, gbase, vg); else PG8_STAGE(bufoff, (gbase) + hstepA, voffA0); } while (0)
#define PG8_LDA(dst, b, h) do { if constexpr (Op::FP8) { _Pragma("unroll") for (int m = 0; m < 4; ++m) dst##8[m] = __builtin_shufflevector(*(const LAS v4i_t*)(lds + PG8_SA(b, h) + aoff + m * 2048), *(const LAS v4i_t*)(lds + PG8_SA(b, h) + aoff + m * 2048 + 1024), 0, 1, 2, 3, 4, 5, 6, 7); } \
        else { _Pragma("unroll") for (int m = 0; m < 4; ++m) _Pragma("unroll") for (int k = 0; k < 2; ++k) dst[m][k] = *(const LAS bf16x8*)(lds + PG8_SA(b, h) + aoff + m * 2048 + k * 1024); } } while (0)
#define PG8_LDB(dst, b, h) do { if constexpr (Op::FP8) { _Pragma("unroll") for (int n = 0; n < 2; ++n) dst##8[n] = __builtin_shufflevector(*(const LAS v4i_t*)(lds + PG8_SB(b, h) + boff + n * 2048), *(const LAS v4i_t*)(lds + PG8_SB(b, h) + boff + n * 2048 + 1024), 0, 1, 2, 3, 4, 5, 6, 7); } \
        else { _Pragma("unroll") for (int n = 0; n < 2; ++n) _Pragma("unroll") for (int k = 0; k < 2; ++k) dst[n][k] = *(const LAS bf16x8*)(lds + PG8_SB(b, h) + boff + n * 2048 + k * 1024); } } while (0)
#define PG8_MMA(ai, bj, At, Bt) do { __builtin_amdgcn_s_setprio(1); _Pragma("unroll") for (int m = 0; m < 4; ++m) _Pragma("unroll") for (int n = 0; n < 2; ++n) _Pragma("unroll") for (int k = 0; k < 2; ++k) \
        acc[ai][bj][m][n] = __builtin_amdgcn_mfma_f32_16x16x32_bf16(Bt[n][k], At[m][k], acc[ai][bj][m][n], 0, 0, 0); __builtin_amdgcn_s_setprio(0); } while (0)
#define PG8_MMA8(ai, bj, At, Bt) do { __builtin_amdgcn_s_setprio(1); _Pragma("unroll") for (int m = 0; m < 4; ++m) _Pragma("unroll") for (int n = 0; n < 2; ++n) \
        asm volatile("v_mfma_scale_f32_16x16x128_f8f6f4 %0, %1, %2, %0, %3, %4 op_sel_hi:[0,0,0]" : "+v"(acc[ai][bj][m][n]) : "v"(Bt##8[n]), "v"(At##8[m]), "v"(sclW), "v"(sclA)); \
        __builtin_amdgcn_s_setprio(0); } while (0)
#define PG8_MMAX(ai, bj, At, Bt) do { if constexpr (Op::FP8) PG8_MMA8(ai, bj, At, Bt); else PG8_MMA(ai, bj, At, Bt); } while (0)
#define PG8_WAIT_V(n) asm volatile("s_waitcnt vmcnt(" #n ")" ::: "memory")
#define PG8_WAIT_L(n) asm volatile("s_waitcnt lgkmcnt(" #n ")" ::: "memory")
#define PG8_BAR __builtin_amdgcn_s_barrier()
#define PG8_SCHED __builtin_amdgcn_sched_barrier(0)
    Unit cur, nxt; int ui = 0;
    if (!S.next(0, cur)) return;
    unsigned nvA0[2], nvA1[2];
    if constexpr (Op::GATHER) {
#pragma unroll
        for (int i = 0; i < 2; ++i) { int R, C; stage_rc(tid * 16 + i * 8192, R, C); voffA0[i] = op.a_off_u(cur, R, C); voffA1[i] = op.a_off_u(cur, R + HALF, C); nvA0[i] = voffA0[i]; nvA1[i] = voffA1[i]; } }
    f32x4 acc[2][2][4][2];
#pragma unroll
    for (int a = 0; a < 2; ++a)
#pragma unroll
        for (int b = 0; b < 2; ++b)
#pragma unroll
            for (int m = 0; m < 4; ++m)
#pragma unroll
                for (int n = 0; n < 2; ++n) acc[a][b][m][n] = (f32x4){0.f, 0.f, 0.f, 0.f};
    int sclW = 0x7A7A7A7A, sclA = 0x7F7F7F7F; (void)sclW; (void)sclA;
    bf16x8 At[4][2], B0[2][2], B1[2][2]; v8i_t At8[4], B08[2], B18[2];
    const char* cA = op.a_base(cur); const char* cB = op.b_base(cur);
    if (PG8_SP2) {
        PG8_STAGE(PG8_SB(0, 0), cB, voffB); PG8_STAGE(PG8_SB(0, 1), cB + hstepB, voffB); PG8_STAGE(PG8_SA(0, 0), cA, voffA0); PG8_STAGE_A1(PG8_SA(0, 1), cA, voffA1);
        if (wr == 1) PG8_BAR;
        PG8_WAIT_V(2); PG8_BAR;
        PG8_STAGE(PG8_SB(1, 0), cB + kstep, voffB); PG8_STAGE(PG8_SA(1, 0), cA + kstep, voffA0); PG8_STAGE(PG8_SB(1, 1), cB + hstepB + kstep, voffB);
        PG8_WAIT_V(6); PG8_BAR;
    } else {
    PG8_STAGE(PG8_SB(0, 0), cB, voffB); PG8_STAGE(PG8_SA(0, 0), cA, voffA0); PG8_STAGE(PG8_SB(0, 1), cB + hstepB, voffB); PG8_STAGE_A1(PG8_SA(0, 1), cA, voffA1);
    if (wr == 1) PG8_BAR;
    PG8_WAIT_V(4); PG8_BAR;
    PG8_STAGE(PG8_SB(1, 0), cB + kstep, voffB); PG8_STAGE(PG8_SA(1, 0), cA + kstep, voffA0); PG8_STAGE(PG8_SB(1, 1), cB + hstepB + kstep, voffB);
    PG8_WAIT_V(6); PG8_BAR;
    }
    for (;;) {
        const bool has_next = S.next(ui + 1, nxt);
        const char* nA = has_next ? op.a_base(nxt) : cA; const char* nB = has_next ? op.b_base(nxt) : cB;
        if constexpr (Op::GATHER) { if (has_next) {
#pragma unroll
            for (int i = 0; i < 2; ++i) { int R, C; stage_rc(tid * 16 + i * 8192, R, C); nvA0[i] = op.a_off_u(nxt, R, C); nvA1[i] = op.a_off_u(nxt, R + HALF, C); } } }
        for (int t = 0; t < nt; t += 2) {
            const bool last = (t == nt - 2);
            if constexpr (Op::GATHER) asm volatile("" : "+v"(voffA1[0]), "+v"(voffA1[1]));
            asm volatile("" : "+v"(voffA0[0]), "+v"(voffA0[1]), "+v"(voffB[0]), "+v"(voffB[1]));
            const char* a1 = cA + (size_t)(t + 1) * kstep;
            const char* a2 = last ? nA : cA + (size_t)(t + 2) * kstep; const char* b2 = last ? nB : cB + (size_t)(t + 2) * kstep;
            const char* a3 = a2 + kstep; const char* b3 = b2 + kstep;
            unsigned sA0[2], sA1[2];
#pragma unroll
            for (int i = 0; i < 2; ++i) { if constexpr (Op::GATHER) { sA0[i] = last ? nvA0[i] : voffA0[i]; sA1[i] = last ? nvA1[i] : voffA1[i]; } else { sA0[i] = voffA0[i]; sA1[i] = voffA1[i]; } }
            if (PG8_SP2) {
            const bool fresh = (t == 0) && (ui > 0);
            PG8_LDB(B0, 0, 0); PG8_LDB(B1, 0, 1); PG8_SCHED; PG8_LDA(At, 0, 0); if (!fresh) PG8_STAGE_A1(PG8_SA(1, 1), a1, voffA1);
            if (!fresh) PG8_WAIT_V(8); PG8_WAIT_L(0); PG8_BAR; PG8_MMAX(0, 0, At, B0); PG8_MMAX(0, 1, At, B1); PG8_BAR; PG8_SCHED;
            PG8_LDA(At, 0, 1); PG8_STAGE(PG8_SB(0, 0), b2, voffB); PG8_STAGE(PG8_SB(0, 1), b2 + hstepB, voffB); PG8_STAGE(PG8_SA(0, 0), a2, sA0);
            if (!fresh) PG8_WAIT_V(8); PG8_WAIT_L(0); PG8_BAR; PG8_MMAX(1, 0, At, B0); PG8_MMAX(1, 1, At, B1); PG8_BAR; PG8_SCHED;
            PG8_LDB(B0, 1, 0); PG8_LDB(B1, 1, 1); PG8_SCHED; PG8_LDA(At, 1, 0); PG8_STAGE_A1(PG8_SA(0, 1), a2, sA1);
            if (!fresh) PG8_WAIT_V(8); PG8_WAIT_L(0); PG8_BAR; PG8_MMAX(0, 0, At, B0); PG8_MMAX(0, 1, At, B1); PG8_BAR; PG8_SCHED;
            PG8_LDA(At, 1, 1); PG8_STAGE(PG8_SB(1, 0), b3, voffB); PG8_STAGE(PG8_SB(1, 1), b3 + hstepB, voffB); PG8_STAGE(PG8_SA(1, 0), a3, sA0);
            if (!fresh) PG8_WAIT_V(8); PG8_WAIT_L(0); PG8_BAR; PG8_MMAX(1, 0, At, B0); PG8_MMAX(1, 1, At, B1); PG8_BAR; PG8_SCHED;
            } else {
            PG8_LDB(B0, 0, 0); PG8_SCHED; PG8_LDA(At, 0, 0); PG8_STAGE_A1(PG8_SA(1, 1), a1, voffA1);
            PG8_WAIT_L(8); PG8_BAR; PG8_WAIT_L(0); PG8_MMAX(0, 0, At, B0); PG8_BAR; PG8_SCHED;
            PG8_LDB(B1, 0, 1); PG8_STAGE(PG8_SB(0, 0), b2, voffB);
            PG8_BAR; PG8_WAIT_L(0); PG8_MMAX(0, 1, At, B1); PG8_BAR;
            PG8_LDA(At, 0, 1); PG8_STAGE(PG8_SA(0, 0), a2, sA0);
            PG8_BAR; PG8_WAIT_L(0); PG8_MMAX(1, 0, At, B0); PG8_BAR; PG8_SCHED;
            PG8_STAGE(PG8_SB(0, 1), b2 + hstepB, voffB);
            PG8_WAIT_V(6); PG8_BAR; PG8_MMAX(1, 1, At, B1); PG8_BAR;
            PG8_LDB(B0, 1, 0); PG8_SCHED; PG8_LDA(At, 1, 0); PG8_STAGE_A1(PG8_SA(0, 1), a2, sA1);
            PG8_WAIT_L(8); PG8_BAR; PG8_WAIT_L(0); PG8_MMAX(0, 0, At, B0); PG8_BAR; PG8_SCHED;
            PG8_LDB(B1, 1, 1); PG8_STAGE(PG8_SB(1, 0), b3, voffB);
            PG8_BAR; PG8_WAIT_L(0); PG8_MMAX(0, 1, At, B1); PG8_BAR;
            PG8_LDA(At, 1, 1); PG8_STAGE(PG8_SA(1, 0), a3, sA0);
            PG8_BAR; PG8_WAIT_L(0); PG8_MMAX(1, 0, At, B0); PG8_BAR; PG8_SCHED;
            PG8_STAGE(PG8_SB(1, 1), b3 + hstepB, voffB);
            PG8_WAIT_V(6); PG8_BAR; PG8_MMAX(1, 1, At, B1); PG8_BAR;
            }
        }
        if constexpr (Op::FP8) asm volatile("s_nop 15\n\ts_nop 15" ::: "memory");
        if (PG8_ALIGN_EPI) { if (wr == 0) PG8_BAR; }
        if (PG8_SP2 && PG8_ALIGN_EPI && has_next) {
            if constexpr (Op::GATHER) { PG8_STAGE_A1(PG8_SA(1, 1), nA + kstep, nvA1); } else { PG8_STAGE_A1(PG8_SA(1, 1), nA + kstep, voffA1); } }
        {
          int lane_e = (int)__builtin_amdgcn_mbcnt_hi(~0u, __builtin_amdgcn_mbcnt_lo(~0u, 0u)); asm volatile("" : "+v"(lane_e));
          const int src_ = ((((lane_e & 3) << 4) | (lane_e >> 2)) << 2);
#pragma unroll
          for (int a = 0; a < 2; ++a)
#pragma unroll
              for (int b = 0; b < 2; ++b)
#pragma unroll
                  for (int m = 0; m < 4; ++m)
#pragma unroll
                      for (int n = 0; n < 2; ++n)
#pragma unroll
                          for (int j = 0; j < 4; ++j) acc[a][b][m][n][j] = __int_as_float(__builtin_amdgcn_ds_bpermute(src_, __float_as_int(acc[a][b][m][n][j])));
          if (PG8_SP2 && PG8_ALIGN_EPI) PG8_WAIT_V(0);
          op.epi(acc, cur, wr, wc, lane_e >> 2, lane_e & 3); }
        if (!has_next) break;
#pragma unroll
        for (int a = 0; a < 2; ++a)
#pragma unroll
            for (int b = 0; b < 2; ++b)
#pragma unroll
                for (int m = 0; m < 4; ++m)
#pragma unroll
                    for (int n = 0; n < 2; ++n) acc[a][b][m][n] = (f32x4){0.f, 0.f, 0.f, 0.f};
        cur = nxt; cA = nA; cB = nB; ++ui;
        if constexpr (Op::GATHER) {
#pragma unroll
            for (int i = 0; i < 2; ++i) { voffA0[i] = nvA0[i]; voffA1[i] = nvA1[i]; } }
        if (PG8_ALIGN_EPI) { if (wr == 1) PG8_BAR; }
    }
    PG8_WAIT_V(0);
    if (!PG8_ALIGN_EPI) { if (wr == 0) PG8_BAR; }
    PG8_BAR;
#undef PG8_SA
#undef PG8_SB
#undef PG8_STAGE
#undef PG8_LDA
#undef PG8_STAGE_A1
#undef PG8_LDB
#undef PG8_MMA
#undef PG8_MMA8
#undef PG8_MMAX
#undef PG8_WAIT_V
#undef PG8_WAIT_L
#undef PG8_BAR
#undef PG8_SCHED
}
}
using pg8::Unit;
typedef f32x4 Acc[2][2][4][2];

struct RopeCS { f32x4 c0, c1, s0, s1; };
__device__ __forceinline__ RopeCS rope_load(const float* cosT, const float* sinT, int row, int fq) { const int i0 = 8 * (fq & 1); RopeCS r;
    r.c0 = *(const f32x4*)(cosT + (size_t)row * 16 + i0); r.c1 = *(const f32x4*)(cosT + (size_t)row * 16 + i0 + 4); r.s0 = *(const f32x4*)(sinT + (size_t)row * 16 + i0); r.s1 = *(const f32x4*)(sinT + (size_t)row * 16 + i0 + 4); return r; }
__device__ __forceinline__ void rope_apply(f32x4& v0, f32x4& v1, const RopeCS& r, int fq) {
    f32x4 p0, p1;
#pragma unroll
    for (int j = 0; j < 4; ++j) { p0[j] = __shfl_xor(v0[j], 2); p1[j] = __shfl_xor(v1[j], 2); }
    if (fq < 2) { v0 = v0 * r.c0 - p0 * r.s0; v1 = v1 * r.c1 - p1 * r.s1; } else { v0 = v0 * r.c0 + p0 * r.s0; v1 = v1 * r.c1 + p1 * r.s1; }
}
__device__ __forceinline__ void rope8(f32x4& v0, f32x4& v1, const float* cosT, const float* sinT, int row, int fq) {
    f32x4 p0, p1;
#pragma unroll
    for (int j = 0; j < 4; ++j) { p0[j] = __shfl_xor(v0[j], 2); p1[j] = __shfl_xor(v1[j], 2); }
    const int i0 = 8 * (fq & 1);
    const f32x4 c0 = *(const f32x4*)(cosT + (size_t)row * 16 + i0), c1 = *(const f32x4*)(cosT + (size_t)row * 16 + i0 + 4);
    const f32x4 s0 = *(const f32x4*)(sinT + (size_t)row * 16 + i0), s1 = *(const f32x4*)(sinT + (size_t)row * 16 + i0 + 4);
    if (fq < 2) { v0 = v0 * c0 - p0 * s0; v1 = v1 * c1 - p1 * s1; }
    else        { v0 = v0 * c0 + p0 * s0; v1 = v1 * c1 + p1 * s1; }
}
__device__ __forceinline__ float ssq8(const f32x4 v0, const f32x4 v1) { return (v0[0] * v0[0] + v0[1] * v0[1]) + (v0[2] * v0[2] + v0[3] * v0[3]) + (v1[0] * v1[0] + v1[1] * v1[1]) + (v1[2] * v1[2] + v1[3] * v1[3]); }
typedef unsigned long long u64;
constexpr float FX_SCALE = 16777216.0f, FX_INV = 1.0f / 16777216.0f;
__device__ __forceinline__ void row_atomic_add(u64* p, float s, int fq) { s += __shfl_xor(s, 1); s += __shfl_xor(s, 2); if (fq == 0) __hip_atomic_fetch_add(p, (u64)(s * FX_SCALE + 0.5f), RLX_AGENT); }
__device__ __forceinline__ float fx_load(const u64* p) { return (float)(*p) * FX_INV; }

#ifndef EPI_FENCE
#define EPI_FENCE
#endif
#define RT_(ai, m) ((ai) * 128 + wr * 64 + (m) * 16 + fr)
#define FOR_AI _Pragma("unroll") for (int ai = 0; ai < 2; ++ai)
#define FOR_M _Pragma("unroll") for (int m = 0; m < 4; ++m)
#define FOR_BJ _Pragma("unroll") for (int bj = 0; bj < 2; ++bj)
__device__ __forceinline__ void unpack8(const u32x4 w, f32x4& v0, f32x4& v1) { v0 = (f32x4){bf_lo(w.x), bf_hi(w.x), bf_lo(w.y), bf_hi(w.y)}; v1 = (f32x4){bf_lo(w.z), bf_hi(w.z), bf_lo(w.w), bf_hi(w.w)}; }
#define EPI_ROWS(...) _Pragma("unroll") for (int ai = 0; ai < 2; ++ai) _Pragma("unroll") for (int m = 0; m < 4; ++m) { const int rt = ai * 128 + wr * 64 + m * 16 + fr; __VA_ARGS__ EPI_FENCE }

template <bool F8> struct OpInT {
    static constexpr bool PERM = true, GATHER = false, FP8 = F8;
    const bf16_t* A; const bf16_t* Bt; int K, lda, ldb;
    bf16_t *QLb, *KVLb, *KRb, *U, *GA, *GB; u64 *ssq_q, *ssq_kv; const float *cosT, *sinT;
    const float* rs0;
    __device__ __forceinline__ unsigned a_off(int r, int c) const { return (unsigned)(r * lda + c) * 2u; }
    __device__ __forceinline__ const char* a_base(const Unit& u) const { return (const char*)(A + (size_t)u.pm * 256 * lda); }
    __device__ __forceinline__ const char* b_base(const Unit& u) const { return (const char*)(Bt + (size_t)u.pn * 256 * ldb); }
    __device__ __forceinline__ void epi(const Acc& acc, const Unit& u, int wr, int wc, int fr, int fq) const {
        const int row0 = u.pm * 256, col = 32 * wc + 8 * fq;
#pragma unroll
        for (int bj = 0; bj < 2; ++bj) {
            const int hc = u.pn * 2 + bj;
            if (hc < 5) {
                u64* ssq = hc < 3 ? ssq_q : ssq_kv;
                if constexpr (F8) {
                    unsigned char* dst = hc < 3 ? (unsigned char*)QLb + hc * 128 : (unsigned char*)KVLb + (hc - 3) * 128; const int pitch = hc < 3 ? 512 : 256;
                    EPI_ROWS( const int row = row0 + rt; const f32x4 v0 = acc[ai][bj][m][0], v1 = acc[ai][bj][m][1];
                        row_atomic_add(ssq + row, ssq8(v0, v1), fq); store8_fp8(dst + (size_t)row * pitch + col, v0, v1);
                        if (hc == 2) *(u32x2*)(dst + (size_t)row * pitch + col + 128) = (u32x2){0u, 0u}; )
                } else {
                bf16_t* dst = hc < 3 ? QLb + hc * 128 : KVLb + (hc - 3) * 128; const int pitch = hc < 3 ? QLORA : KVLORA;
                EPI_ROWS( const int row = row0 + rt; const f32x4 v0 = acc[ai][bj][m][0], v1 = acc[ai][bj][m][1];
                    row_atomic_add(ssq + row, ssq8(v0, v1), fq); store8(dst + (size_t)row * pitch + col, v0, v1); )
                }
            } else if (hc == 5) {
                if (wc == 0) { FOR_AI { RopeCS cs[4]; FOR_M cs[m] = rope_load(cosT, sinT, row0 + RT_(ai, m), fq);
                    FOR_M { const int row = row0 + RT_(ai, m); f32x4 v0 = acc[ai][bj][m][0], v1 = acc[ai][bj][m][1]; rope_apply(v0, v1, cs[m], fq);
                        if constexpr (F8) store8_fp8((unsigned char*)KRb + (size_t)row * ROPE + col, v0, v1);
                        else store8(KRb + (size_t)row * ROPE + col, v0, v1); } } }
            } else if (hc < 10) {
                bf16_t* dst = U + (hc - 6) * 128;
                EPI_ROWS( const int row = row0 + rt; const float r_ = rs0 ? rs0[row] : 1.f; store8(dst + (size_t)row * POOLW + col, acc[ai][bj][m][0] * r_, acc[ai][bj][m][1] * r_); )
            } else {
                bf16_t* dst = hc < 18 ? GA + (hc - 10) * 128 : GB + (hc - 18) * 128;
                EPI_ROWS( const int row = row0 + rt; f32x4 v0 = acc[ai][bj][m][0], v1 = acc[ai][bj][m][1];
                    _Pragma("unroll") for (int j = 0; j < 4; ++j) { v0[j] = sigmoidf_(v0[j]); v1[j] = sigmoidf_(v1[j]); }
                    store8(dst + (size_t)row * DM + col, v0, v1); )
            }
        }
    }
};
typedef OpInT<false> OpIn; typedef OpInT<true> OpIn8;
struct OpGate8 {
    static constexpr bool PERM = true, GATHER = false, FP8 = true;
    const bf16_t* A; const bf16_t* Bt; int K, lda, ldb;
    bf16_t *GA, *GB;
    __device__ __forceinline__ unsigned a_off(int r, int c) const { return (unsigned)(r * lda + c) * 2u; }
    __device__ __forceinline__ const char* a_base(const Unit& u) const { return (const char*)(A + (size_t)u.pm * 256 * lda); }
    __device__ __forceinline__ const char* b_base(const Unit& u) const { return (const char*)(Bt + (size_t)u.pn * 256 * ldb); }
    __device__ __forceinline__ void epi(const Acc& acc, const Unit& u, int wr, int wc, int fr, int fq) const {
        const size_t off = (size_t)u.pm * 256 * DM + ((u.pn - 5) & 3) * 256 + 32 * wc + 8 * fq;
        FOR_AI FOR_M FOR_BJ { f32x4 v0 = acc[ai][bj][m][0], v1 = acc[ai][bj][m][1];
            _Pragma("unroll") for (int j = 0; j < 4; ++j) { v0[j] = sigmoidf_(v0[j]); v1[j] = sigmoidf_(v1[j]); }
            if (u.pn < 9) store8_fp8((unsigned char*)GA + off + (size_t)RT_(ai, m) * DM + bj * 128, v0 * 256.f, v1 * 256.f);
            else store8(GB + off + (size_t)RT_(ai, m) * DM + bj * 128, v0, v1); }
    }
};
struct OffsetOrder { pg8::StaticOrder s; int off; __device__ __forceinline__ bool next(int i, Unit& u) const { if (!s.next(i, u)) return false; u.pn += off; return true; } };
struct OpPlain {
    static constexpr bool PERM = true, GATHER = false, FP8 = false;
    const bf16_t* A; const bf16_t* Bt; int K, lda, ldb;
    bf16_t* O; int ldo;
    __device__ __forceinline__ unsigned a_off(int r, int c) const { return (unsigned)(r * lda + c) * 2u; }
    __device__ __forceinline__ const char* a_base(const Unit& u) const { return (const char*)(A + (size_t)u.pm * 256 * lda); }
    __device__ __forceinline__ const char* b_base(const Unit& u) const { return (const char*)(Bt + (size_t)u.pn * 256 * ldb); }
    __device__ __forceinline__ void epi(const Acc& acc, const Unit& u, int wr, int wc, int fr, int fq) const {
        bf16_t* base = O + (size_t)u.pm * 256 * ldo + u.pn * 256 + 32 * wc + 8 * fq;
        EPI_ROWS( _Pragma("unroll") for (int bj = 0; bj < 2; ++bj) store8(base + (size_t)rt * ldo + bj * 128, acc[ai][bj][m][0], acc[ai][bj][m][1]); )
    }
};
__device__ __forceinline__ int key_of_slot(int sl) { const int hi = sl >> 5, j = sl & 31, jj = j & 15; return ((j >> 4) << 5) + (jj & 3) + 8 * (jj >> 2) + 4 * hi; }
struct OpQ {
    static constexpr bool PERM = true, GATHER = false, FP8 = true;
    const bf16_t* A; const bf16_t* Bt; int K, lda, ldb;
    unsigned char* Q  ; const u64* ssq_q; const float *cosT, *sinT;
    __device__ __forceinline__ unsigned a_off(int r, int c) const { return (unsigned)(r * lda + c) * 2u; }
    __device__ __forceinline__ const char* a_base(const Unit& u) const { return (const char*)(A + (size_t)u.pm * 256 * lda); }
    __device__ __forceinline__ const char* b_base(const Unit& u) const { return (const char*)(Bt + (size_t)u.pn * 256 * ldb); }
    __device__ __forceinline__ void epi(const Acc& acc, const Unit& u, int wr, int wc, int fr, int fq) const {
        float rs[2][4]; FOR_AI FOR_M rs[ai][m] = fx_load(ssq_q + u.pm * 256 + RT_(ai, m));
        FOR_AI FOR_M rs[ai][m] = 16.f * C2Q * __builtin_amdgcn_rsqf(rs[ai][m] * (1.0f / QLORA) + EPS);
        const int g0 = u.pn * 8 + wc; const bool rp0 = (g0 % 3 == 2), rp1 = ((g0 + 4) % 3 == 2);
        FOR_AI _Pragma("unroll") for (int m0 = 0; m0 < 4; m0 += 2) { RopeCS cs[2]; if (rp0 || rp1) { _Pragma("unroll") for (int mi = 0; mi < 2; ++mi) cs[mi] = rope_load(cosT, sinT, u.pm * 256 + RT_(ai, m0 + mi), fq); }
            _Pragma("unroll") for (int mi = 0; mi < 2; ++mi) { const int m = m0 + mi; const int row = u.pm * 256 + RT_(ai, m);
                FOR_BJ { const int g32 = g0 + bj * 4; f32x4 v0 = acc[ai][bj][m][0] * rs[ai][m], v1 = acc[ai][bj][m][1] * rs[ai][m];
                    if (bj == 0 ? rp0 : rp1) rope_apply(v0, v1, cs[mi], fq);
                    unsigned char* qd = Q + (size_t)row * 1024 + (g32 / 3) * 128 + (g32 % 3) * 32 + 8 * fq; store8_fp8(qd, v0, v1); if (bj == 0 ? rp0 : rp1) *(u32x2*)(qd + 32) = (u32x2){0u, 0u}; } } }
    }
};
struct OpK8 {
    static constexpr bool PERM = true, GATHER = false, FP8 = true;
    const bf16_t* A; const bf16_t* Bt; int K, lda, ldb;
    unsigned char* K8; const u64* ssq_kv;
    __device__ __forceinline__ unsigned a_off(int r, int c) const { return (unsigned)(r * lda + c) * 2u; }
    __device__ __forceinline__ const char* a_base(const Unit& u) const { return (const char*)(A + (size_t)u.pm * 256 * lda); }
    __device__ __forceinline__ const char* b_base(const Unit& u) const { return (const char*)(Bt + (size_t)u.pn * 256 * ldb); }
    __device__ __forceinline__ void epi(const Acc& acc, const Unit& u, int wr, int wc, int fr, int fq) const {
        float rs[2][4]; FOR_AI FOR_M rs[ai][m] = fx_load(ssq_kv + u.pm * 256 + RT_(ai, m));
        FOR_AI FOR_M { const int row = u.pm * 256 + RT_(ai, m); const float r_ = __builtin_amdgcn_rsqf(rs[ai][m] * (1.0f / KVLORA) + EPS);
            FOR_BJ { const int col = u.pn * 256 + bj * 128 + 32 * wc + 8 * fq; store8_fp8(K8 + (size_t)row * 512 + col, acc[ai][bj][m][0] * r_, acc[ai][bj][m][1] * r_); } }
    }
};
struct OpVT {
    static constexpr bool PERM = true, GATHER = false, FP8 = true;
    const bf16_t* A; const bf16_t* Bt; int K, lda, ldb;
    unsigned char* VT8; const u64* ssq_kv;
    __device__ __forceinline__ int brow(int c) const { return (c & ~63) + key_of_slot(c & 63); }
    __device__ __forceinline__ unsigned a_off(int r, int c) const { return (unsigned)(r * lda + c) * 2u; }
    __device__ __forceinline__ const char* a_base(const Unit& u) const { return (const char*)(A + (size_t)u.pm * 256 * lda); }
    __device__ __forceinline__ const char* b_base(const Unit& u) const { return (const char*)(Bt + (size_t)u.pn * 256 * ldb); }
    __device__ __forceinline__ void epi(const Acc& acc, const Unit& u, int wr, int wc, int fr, int fq) const {
        float rs[2][2][4];
        FOR_BJ _Pragma("unroll") for (int n = 0; n < 2; ++n) _Pragma("unroll") for (int j = 0; j < 4; ++j) { const int c = bj * 128 + 32 * wc + 8 * fq + 4 * n + j; rs[bj][n][j] = fx_load(ssq_kv + u.pn * 256 + (c & ~63) + key_of_slot(c & 63)); }
        FOR_BJ _Pragma("unroll") for (int n = 0; n < 2; ++n) _Pragma("unroll") for (int j = 0; j < 4; ++j) rs[bj][n][j] = __builtin_amdgcn_rsqf(rs[bj][n][j] * (1.0f / KVLORA) + EPS);
        FOR_AI FOR_M FOR_BJ { f32x4 v0 = acc[ai][bj][m][0], v1 = acc[ai][bj][m][1];
            _Pragma("unroll") for (int j = 0; j < 4; ++j) { v0[j] *= rs[bj][0][j]; v1[j] *= rs[bj][1][j]; }
            const size_t grp = (size_t)u.pn * 4 + 2 * bj + (wc >> 1);
            store8_fp8(VT8 + (grp * 512 + u.pm * 256 + RT_(ai, m)) * 64 + (wc & 1) * 32 + 8 * fq, v0, v1); }
    }
};
struct OpYB {
    static constexpr bool PERM = true, GATHER = false, FP8 = false;
    const bf16_t* A; const bf16_t* Bt; int K, lda, ldb;
    bf16_t* GBM;
    __device__ __forceinline__ unsigned a_off(int r, int c) const { return (unsigned)(r * lda + c) * 2u; }
    __device__ __forceinline__ const char* a_base(const Unit& u) const { return (const char*)(A + (size_t)u.pm * 256 * lda); }
    __device__ __forceinline__ const char* b_base(const Unit& u) const { return (const char*)(Bt + (size_t)u.pn * 256 * ldb); }
    __device__ __forceinline__ void epi(const Acc& acc, const Unit& u, int wr, int wc, int fr, int fq) const {
        bf16_t* base = GBM + (size_t)u.pm * 256 * DM + u.pn * 256 + 32 * wc + 8 * fq;
        u32x4 gb[2][4][2]; FOR_AI FOR_M FOR_BJ gb[ai][m][bj] = *(const u32x4*)(base + (size_t)RT_(ai, m) * DM + bj * 128);
        FOR_AI FOR_M FOR_BJ { f32x4 g0, g1; unpack8(gb[ai][m][bj], g0, g1); store8(base + (size_t)RT_(ai, m) * DM + bj * 128, g0 * acc[ai][bj][m][0], g1 * acc[ai][bj][m][1]); }
    }
};
struct OpYA {
    static constexpr bool PERM = true, GATHER = false, FP8 = true;
    const bf16_t* A; const bf16_t* Bt; int K, lda, ldb;
    const bf16_t* GA; bf16_t* MB; unsigned char* M8;
    __device__ __forceinline__ unsigned a_off(int r, int c) const { return (unsigned)(r * lda + c) * 2u; }
    __device__ __forceinline__ const char* a_base(const Unit& u) const { return (const char*)(A + (size_t)u.pm * 256 * lda); }
    __device__ __forceinline__ const char* b_base(const Unit& u) const { return (const char*)(Bt + (size_t)u.pn * 256 * ldb); }
    __device__ __forceinline__ void epi(const Acc& acc, const Unit& u, int wr, int wc, int fr, int fq) const {
        const size_t off0 = (size_t)u.pm * 256 * DM + u.pn * 256 + 32 * wc + 8 * fq;
        FOR_AI { u32x2 ga[4][2]; u32x4 mb[4][2]; FOR_M FOR_BJ { const size_t off = off0 + (size_t)RT_(ai, m) * DM + bj * 128; ga[m][bj] = *(const u32x2*)((const unsigned char*)GA + off); mb[m][bj] = *(const u32x4*)(MB + off); }
            FOR_M FOR_BJ { const size_t off = off0 + (size_t)RT_(ai, m) * DM + bj * 128; f32x4 g0, g1, b0, b1; unpack8_fp8(ga[m][bj], g0, g1); unpack8(mb[m][bj], b0, b1);
                store8_fp8(M8 + off, (g0 * (acc[ai][bj][m][0] * (0.0625f / 256.f)) + b0) * 4.f, (g1 * (acc[ai][bj][m][1] * (0.0625f / 256.f)) + b1) * 4.f); } }
    }
};
template <bool BASE_F32, bool F8 = false> struct OpRes {
    static constexpr bool PERM = true, GATHER = false, FP8 = F8;
    const bf16_t* A; const bf16_t* Bt; int K, lda, ldb;
    const void* base; bf16_t* Hout; u64* ssq; size_t bbatch;
    unsigned char* H8; float ascale;
    __device__ __forceinline__ unsigned a_off(int r, int c) const { return (unsigned)(r * lda + c) * 2u; }
    __device__ __forceinline__ const char* a_base(const Unit& u) const { return (const char*)(A + (size_t)u.pm * 256 * lda); }
    __device__ __forceinline__ const char* b_base(const Unit& u) const { return (const char*)(Bt + (size_t)(u.pm >> 4) * bbatch + (size_t)u.pn * 256 * ldb); }
    __device__ __forceinline__ void epi(const Acc& acc, const Unit& u, int wr, int wc, int fr, int fq) const {
        const size_t off0 = (size_t)u.pm * 256 * DM + u.pn * 256 + 32 * wc + 8 * fq;
        constexpr int MB_ = 4;
        FOR_AI _Pragma("unroll") for (int m0 = 0; m0 < 4; m0 += MB_) { f32x4 bv[MB_][2][2];
            _Pragma("unroll") for (int mi = 0; mi < MB_; ++mi) FOR_BJ { const size_t off = off0 + (size_t)RT_(ai, m0 + mi) * DM + bj * 128;
                if (BASE_F32) { bv[mi][bj][0] = *(const f32x4*)((const float*)base + off); bv[mi][bj][1] = *(const f32x4*)((const float*)base + off + 4); } else load8((const bf16_t*)base + off, bv[mi][bj][0], bv[mi][bj][1]); }
            _Pragma("unroll") for (int mi = 0; mi < MB_; ++mi) { const int m = m0 + mi; float s = 0.f;
                FOR_BJ { const size_t off = off0 + (size_t)RT_(ai, m) * DM + bj * 128; const f32x4 h0 = bv[mi][bj][0] + acc[ai][bj][m][0] * ascale, h1 = bv[mi][bj][1] + acc[ai][bj][m][1] * ascale; s += ssq8(h0, h1); store8(Hout + off, h0, h1); if (H8) store8_fp8(H8 + off, h0, h1); }
                row_atomic_add(ssq + u.pm * 256 + RT_(ai, m), s, fq); }
            asm volatile("" ::: "memory"); }
    }
};
struct OpPre {
    static constexpr bool PERM = true, GATHER = false, FP8 = false;
    const bf16_t* KVM; const bf16_t* W; int K, lda, ldb; unsigned char* O; int mode;
    __device__ __forceinline__ unsigned a_off(int r, int c) const { return (unsigned)(r * lda + c) * 2u; }
    __device__ __forceinline__ const char* a_base(const Unit& u) const { return mode == 0 ? (const char*)(KVM + (size_t)(u.pm >> 2) * 256 * 2048 + (u.pm & 3) * 256) : (const char*)(W + (size_t)(u.pm & 3) * 256 * DM + u.pn * 256); }
    __device__ __forceinline__ const char* b_base(const Unit& u) const { return mode == 0 ? (const char*)(W + (size_t)u.pn * 256 * DM + (u.pm & 3) * 256) : (const char*)(KVM + (size_t)(u.pm >> 2) * 256 * 2048 + DM + u.pn * 256); }
    __device__ __forceinline__ void epi(const Acc& acc, const Unit& u, int wr, int wc, int fr, int fq) const {
        unsigned char* base = O + (size_t)u.pm * 256 * DM + u.pn * 256 + 32 * wc + 8 * fq;
        FOR_AI FOR_M FOR_BJ store8_fp8(base + (size_t)RT_(ai, m) * DM + bj * 128, acc[ai][bj][m][0] * 32.f, acc[ai][bj][m][1] * 32.f);
    }
};
struct OpSX {
    static constexpr bool PERM = true, GATHER = false, FP8 = true;
    const bf16_t* A; const bf16_t* BQK; int K, lda, ldb;
    unsigned char* P; const u64* ssq1; LAS f32x4* ps;
    __device__ __forceinline__ unsigned a_off(int r, int c) const { return (unsigned)(r * lda + c) * 2u; }
    __device__ __forceinline__ const char* a_base(const Unit& u) const { return (const char*)(A + (size_t)u.pm * 256 * lda); }
    __device__ __forceinline__ const char* b_base(const Unit& u) const { return (const char*)(BQK + ((size_t)(u.pm >> 4) * DM + u.pn * 256) * ldb); }
    __device__ __forceinline__ void epi(Acc& acc, const Unit& u, int wr, int wc, int fr, int fq) const {
        float rs[2][4]; FOR_AI FOR_M rs[ai][m] = fx_load(ssq1 + u.pm * 256 + RT_(ai, m));
        FOR_AI FOR_M { const float r_ = C2X * __builtin_amdgcn_rsqf(rs[ai][m] * (1.0f / DM) + EPS); float s = 0.f;
            FOR_BJ { _Pragma("unroll") for (int n = 0; n < 2; ++n) _Pragma("unroll") for (int j = 0; j < 4; ++j) { const float e = fast_exp2(acc[ai][bj][m][n][j] * r_); acc[ai][bj][m][n][j] = e; s += e; } }
            s += __shfl_xor(s, 1); s += __shfl_xor(s, 2);
            if (fq == 0) ((LAS float*)(ps + RT_(ai, m)))[wc] = s; }
        asm volatile("s_waitcnt lgkmcnt(0)\n\ts_barrier" ::: "memory");
        unsigned char* base = P + (size_t)u.pm * 256 * DM + u.pn * 256 + 32 * wc + 8 * fq;
        FOR_AI FOR_M { const f32x4 q = ps[RT_(ai, m)]; const float inv = 256.f * __builtin_amdgcn_rcpf((q[0] + q[1]) + (q[2] + q[3]));
            FOR_BJ store8_fp8(base + (size_t)RT_(ai, m) * DM + bj * 128, acc[ai][bj][m][0] * inv, acc[ai][bj][m][1] * inv); }
    }
};
struct OpR {
    static constexpr bool PERM = false, GATHER = false, FP8 = false;
    const bf16_t* A; const bf16_t* Bt; int K, lda, ldb;
    float* LG; const u64* ssq2;
    __device__ __forceinline__ unsigned a_off(int r, int c) const { return (unsigned)(r * lda + c) * 2u; }
    __device__ __forceinline__ const char* a_base(const Unit& u) const { return (const char*)(A + (size_t)u.pm * 256 * lda); }
    __device__ __forceinline__ const char* b_base(const Unit& u) const { return (const char*)(Bt + (size_t)u.pn * 256 * ldb); }
    __device__ __forceinline__ void epi(const Acc& acc, const Unit& u, int wr, int wc, int fr, int fq) const {
        if (wc > 1) return;
        float rs[2][4]; FOR_AI FOR_M rs[ai][m] = fx_load(ssq2 + u.pm * 256 + RT_(ai, m));
        FOR_AI FOR_M { const int row = u.pm * 256 + RT_(ai, m); const float r_ = __builtin_amdgcn_rsqf(rs[ai][m] * (1.0f / DM) + EPS); float* lg = LG + (size_t)row * 40;
            if (wc == 0) { *(f32x4*)(lg + 4 * fq) = acc[ai][0][m][0] * r_; *(f32x4*)(lg + 16 + 4 * fq) = acc[ai][0][m][1] * r_; }
            else if (fq == 0) { *(f32x4*)(lg + 32) = acc[ai][0][m][0] * r_; } }
    }
};
struct MoeTab { const LAS int* tileE; const LAS int* tbase; const LAS int* cntL; };
template <int NPN> struct MoeOrder {
    int nunits, G, c;
    __device__ __forceinline__ bool next(int i, Unit& u) const { const int L = i * G + c; if (L >= nunits) return false; u.pm = L / NPN; u.pn = L - u.pm * NPN; return true; }
};
struct OpGU {
    static constexpr bool PERM = true, GATHER = true, FP8 = true;
    const bf16_t* A; const bf16_t* WGUp; int K, lda, ldb;
    unsigned char* HID  ; const int* LIST; const float* WL; const float* RSL; MoeTab tb;
    __device__ __forceinline__ unsigned a_off_u(const Unit& u, int r, int c) const { const int e = tb.tileE[u.pm]; const int p = (u.pm - tb.tbase[e]) * 256 + r;
        const int tok = p < tb.cntL[e] ? (LIST[(size_t)e * NTOK + p] >> 1) : 0; return (unsigned)(tok * lda + c) * 2u; }
    __device__ __forceinline__ const char* a_base(const Unit&) const { return (const char*)A; }
    __device__ __forceinline__ const char* b_base(const Unit& u) const { return (const char*)(WGUp + ((size_t)tb.tileE[u.pm] * 512 + u.pn * 256) * ldb); }
    __device__ __forceinline__ void epi(const Acc& acc, const Unit& u, int wr, int wc, int fr, int fq) const {
        const int e = tb.tileE[u.pm], row0 = (u.pm - tb.tbase[e]) * 256, ce = tb.cntL[e]; const size_t lb = (size_t)e * NTOK + row0;
        float cw[2][4], rs[2][4];
        FOR_AI FOR_M { const int r = RT_(ai, m); const bool v = row0 + r < ce; cw[ai][m] = v ? WL[lb + r] : 0.f; rs[ai][m] = v ? RSL[lb + r] : 0.f; }
        unsigned char* base = HID + (size_t)u.pm * 256 * EFF + u.pn * 128 + 32 * wc + 8 * fq;
        FOR_AI FOR_M { const float r_ = rs[ai][m], c_ = cw[ai][m]; f32x4 h0, h1;
#pragma unroll
            for (int j = 0; j < 4; ++j) { const float g0 = acc[ai][0][m][0][j] * r_, u0 = acc[ai][1][m][0][j] * r_, g1 = acc[ai][0][m][1][j] * r_, u1 = acc[ai][1][m][1][j] * r_;
                h0[j] = g0 * sigmoidf_(g0) * u0 * c_ * 16.f; h1[j] = g1 * sigmoidf_(g1) * u1 * c_ * 16.f; }
            store8_fp8(base + (size_t)RT_(ai, m) * EFF, h0, h1); }
    }
};
struct OpDN {
    static constexpr bool PERM = true, GATHER = false, FP8 = true;
    const bf16_t* HID; const bf16_t* WDp; int K, lda, ldb;
    unsigned char* Y  ; const int* LIST; MoeTab tb;
    __device__ __forceinline__ unsigned a_off(int r, int c) const { return (unsigned)(r * lda + c) * 2u; }
    __device__ __forceinline__ const char* a_base(const Unit& u) const { return (const char*)(HID + (size_t)u.pm * 256 * lda); }
    __device__ __forceinline__ const char* b_base(const Unit& u) const { return (const char*)(WDp + ((size_t)tb.tileE[u.pm] * DM + u.pn * 256) * ldb); }
    __device__ __forceinline__ void epi(const Acc& acc, const Unit& u, int wr, int wc, int fr, int fq) const {
        const int e = tb.tileE[u.pm], row0 = (u.pm - tb.tbase[e]) * 256, ce = tb.cntL[e]; const size_t lb = (size_t)e * NTOK + row0;
        int ent[2][4];
        FOR_AI FOR_M { const int r = RT_(ai, m); ent[ai][m] = row0 + r < ce ? LIST[lb + r] : -1; }
        FOR_AI FOR_M { const int en = ent[ai][m];
            if (en >= 0) { unsigned char* p = Y + ((size_t)(en & 1) * NTOK + (size_t)(en >> 1)) * DM + u.pn * 256 + 32 * wc + 8 * fq;
                FOR_BJ store8_fp8(p + bj * 128, acc[ai][bj][m][0], acc[ai][bj][m][1]); } }
    }
};
__device__ __forceinline__ int moe_build_tables(const unsigned* cnt, LAS int* cntL, LAS int* tbase, LAS int* tileE, int tid) {
    if (tid < NEXP) cntL[tid] = (int)__hip_atomic_load(cnt + tid, RLX_AGENT);
    __syncthreads();
    if (tid == 0) { int acc_ = 0; for (int e = 0; e < NEXP; ++e) { tbase[e] = acc_; acc_ += (cntL[e] + 255) >> 8; } tbase[NEXP] = acc_; }
    __syncthreads();
    const int nt = tbase[NEXP];
    for (int t = tid; t < nt; t += 512) { int e = 0; for (int k = 1; k < NEXP; ++k) e += (tbase[k] <= t) ? 1 : 0; tileE[t] = e; }
    __syncthreads();
    return __builtin_amdgcn_readfirstlane(nt);
}

namespace mla {
constexpr int KSLOT = 4096, RSLOT = 2048, VSLOT = 4096, NSLOT = 8;
constexpr int L_K = 0, L_R = NSLOT * KSLOT, L_V = L_R + NSLOT * RSLOT, L_WS = L_V + NSLOT * VSLOT, L_OST = L_WS + 8 * 256, L_DUM = L_OST + 8 * 4096, L_END = L_DUM + 8 * 1024;
static_assert(L_END <= RING_BYTES, "attention LDS");
constexpr float THR = 6.0f;
__device__ __forceinline__ int crow(int r, int hi) { return (r & 3) + 8 * (r >> 2) + 4 * hi; }
__device__ __forceinline__ void glds16(const void* gsrc, unsigned lds_dst) { unsigned keep;
    asm volatile("s_mov_b32 %0, m0\n\ts_mov_b32 m0, %2\n\ts_nop 0\n\tglobal_load_lds_dwordx4 %1, off\n\ts_mov_b32 m0, %0" : "=&s"(keep) : "v"(gsrc), "s"(lds_dst) : "memory"); }
#define MX3(a, b, c) __builtin_fmaxf(__builtin_fmaxf((a), (b)), (c))
__device__ __forceinline__ float rowmax(const f32x16& p0, const f32x16& p1) {
    float a = MX3(p0[0], p0[1], p1[0]), b = MX3(p0[2], p0[3], p1[1]); a = MX3(a, p1[2], p1[3]);
#pragma unroll
    for (int r = 4; r < 16; r += 4) { a = MX3(a, p0[r], p0[r + 1]); b = MX3(b, p0[r + 2], p0[r + 3]); a = MX3(a, p1[r], p1[r + 1]); b = MX3(b, p1[r + 2], p1[r + 3]); }
    a = __builtin_fmaxf(a, b);
    auto rr = __builtin_amdgcn_permlane32_swap(__float_as_uint(a), __float_as_uint(a), false, false);
    return __builtin_fmaxf(__uint_as_float(rr[0]), __uint_as_float(rr[1]));
}
#define MLA_SC1 0x7F7F7F7F
#define MLA_SCQ 0x7B7B7B7B
template <bool GA> __device__ __forceinline__ void attn_unit(int b, int h, int qb, const unsigned char* Q8, const unsigned char* K8, const unsigned char* KR8, const unsigned char* VT8, bf16_t* O, LAS unsigned char* shm, const int wv_) {
    int tid = wv_ * 64 + lane_mb(); asm volatile("" : "+v"(tid));
    const int lane = tid & 63, r32 = lane & 31, hi = lane >> 5; const int wid = __builtin_amdgcn_readfirstlane(tid >> 6);
    const long rowbase = (long)b * SEQ; const int q0 = qb * 256;
    const unsigned lds0 = (unsigned)(uintptr_t)shm;
    LAS float* wsf = (LAS float*)(shm + L_WS) + wid * 64;
    const int sw1 = (lane & 3) ^ ((lane >> 4) & 3);
    const unsigned char* src1 = wid < 4 ? K8 + (rowbase + wid * 16 + (lane >> 2)) * 512 + h * 64 + sw1 * 16
                                        : VT8 + ((size_t)(rowbase >> 6) * 512 + h * 64 + (wid - 4) * 16 + (lane >> 2)) * 64 + sw1 * 16;
    const long step1 = wid < 4 ? 64 * 512 : 512 * 64;
    const unsigned dst1 = wid < 4 ? lds0 + L_K + wid * 1024 : lds0 + L_V + (wid - 4) * 1024; const unsigned slot1 = wid < 4 ? KSLOT : VSLOT;
    const unsigned char* src2 = wid < 2 ? KR8 + (rowbase + wid * 32 + (lane >> 1)) * ROPE + ((lane & 1) ^ ((lane >> 4) & 1)) * 16 : src1;
    const long step2 = wid < 2 ? 64 * ROPE : step1;
    const unsigned dst2 = wid < 2 ? lds0 + L_R + wid * 1024 : lds0 + L_DUM + wid * 1024; const unsigned slot2 = wid < 2 ? RSLOT : 0;
#define MLA_DMA(t, s) do { glds16(src1 + (long)(t) * step1, (unsigned)__builtin_amdgcn_readfirstlane(dst1 + (s) * slot1)); \
        glds16(src2 + (long)(t) * step2, (unsigned)__builtin_amdgcn_readfirstlane(dst2 + (s) * slot2)); } while (0)
    const int NT = 4 * qb + 4, nvis = 4 * qb + (wid >> 1) + 1;
    v8i_t qf[2];
    { const unsigned char* qp = Q8 + (rowbase + q0 + wid * 32 + r32) * 1024 + h * 128 + hi * 32;
#pragma unroll
      for (int st = 0; st < 2; ++st) qf[st] = __builtin_shufflevector(*(const v4i_t*)(qp + st * 64), *(const v4i_t*)(qp + st * 64 + 16), 0, 1, 2, 3, 4, 5, 6, 7); }
    asm volatile("" ::: "memory");
    MLA_DMA(0, 0); MLA_DMA(1, 1); MLA_DMA(2, 2); MLA_DMA(3, 3);
    float mrun = 0.f; f32x16 o[2], lacc;
#pragma unroll
    for (int r = 0; r < 16; ++r) { float z0, z1, z2; asm volatile("v_mov_b32 %0, 0\n\tv_mov_b32 %1, 0\n\tv_mov_b32 %2, 0" : "=v"(z0), "=v"(z1), "=v"(z2)); o[0][r] = z0; o[1][r] = z1; lacc[r] = z2; }
    f32x16 negm;
#pragma unroll
    for (int r = 0; r < 16; ++r) { float z_; asm volatile("v_mov_b32 %0, 0" : "=v"(z_)); negm[r] = z_; }
    v8i_t kn0, kn1, kr0, kr1, p8;
    const int swr = (r32 >> 2) & 3, k64a = ((2 * hi) ^ swr) * 16, k64b = ((2 * hi + 1) ^ swr) * 16, k32a = ((r32 >> 3) & 1) * 16;
#define MLA_KLD(sl_) do { const LAS unsigned char* kp = shm + L_K + (sl_) * KSLOT + r32 * 64; const LAS unsigned char* rp = shm + L_R + (sl_) * RSLOT + r32 * 32; \
        kn0 = __builtin_shufflevector(*(const LAS v4i_t*)(kp + k64a), *(const LAS v4i_t*)(kp + k64b), 0, 1, 2, 3, 4, 5, 6, 7); \
        kn1 = __builtin_shufflevector(*(const LAS v4i_t*)(kp + 2048 + k64a), *(const LAS v4i_t*)(kp + 2048 + k64b), 0, 1, 2, 3, 4, 5, 6, 7); \
        kr0 = __builtin_shufflevector(*(const LAS v4i_t*)(rp + k32a), *(const LAS v4i_t*)(rp + (k32a ^ 16)), 0, 1, 2, 3, 4, 5, 6, 7);      \
        kr1 = __builtin_shufflevector(*(const LAS v4i_t*)(rp + 1024 + k32a), *(const LAS v4i_t*)(rp + 1024 + (k32a ^ 16)), 0, 1, 2, 3, 4, 5, 6, 7); } while (0)
#define MLA_VLD(sl_) do { const LAS unsigned char* vp = shm + L_V + (sl_) * VSLOT + r32 * 64; \
        vf0 = __builtin_shufflevector(*(const LAS v4i_t*)(vp + k64a), *(const LAS v4i_t*)(vp + k64b), 0, 1, 2, 3, 4, 5, 6, 7); \
        vf1 = __builtin_shufflevector(*(const LAS v4i_t*)(vp + 2048 + k64a), *(const LAS v4i_t*)(vp + 2048 + k64b), 0, 1, 2, 3, 4, 5, 6, 7); } while (0)
#define MLA_MF(a_, b_, c_, sa_, sb_) __builtin_amdgcn_mfma_scale_f32_32x32x64_f8f6f4(a_, b_, c_, 0, 0, 0, sa_, 0, sb_)
#define MLA_QK(P0, P1) do { \
        P0 = MLA_MF(kn0, qf[0], negm, MLA_SC1, MLA_SCQ); P1 = MLA_MF(kn1, qf[0], negm, MLA_SC1, MLA_SCQ); \
        P0 = MLA_MF(kr0, qf[1], P0, MLA_SC1, MLA_SCQ); P1 = MLA_MF(kr1, qf[1], P1, MLA_SC1, MLA_SCQ); } while (0)
#define MLA_PV() do { o[0] = MLA_MF(p8, vf0, o[0], MLA_SC1, MLA_SC1); o[1] = MLA_MF(p8, vf1, o[1], MLA_SC1, MLA_SC1); { v8i_t ones; _Pragma("unroll") for (int i = 0; i < 8; ++i) { int w_; asm volatile("v_mov_b32 %0, 0x38383838" : "=v"(w_)); ones[i] = w_; }        \
          lacc = MLA_MF(p8, ones, lacc, MLA_SC1, MLA_SC1); } } while (0)
#define MLA_SM(PA0, PA1, PB0, PB1, t, ADJB) do { \
            const float rm = rowmax(PA0, PA1); \
            if (__any(rm > THR)) { const float dl = __builtin_fmaxf(rm, 0.f); mrun += dl; \
                _Pragma("unroll") for (int r = 0; r < 16; ++r) { PA0[r] -= dl; PA1[r] -= dl; } \
                if (ADJB && (t) + 1 < nvis) { _Pragma("unroll") for (int r = 0; r < 16; ++r) { PB0[r] -= dl; PB1[r] -= dl; } } \
                _Pragma("unroll") for (int r = 0; r < 16; ++r) negm[r] = -mrun; \
                asm volatile("" : "+v"(negm)); \
                const float f = fast_exp2(-dl); if (hi == 0) wsf[r32] = f; LDS_WAIT(); \
                _Pragma("unroll") for (int r = 0; r < 16; ++r) { const float fr_ = wsf[crow(r, hi)]; o[0][r] *= fr_; o[1][r] *= fr_; lacc[r] *= fr_; } \
                LDS_WAIT(); } \
            _Pragma("unroll") for (int r = 0; r < 16; ++r) { PA0[r] = fast_exp2(PA0[r]); PA1[r] = fast_exp2(PA1[r]); } \
            _Pragma("unroll") for (int i = 0; i < 4; ++i) { p8[i] = (int)cvt4_fp8(PA0[4 * i], PA0[4 * i + 1], PA0[4 * i + 2], PA0[4 * i + 3]); p8[4 + i] = (int)cvt4_fp8(PA1[4 * i], PA1[4 * i + 1], PA1[4 * i + 2], PA1[4 * i + 3]); } \
        } while (0)
#define MLA_STEP(PA0, PA1, PB0, PB1, t) do { \
        if ((t) + 2 < NT) { if ((t) + 3 < NT) asm volatile("s_waitcnt vmcnt(2) lgkmcnt(0)\n\ts_barrier" ::: "memory"); else asm volatile("s_waitcnt vmcnt(0) lgkmcnt(0)\n\ts_barrier" ::: "memory"); } \
        if ((t) + 4 < NT) MLA_DMA((t) + 4, ((t) + 4) & 7); \
        v8i_t vf0, vf1;                                                       \
        if constexpr (GA) { \
            const bool pv_ = (t) >= 1 && (t) - 1 < nvis; \
            if (pv_) MLA_VLD(((t) - 1) & 7); \
            if ((t) + 1 < nvis) MLA_QK(PB0, PB1); \
            if (pv_) MLA_PV(); \
            if ((t) < nvis) MLA_SM(PA0, PA1, PB0, PB1, t, true); \
            __builtin_amdgcn_sched_barrier(0); \
            if ((t) + 2 < nvis) MLA_KLD(((t) + 2) & 7); \
        } else { \
            if ((t) < nvis) { \
                MLA_VLD((t) & 7); \
                if ((t) + 1 < nvis) MLA_KLD(((t) + 1) & 7); \
                MLA_SM(PA0, PA1, PB0, PB1, t, false); \
                __builtin_amdgcn_sched_barrier(0); \
                if ((t) + 1 < nvis) MLA_QK(PB0, PB1); \
                MLA_PV(); } \
        } \
    } while (0)
    asm volatile("s_waitcnt vmcnt(4) lgkmcnt(0)\n\ts_barrier" ::: "memory");
    f32x16 pA0, pA1, pB0, pB1;
    MLA_KLD(0); MLA_QK(pA0, pA1);
    { const float rm = rowmax(pA0, pA1); mrun = rm;
#pragma unroll
        for (int r = 0; r < 16; ++r) { pA0[r] -= rm; pA1[r] -= rm; negm[r] = -rm; }
        asm volatile("" : "+v"(negm)); }
    if (GA && 1 < nvis) MLA_KLD(1);
    for (int t = 0; t < NT; t += 2) {
        MLA_STEP(pA0, pA1, pB0, pB1, t);
        MLA_STEP(pB0, pB1, pA0, pA1, t + 1);
    }
    if (GA && nvis == NT) { v8i_t vf0, vf1; MLA_VLD((NT - 1) & 7); MLA_PV(); }
#undef MLA_SM
#undef MLA_VLD
#undef MLA_MF
#undef MLA_PV
#undef MLA_KLD
#undef MLA_QK
#undef MLA_STEP
    float rli[16];
#pragma unroll
    for (int r = 0; r < 16; ++r) rli[r] = __builtin_amdgcn_rcpf(lacc[r]);
    unsigned char* Ow = (unsigned char*)O + (rowbase + q0 + wid * 32) * 512 + h * 64;
    { LAS unsigned char* stg = (LAS unsigned char*)(shm + L_OST) + wid * 4096;
#pragma unroll
        for (int r = 0; r < 16; ++r) { const int orow = crow(r, hi); const unsigned w = cvt4_fp8(o[0][r] * rli[r] * 16.f, o[1][r] * rli[r] * 16.f, 0.f, 0.f);
            stg[orow * 64 + r32] = (unsigned char)(w & 0xffu); stg[orow * 64 + 32 + r32] = (unsigned char)((w >> 8) & 0xffu); }
        LDS_WAIT();
#pragma unroll
        for (int i = 0; i < 2; ++i) { const int row = i * 16 + (lane >> 2), ch = lane & 3; const u32x4 v = *(const LAS u32x4*)(stg + row * 64 + ch * 16); *(u32x4*)(Ow + (long)row * 512 + ch * 16) = v; } }
    asm volatile("s_waitcnt lgkmcnt(0)\n\ts_barrier" ::: "memory");
#undef MLA_DMA
#undef MX3
}
}

#define XB_TMO      128
#define XB_XCNT(j)  (256  + 64 * (j))
#define XB_XSUB(j)  (1280 + 64 * (j))
#define XB_XGEN(j)  (2304 + 64 * (j))
#define XB_TOP      3328
#define XB_TOPGEN   3392
#define XCD_BAR_WORDS 3456
#define XB_SPIN_CAP (1u << 18)
__device__ __forceinline__ unsigned xb_ld(unsigned* p)              { return __hip_atomic_load(p, __ATOMIC_RELAXED, __HIP_MEMORY_SCOPE_AGENT); }
__device__ __forceinline__ unsigned xb_add(unsigned* p, unsigned v) { return __hip_atomic_fetch_add(p, v, __ATOMIC_RELAXED, __HIP_MEMORY_SCOPE_AGENT); }
__device__ __forceinline__ unsigned xb_xcc_id() { return (unsigned)__builtin_amdgcn_s_getreg((3 << 11) | 20) & 0xFu; }
#define XB_SPIN(cond, bar) do { unsigned _sp = 0; while (cond) { __builtin_amdgcn_s_sleep(1); \
    if ((++_sp & 255u) == 0u) { if (xb_ld(&(bar)[XB_TMO])) break; if (_sp > XB_SPIN_CAP) { atomicAdd(&(bar)[XB_TMO], 1u); break; } } } } while (0)
struct XcdBarrier { unsigned* bar; unsigned x; volatile LAS unsigned* st; int w; };
__device__ __forceinline__ XcdBarrier xcd_barrier_post(unsigned* bar, volatile LAS unsigned* st) {
    XcdBarrier b; b.bar = bar; b.x = xb_xcc_id(); b.st = st;
    if (threadIdx.x == 0) (void)xb_add(&bar[XB_XCNT(b.x)], 1u);
    return b;
}
__device__ __forceinline__ void xcd_barrier_complete(unsigned* bar, unsigned x, unsigned& nloc, unsigned& nx) {
    const unsigned G = gridDim.x * gridDim.y * gridDim.z;
    unsigned sum, cnt, mine, sp = 0u;
    for (;;) {
        sum = 0u; cnt = 0u; mine = 0u;
#pragma unroll
        for (unsigned j = 0; j < 16; ++j) { const unsigned c = xb_ld(&bar[XB_XCNT(j)]); sum += c; cnt += (c > 0u) ? 1u : 0u; mine = (j == x) ? c : mine; }
        if (sum == G) break;
        __builtin_amdgcn_s_sleep(1);
        if ((++sp & 255u) == 0u) { if (xb_ld(&bar[XB_TMO])) break; if (sp > XB_SPIN_CAP) { atomicAdd(&bar[XB_TMO], 1u); break; } }
    }
    nloc = mine > 0u ? mine : 1u; nx = cnt > 0u ? cnt : 1u;
}
__device__ __forceinline__ void xcd_barrier(const XcdBarrier& b) {
    asm volatile("s_waitcnt vmcnt(0)" ::: "memory");
    __syncthreads();
    if (b.w == 0 && lane_mb() == 0) {
        unsigned* bar = b.bar;
        __builtin_amdgcn_s_waitcnt(0);
        unsigned nloc = b.st[0], nx = b.st[1];
        if (nloc == 0u) { xcd_barrier_complete(bar, b.x, nloc, nx); b.st[0] = nloc; b.st[1] = nx; }
        const unsigned old = xb_add(&bar[XB_XSUB(b.x)], 1u);
        const unsigned gen = old / nloc;
        if (old + 1u == (gen + 1u) * nloc) {
            __builtin_amdgcn_fence(__ATOMIC_RELEASE, "agent");
            asm volatile("s_waitcnt vmcnt(0)" ::: "memory");
            const unsigned og = xb_add(&bar[XB_TOP], 1u);
            const unsigned tg = og / nx;
            if (og + 1u == (tg + 1u) * nx) xb_add(&bar[XB_TOPGEN], 1u);
            else XB_SPIN(xb_ld(&bar[XB_TOPGEN]) == tg, bar);
            __builtin_amdgcn_fence(__ATOMIC_ACQUIRE, "agent");
            xb_add(&bar[XB_XGEN(b.x)], 1u);
            asm volatile("s_waitcnt vmcnt(0)" ::: "memory");
        } else {
            XB_SPIN(xb_ld(&bar[XB_XGEN(b.x)]) == gen, bar);
            __builtin_amdgcn_fence(__ATOMIC_ACQUIRE, "agent");
            asm volatile("s_waitcnt vmcnt(0)" ::: "memory");
        }
    }
    __syncthreads();
}

__device__ __forceinline__ void transpose_block(const float* src, int ldw, const float* gain, bf16_t* dst  , int ldt, LAS float* scr, int lane, unsigned char* dst8 = nullptr, int ldt8 = 0, float sc8 = 1.f) {
    float tv[32];
#pragma unroll
    for (int i = 0; i < 32; ++i) { const int kk = 2 * i + (lane >> 5); tv[i] = src ? src[(size_t)kk * ldw + (lane & 31)] : 0.f; }
#pragma unroll
    for (int i = 0; i < 32; ++i) { const int kk = 2 * i + (lane >> 5); float v = tv[i]; if (gain) v *= gain[kk]; scr[kk * 33 + (lane & 31)] = v; }
    LDS_WAIT(); asm volatile("" ::: "memory");
    const int c = lane & 7;
#pragma unroll
    for (int j = 0; j < 4; ++j) { const int n = (lane >> 3) + 8 * j; const LAS float* s = scr + (8 * c) * 33 + n;
        u32x4 o; o.x = cvt_pk_bf16(s[0 * 33], s[1 * 33]); o.y = cvt_pk_bf16(s[2 * 33], s[3 * 33]); o.z = cvt_pk_bf16(s[4 * 33], s[5 * 33]); o.w = cvt_pk_bf16(s[6 * 33], s[7 * 33]);
        if (dst) *(u32x4*)(dst + (size_t)n * ldt + 8 * c) = o;
        if (dst8) { u32x2 o8; o8.x = cvt4_fp8(s[0 * 33] * sc8, s[1 * 33] * sc8, s[2 * 33] * sc8, s[3 * 33] * sc8); o8.y = cvt4_fp8(s[4 * 33] * sc8, s[5 * 33] * sc8, s[6 * 33] * sc8, s[7 * 33] * sc8);
            *(u32x2*)(dst8 + (size_t)n * ldt8 + 8 * c) = o8; } }
    LDS_WAIT(); asm volatile("" ::: "memory");
}
__device__ __forceinline__ void rms_row_to_bf16(const float* xrow, const float* g, bf16_t* orow, int lane) {
    const f32x4* xr = (const f32x4*)xrow + lane; const f32x4* gr = (const f32x4*)g + lane;
    f32x4 v[4]; float s = 0.f;
#pragma unroll
    for (int j = 0; j < 4; ++j) { v[j] = xr[64 * j]; s += (v[j].x * v[j].x + v[j].y * v[j].y) + (v[j].z * v[j].z + v[j].w * v[j].w); }
    const float rstd = 1.0f / sqrtf(wave_sum(s) * (1.f / DM) + EPS);
    u32x2* o8 = (u32x2*)orow + lane;
#pragma unroll
    for (int j = 0; j < 4; ++j) { const f32x4 gg = gr[64 * j]; u32x2 w; w.x = cvt_pk_bf16(v[j].x * rstd * gg.x, v[j].y * rstd * gg.y); w.y = cvt_pk_bf16(v[j].z * rstd * gg.z, v[j].w * rstd * gg.w); o8[64 * j] = w; }
}

__device__ __forceinline__ void rms_row2_to_bf16(const float* xrow, const float* g, bf16_t* orow, int lane, unsigned char* orow8, float* rs_out) {
    const f32x4* xr = (const f32x4*)xrow + lane; const f32x4* gr = (const f32x4*)g + lane;
    f32x4 v[2][4]; float s[2] = {0.f, 0.f};
#pragma unroll
    for (int r = 0; r < 2; ++r)
#pragma unroll
        for (int j = 0; j < 4; ++j) v[r][j] = xr[r * 256 + 64 * j];
#pragma unroll
    for (int r = 0; r < 2; ++r)
#pragma unroll
        for (int j = 0; j < 4; ++j) s[r] += (v[r][j].x * v[r][j].x + v[r][j].y * v[r][j].y) + (v[r][j].z * v[r][j].z + v[r][j].w * v[r][j].w);
#pragma unroll
    for (int r = 0; r < 2; ++r) { const float rstd = 1.0f / sqrtf(wave_sum(s[r]) * (1.f / DM) + EPS); u32x2* o8 = (u32x2*)(orow + (size_t)r * DM) + lane;
        if (lane == 0) rs_out[r] = rstd;
#pragma unroll
        for (int j = 0; j < 4; ++j) { const f32x4 gg = gr[64 * j]; u32x2 w; w.x = cvt_pk_bf16(v[r][j].x, v[r][j].y); w.y = cvt_pk_bf16(v[r][j].z, v[r][j].w); o8[64 * j] = w;
            ((unsigned*)(orow8 + (size_t)r * DM))[lane + 64 * j] = cvt4_fp8(v[r][j].x * rstd * gg.x, v[r][j].y * rstd * gg.y, v[r][j].z * rstd * gg.z, v[r][j].w * rstd * gg.w); } }
}
struct Args { const void* in[28]; float* out; unsigned char* ws; int ph_lo, ph_hi; };
constexpr int NPHASE = 12;

#define CAS __attribute__((address_space(4)))
#define PHASE_PTRS const CAS char* ka_ = (const CAS char*)__builtin_amdgcn_kernarg_segment_ptr(); asm volatile("" : "+s"(ka_)); unsigned char* ws = *(unsigned char* const CAS*)(ka_ + 232); float* outp = *(float* const CAS*)(ka_ + 224); const float* x = *(const float* const CAS*)(ka_ + 0); const float* mem = *(const float* const CAS*)(ka_ + 8); const int* positions = *(const int* const CAS*)(ka_ + 16); const float* mix_norm_g = *(const float* const CAS*)(ka_ + 24); const float* w_in = *(const float* const CAS*)(ka_ + 32); const float* q_norm_g = *(const float* const CAS*)(ka_ + 40); const float* w_q_up = *(const float* const CAS*)(ka_ + 48); const float* kv_norm_g = *(const float* const CAS*)(ka_ + 56); const float* w_kv_up = *(const float* const CAS*)(ka_ + 64); const float* w_attn_branch = *(const float* const CAS*)(ka_ + 72); const float* pool_w = *(const float* const CAS*)(ka_ + 80); const float* pool_scale = *(const float* const CAS*)(ka_ + 88); const float* w_pool_branch = *(const float* const CAS*)(ka_ + 96); const float* w_mix_out = *(const float* const CAS*)(ka_ + 104); const float* xattn_norm_g = *(const float* const CAS*)(ka_ + 112); const float* mem_norm_g = *(const float* const CAS*)(ka_ + 120); const float* w_xq = *(const float* const CAS*)(ka_ + 128); const float* w_xkv = *(const float* const CAS*)(ka_ + 136); const float* w_xo = *(const float* const CAS*)(ka_ + 144); const float* ffn_norm_g = *(const float* const CAS*)(ka_ + 152); const float* w_rg = *(const float* const CAS*)(ka_ + 160); const float* b_rg = *(const float* const CAS*)(ka_ + 168); const float* w_re = *(const float* const CAS*)(ka_ + 176); const float* b_re = *(const float* const CAS*)(ka_ + 184); const float* w_eg = *(const float* const CAS*)(ka_ + 192); const float* w_eu = *(const float* const CAS*)(ka_ + 200); const float* w_ed = *(const float* const CAS*)(ka_ + 208); const float* final_g = *(const float* const CAS*)(ka_ + 216); u64* ssq_q = (u64*)(ws + OFF_SSQQ); u64* ssq_kv = (u64*)(ws + OFF_SSQKV); u64* ssq1 = (u64*)(ws + OFF_SSQ1); u64* ssq2 = (u64*)(ws + OFF_SSQ2); unsigned* cnt = (unsigned*)(ws + OFF_CNT); float* cosT = (float*)(ws + WS_COS); float* sinT = (float*)(ws + WS_SIN); unsigned char* WIN8 = ws + WS_WIN8; unsigned char* HN8 = ws + WS_S6;     bf16_t* WIN = (bf16_t*)(ws + WS_WIN); unsigned char* WQ8 = ws + WS_WQ; unsigned char* WKVU8 = ws + WS_WKVU; unsigned char* WA8 = ws + WS_WA; bf16_t* WPB = (bf16_t*)(ws + WS_WPB); unsigned char* WMO8 = ws + WS_WMO; unsigned char* M8 = ws + WS_S1; bf16_t* WXKV = (bf16_t*)(ws + WS_WXKV); bf16_t* WXO = (bf16_t*)(ws + WS_WXO); bf16_t* WR = (bf16_t*)(ws + WS_WR); unsigned char* WGU8 = ws + WS_WGU; unsigned char* H28 = ws + WS_S5; unsigned char* WD8 = ws + WS_WD; bf16_t* MEMN = (bf16_t*)(ws + WS_MEMN); bf16_t* KVM = (bf16_t*)(ws + WS_KVM); bf16_t* WXQN = (bf16_t*)(ws + WS_WXQN); unsigned char* BQK = ws + WS_BQK; unsigned char* BVO = ws + WS_BVO; unsigned char* H18 = ws + WS_S5; unsigned char* P8 = ws + WS_S1; float* LG = (float*)(ws + WS_LG); bf16_t* HN = (bf16_t*)(ws + WS_S0); bf16_t* Qb = (bf16_t*)(ws + WS_S0); bf16_t* H1 = (bf16_t*)(ws + WS_S0); bf16_t* GA = (bf16_t*)(ws + WS_S1); bf16_t* XQ = (bf16_t*)(ws + WS_S1); bf16_t* Y = (bf16_t*)(ws + WS_S1); bf16_t* GBM = (bf16_t*)(ws + WS_S2); bf16_t* QLb = (bf16_t*)(ws + WS_QLB); bf16_t* KVLb = (bf16_t*)(ws + WS_KVLB); bf16_t* KRb = (bf16_t*)(ws + WS_KRB); bf16_t* H2 = (bf16_t*)(ws + WS_S3); bf16_t* U = (bf16_t*)(ws + WS_U); bf16_t* DP = (bf16_t*)(ws + WS_DP); unsigned char* HID = ws + WS_HID; int* LIST = (int*)(ws + WS_LIST); float* WL = (float*)(ws + WS_WL); float* RSL = (float*)(ws + WS_RSL); unsigned char* K8 = ws + WS_S5; unsigned char* VT8 = ws + WS_S5 + 64 * MiB; unsigned char* Q8 = ws + WS_S1 + 64 * MiB;     float* RS0 = (float*)(ws + 3584 * 1024);     bf16_t* ATT = (bf16_t*)(ws + WS_ATT); (void)outp; int tidp_ = wave * 64 + lane_mb(); asm volatile("" : "+v"(tidp_)); const int tid = tidp_, lane = tid & 63, gt = bx * 512 + tid; (void)lane; (void)gt;
__global__ void __launch_bounds__(512, 2) fwd_kernel(Args args) {
    extern __shared__ __attribute__((aligned(16))) unsigned char lds_raw[];
    LAS unsigned char* lds = (LAS unsigned char*)lds_raw;
    LAS unsigned char* misc = lds + MISC_OFF;
    const int tid = threadIdx.x, lane = tid & 63, wave = __builtin_amdgcn_readfirstlane(tid >> 6);
    const int G = gridDim.x, bx = blockIdx.x;
    const int vcu = (G % 8 == 0) ? (bx % 8) * (G / 8) + bx / 8 : bx;
    for (int u = tid; u < (LDS_BYTES - MISC_OFF) / 4; u += 512) ((LAS unsigned*)misc)[u] = 0u;
    __syncthreads();
    unsigned* barw = (unsigned*)(args.ws + WS_CTL);
    XcdBarrier bar; bar.bar = barw; bar.x = 0; bar.st = nullptr; bar.w = wave;
    if (MK_N_LAUNCHES == 1) { bar = xcd_barrier_post(barw, (volatile LAS unsigned*)(misc + MO_BAR)); bar.w = wave; }
#define GRID_BAR() do { if (MK_N_LAUNCHES == 1) xcd_barrier(bar); } while (0)
    const int lo = args.ph_lo, hi = args.ph_hi;
#ifndef PH_MASK
#define PH_MASK 0xfff
#endif
#define IN(k) ((((PH_MASK) >> (k)) & 1) && lo <= (k) && (k) < hi)
#define BOTH(k) (IN(k) && IN((k) + 1))
    const int gw = vcu * 8 + wave, NGW = G * 8;
    const int gt = bx * 512 + tid, NGT = G * 512;

    if (IN(0)) {
        PHASE_PTRS
        for (int i = gt; i < (int)(SMALL_ZERO_BYTES / 4); i += NGT) ((unsigned*)(ws + WS_SMALL))[i] = 0u;
        for (int i = gt; i < NTOK * 16; i += NGT) { const int row = i >> 4, k = i & 15;
            const float inv = (float)exp2(-(double)k * (13.287712379549449 / 16.0)); const float ang = (float)positions[row] * inv;
            const double rev = (double)ang * 0.15915494309189535; const float fr_ = (float)(rev - rint(rev));
            cosT[i] = __builtin_amdgcn_cosf(fr_); sinT[i] = __builtin_amdgcn_sinf(fr_); }
        for (int i = gt; i < POOLW * DM; i += NGT) { const int n = i & (DM - 1), k = i >> 10, g = k >> 7; const float* pw = pool_w + (size_t)k * 128; const float* sc = pool_scale + g * 128; const float* wb = w_pool_branch + (size_t)g * 128 * DM + n;
            float s = 0.f;
            for (int e = 0; e < 128; ++e) s += pw[e] * sc[e] * wb[(size_t)e * DM];
            WPB[(size_t)n * POOLW + k] = (bf16_t)(cvt_pk_bf16(s, 0.f) & 0xffffu); }
        for (int i = gt; i < DM * DM / 8; i += NGT) { const int k = i >> 7; const float g_ = xattn_norm_g[k]; const f32x4 a0 = *(const f32x4*)(w_xq + (size_t)i * 8), a1 = *(const f32x4*)(w_xq + (size_t)i * 8 + 4); store8(WXQN + (size_t)i * 8, a0 * g_, a1 * g_); }
        for (int i = gt; i < 256 * DM; i += NGT) { const int n = i >> 10, k = i & (DM - 1); float v = 0.f;
            if (n < 32) v = w_re[k * 32 + n] * ffn_norm_g[k]; else if (n < 36) v = w_rg[k * 4 + (n - 32)] * ffn_norm_g[k];
            WR[i] = (bf16_t)(cvt_pk_bf16(v, 0.f) & 0xffffu); }
        {
            LAS float* scr = (LAS float*)(lds + wave * 16384);
            constexpr int I_IN = 16 * 104, I_Q = 8 * 24, I_KV = 4 * 32, I_A = 8 * 32, I_SQ = 16 * 32, I_XKV = 16 * 64, I_GU = 32 * 16 * 16, I_D = 32 * 4 * 32;
            constexpr int NITEMS = I_IN + I_Q + I_KV + I_A + 2 * I_SQ + I_XKV + I_GU + I_D;
            for (int it = gw; it < NITEMS; it += NGW) {
                int r = it;
                if (r < I_IN) { const int kb = r / 104, nb = r % 104, n0 = nb * 32; const int sn = n0 < 672 ? n0 : (n0 < 768 ? -1 : n0 - 96);
                    transpose_block(sn >= 0 ? w_in + (size_t)kb * 64 * IN_COLS + sn : nullptr, IN_COLS, (n0 >= 768 && n0 < 1280) ? mix_norm_g + kb * 64 : nullptr  , WIN + (size_t)n0 * DM + kb * 64, DM, scr, lane, (n0 >= 1280 || n0 < 768) ? WIN8 + (size_t)n0 * DM + kb * 64 : nullptr, DM, 32.f); continue; } r -= I_IN;
                if (r < I_Q) { const int kb = r / 24, nb = r % 24; transpose_block(kb < 6 ? w_q_up + (size_t)kb * 64 * 768 + nb * 32 : nullptr, 768, kb < 6 ? q_norm_g + kb * 64 : nullptr, nullptr, 512, scr, lane, WQ8 + (size_t)nb * 32 * 512 + kb * 64, 512, 32.f); continue; } r -= I_Q;
                if (r < I_KV) { const int kb = r / 32, nb = r % 32, n0 = nb * 32; const int nn = n0 & 511, sn = (nn >> 6) * 128 + (n0 >= 512 ? 64 : 0) + (nn & 63);
                    transpose_block(w_kv_up + (size_t)kb * 64 * 1024 + sn, 1024, kv_norm_g + kb * 64, nullptr, KVLORA, scr, lane, WKVU8 + (size_t)n0 * KVLORA + kb * 64, KVLORA, 32.f); continue; } r -= I_KV;
                if (r < I_A) { const int kb = r / 32, nb = r % 32; transpose_block(w_attn_branch + (size_t)kb * 64 * DM + nb * 32, DM, nullptr, nullptr, 512, scr, lane, WA8 + (size_t)nb * 32 * 512 + kb * 64, 512, 32.f); continue; } r -= I_A;
                if (r < I_SQ) { const int kb = r / 32, nb = r % 32; transpose_block(w_mix_out + (size_t)kb * 64 * DM + nb * 32, DM, nullptr, nullptr, DM, scr, lane, WMO8 + (size_t)nb * 32 * DM + kb * 64, DM, 32.f); continue; } r -= I_SQ;
                if (r < I_SQ) { const int kb = r / 32, nb = r % 32; transpose_block(w_xo + (size_t)kb * 64 * DM + nb * 32, DM, nullptr, WXO + (size_t)nb * 32 * DM + kb * 64, DM, scr, lane); continue; } r -= I_SQ;
                if (r < I_XKV) { const int kb = r / 64, nb = r % 64; transpose_block(w_xkv + (size_t)kb * 64 * 2048 + nb * 32, 2048, nullptr, WXKV + (size_t)nb * 32 * DM + kb * 64, DM, scr, lane); continue; } r -= I_XKV;
                if (r < I_GU) { const int e = r / 256, q = r % 256, kb = q / 16, nb = q % 16, n0 = nb * 32;
                    const int pn = n0 >> 8, j = n0 & 255; const float* srcm = (j < 128 ? w_eg : w_eu) + (size_t)e * DM * EFF; const int sc = pn * 128 + (j & 127);
                    transpose_block(srcm + (size_t)kb * 64 * EFF + sc, EFF, ffn_norm_g + kb * 64, nullptr, DM, scr, lane, WGU8 + ((size_t)e * 512 + n0) * DM + kb * 64, DM, 32.f); continue; } r -= I_GU;
                { const int e = r / 128, q = r % 128, kb = q / 32, nb = q % 32;
                    transpose_block(w_ed + (size_t)e * EFF * DM + (size_t)kb * 64 * DM + nb * 32, DM, nullptr, nullptr, EFF, scr, lane, WD8 + ((size_t)e * DM + nb * 32) * EFF + kb * 64, EFF, 32.f); }
            }
        }
        for (int m = gw * 2; m < NTOK; m += NGW * 2) rms_row2_to_bf16(x + (size_t)m * DM, mix_norm_g, HN + (size_t)m * DM, lane, HN8 + (size_t)m * DM, RS0 + m);
        for (int m = gw; m < NMEM; m += NGW) rms_row_to_bf16(mem + (size_t)m * DM, mem_norm_g, MEMN + (size_t)m * DM, lane);
        if (BOTH(0)) GRID_BAR();
    }

    if (IN(1)) {
        PHASE_PTRS
        { OpIn op{HN, WIN, DM, DM, DM, QLb, KVLb, KRb, U, GA, GBM, ssq_q, ssq_kv, cosT, sinT, RS0}; OffsetOrder S; S.s.init(NTOK, 512, G, bx); S.off = 3; pg8::gemm_phase(lds, op, S, wave); }
        { OpPlain op{MEMN, WXKV, DM, DM, DM, KVM, 2 * DM}; pg8::StaticOrder S; S.init(NMEM, 2 * DM, G, bx); pg8::gemm_phase(lds, op, S, wave); }
    }
    if (IN(1)) {
        PHASE_PTRS
        { OpIn8 op{(const bf16_t*)HN8, (const bf16_t*)WIN8, DM / 2, DM / 2, DM / 2, QLb, KVLb, KRb, U, GA, GBM, ssq_q, ssq_kv, cosT, sinT}; pg8::StaticOrder S; S.init(NTOK, 768, G, bx); pg8::gemm_phase(lds, op, S, wave); }
        { OpGate8 op{(const bf16_t*)HN8, (const bf16_t*)WIN8, DM / 2, DM / 2, DM / 2, GA, GBM};
          OffsetOrder S; S.s.init(NTOK, 2048, G, bx); S.off = 5; pg8::gemm_phase(lds, op, S, wave); }
        if (BOTH(1)) GRID_BAR();
    }

    if (IN(2)) {
        PHASE_PTRS
        { OpPre op{KVM, WXQN, 256, 2 * DM, DM, BQK, 0}; pg8::StaticOrder S; S.init(16 * DM, DM, G, bx); pg8::gemm_phase(lds, op, S, wave); }
        { OpPre op{KVM, WXO, 256, DM, 2 * DM, BVO, 1}; pg8::StaticOrder S; S.init(16 * DM, DM, G, bx); pg8::gemm_phase(lds, op, S, wave); }
        { OpQ op{QLb, (const bf16_t*)WQ8, 256, 256, 256, Q8, ssq_q, cosT, sinT}; pg8::StaticOrder S; S.init(NTOK, NHEAD * QKD, G, bx); pg8::gemm_phase(lds, op, S, wave); }
        { OpK8 op{KVLb, (const bf16_t*)WKVU8, KVLORA / 2, KVLORA / 2, KVLORA / 2, K8, ssq_kv}; pg8::StaticOrder S; S.init(NTOK, 512, G, bx); pg8::gemm_phase(lds, op, S, wave); }
        { OpVT op{(const bf16_t*)(WKVU8 + 512 * KVLORA), KVLb, KVLORA / 2, KVLORA / 2, KVLORA / 2, VT8, ssq_kv}; pg8::StaticOrder S; S.init(512, NTOK, G, bx); pg8::gemm_phase(lds, op, S, wave); }
        { RELANE
        static_assert((4 * (NTOK / 4)) % 2 == 0, "item pairs");
        for (int it = gw; it < 4 * (NTOK / 4); it += 2 * NGW) { const int g = it & 3, ch = g * 16 + (lane & 15); const bool two_ = it + NGW < 4 * (NTOK / 4);
            const int rowA = (it >> 2) * 4 + (lane >> 4), rowB = two_ ? ((it + NGW) >> 2) * 4 + (lane >> 4) : rowA, tA = rowA & (SEQ - 1), tB = rowB & (SEQ - 1);
            const bf16_t* pA = U + (size_t)rowA * POOLW + ch * 8; const bf16_t* pB = U + (size_t)rowB * POOLW + ch * 8;
            f32x4 a0, a1, ua0, ua1, b0, b1, ub0, ub1; load8(pA, ua0, ua1); load8(pB, ub0, ub1); a0 = ua0; a1 = ua1; b0 = ub0; b1 = ub1;
#define DP_WIN(W) { u32x4 wa_[W - 1], wb_[W - 1]; \
                    _Pragma("unroll") for (int j = 1; j < W; ++j) { wa_[j - 1] = *(const u32x4*)(pA - (size_t)(j <= tA ? j : 0) * POOLW); wb_[j - 1] = *(const u32x4*)(pB - (size_t)(j <= tB ? j : 0) * POOLW); } \
                    _Pragma("unroll") for (int j = 1; j < W; ++j) { const u32x4 w = wa_[j - 1]; const float k_ = (j <= tA) ? 1.f : 0.f; a0 += (f32x4){bf_lo(w.x), bf_hi(w.x), bf_lo(w.y), bf_hi(w.y)} * k_; a1 += (f32x4){bf_lo(w.z), bf_hi(w.z), bf_lo(w.w), bf_hi(w.w)} * k_; } \
                    _Pragma("unroll") for (int j = 1; j < W; ++j) { const u32x4 w = wb_[j - 1]; const float k_ = (j <= tB) ? 1.f : 0.f; b0 += (f32x4){bf_lo(w.x), bf_hi(w.x), bf_lo(w.y), bf_hi(w.y)} * k_; b1 += (f32x4){bf_lo(w.z), bf_hi(w.z), bf_lo(w.w), bf_hi(w.w)} * k_; } }
            if (g == 0) DP_WIN(2) else if (g == 1) DP_WIN(4) else if (g == 2) DP_WIN(8) else DP_WIN(16)
#undef DP_WIN
            const int w = 2 << g, nA = (tA + 1 < w) ? tA + 1 : w, nB = (tB + 1 < w) ? tB + 1 : w; const float invA = 1.0f / (float)nA, invB = 1.0f / (float)nB;
            store8(DP + (size_t)rowA * POOLW + ch * 8, a0 * invA - ua0, a1 * invA - ua1);
            if (two_) store8(DP + (size_t)rowB * POOLW + ch * 8, b0 * invB - ub0, b1 * invB - ub1); }
        }
        if (BOTH(2)) GRID_BAR();
    }

    if (IN(3)) {
        PHASE_PTRS
        { OpYB op{DP, WPB, POOLW, POOLW, POOLW, GBM}; pg8::StaticOrder S; S.init(NTOK, DM, G, bx); pg8::gemm_phase(lds, op, S, wave); }
        { const int bh = vcu >> 1, half = vcu & 1;
          if (bh < NBATCH * NHEAD) for (int i = 0; i < 8; ++i) { const int pr = i >> 1, od = i & 1; const int qb = 4 * pr + (od ? (half ? 2 : 3) : (half ? 1 : 0));
              if (wave < 4) mla::attn_unit<true>(bh >> 3, bh & 7, qb, Q8, K8, (const unsigned char*)KRb, VT8, ATT, lds, wave); else mla::attn_unit<false>(bh >> 3, bh & 7, qb, Q8, K8, (const unsigned char*)KRb, VT8, ATT, lds, wave); } }
        if (BOTH(3)) GRID_BAR();
    }

    if (IN(4)) {
        PHASE_PTRS
        { OpYA op{ATT, (const bf16_t*)WA8, 256, 256, 256, GA, GBM, M8}; pg8::StaticOrder S; S.init(NTOK, DM, G, bx); pg8::gemm_phase(lds, op, S, wave); }
        if (BOTH(4)) GRID_BAR();
    }

    if (IN(5)) {
        PHASE_PTRS
        { OpRes<false, true> op{(const bf16_t*)M8, (const bf16_t*)WMO8, DM / 2, DM / 2, DM / 2, HN  , H1, ssq1, 0, H18, 0.25f}; pg8::StaticOrder S; S.init(NTOK, DM, G, bx); pg8::gemm_phase(lds, op, S, wave); }
        if (BOTH(5)) GRID_BAR();
    }

    if (IN(6)) {
        PHASE_PTRS
        { OpSX op{(const bf16_t*)H18, (const bf16_t*)BQK, DM / 2, DM / 2, DM / 2, P8, ssq1, (LAS f32x4*)(misc + MO_PS)}; pg8::StaticOrder S; S.init(NTOK, DM, G, bx); pg8::gemm_phase(lds, op, S, wave); }
        if (BOTH(6)) GRID_BAR();
    }

    if (IN(7)) {
        PHASE_PTRS
        { OpRes<false, true> op{(const bf16_t*)P8, (const bf16_t*)BVO, DM / 2, DM / 2, DM / 2, H1, H2, ssq2, (size_t)DM * DM / 2, H28, 1.0f / 256.f}; pg8::StaticOrder S; S.init(NTOK, DM, G, bx); pg8::gemm_phase(lds, op, S, wave); }
        if (BOTH(7)) GRID_BAR();
    }

    if (IN(8)) {
        PHASE_PTRS
        pg8::StaticOrder S; S.init(NTOK, 256, G, bx);
        { OpR op{H2, WR, DM, DM, DM, LG, ssq2}; pg8::gemm_phase(lds, op, S, wave); }
        { RELANE
        VM_WAIT(); __syncthreads(); __builtin_amdgcn_fence(__ATOMIC_ACQUIRE, "agent"); VM_WAIT(); __syncthreads();
        LAS unsigned* hist = (LAS unsigned*)(misc + MO_HIST); LAS unsigned* basee = (LAS unsigned*)(misc + MO_BASE);
        pg8::StaticOrder S2; S2.init(NTOK, 256, G, bx);
        for (int i = 0; i < (256 + G - 1) / G; ++i) { Unit u; if (!S2.next(i, u)) break;
            if (tid < 32) hist[tid] = 0u;
            __syncthreads();
            int e1 = 0, e2 = 0; float w1 = 0.f, w2 = 0.f; unsigned r1 = 0, r2 = 0; const int row = u.pm * 256 + tid;
            if (tid < 256) {
                const float* lg = LG + (size_t)row * 40;
                float gl[4]; int gi = 0;
#pragma unroll
                for (int j = 0; j < 4; ++j) gl[j] = lg[32 + j] + b_rg[j];
                float gm = gl[0];
#pragma unroll
                for (int j = 1; j < 4; ++j) if (gl[j] > gm) { gm = gl[j]; gi = j; }
                float gs = 0.f;
#pragma unroll
                for (int j = 0; j < 4; ++j) gs += __expf(gl[j] - gm);
                const float gwt = 1.0f / gs;
                float el[8];
#pragma unroll
                for (int j = 0; j < 8; ++j) el[j] = lg[gi * 8 + j] + b_re[gi * 8 + j];
                int i1 = 0; float m1 = el[0];
#pragma unroll
                for (int j = 1; j < 8; ++j) if (el[j] > m1) { m1 = el[j]; i1 = j; }
                int i2 = -1; float m2 = -3.0e38f;
#pragma unroll
                for (int j = 0; j < 8; ++j) if (j != i1 && el[j] > m2) { m2 = el[j]; i2 = j; }
                const float p2 = __expf(m2 - m1);
                w1 = gwt / (1.0f + p2); w2 = gwt * p2 / (1.0f + p2);
                e1 = gi * 8 + i1; e2 = gi * 8 + i2;
                r1 = __hip_atomic_fetch_add(&hist[e1], 1u, __ATOMIC_RELAXED, __HIP_MEMORY_SCOPE_WORKGROUP); r2 = __hip_atomic_fetch_add(&hist[e2], 1u, __ATOMIC_RELAXED, __HIP_MEMORY_SCOPE_WORKGROUP);
            }
            __syncthreads();
            if (tid < 32) basee[tid] = hist[tid] ? __hip_atomic_fetch_add(cnt + tid, hist[tid], RLX_AGENT) : 0u;
            __syncthreads();
            if (tid < 256) { const size_t p1 = (size_t)e1 * NTOK + basee[e1] + r1, p2 = (size_t)e2 * NTOK + basee[e2] + r2;
                const float rs_ = __builtin_amdgcn_rsqf(fx_load(ssq2 + row) * (1.0f / DM) + EPS);
                LIST[p1] = row * 2; WL[p1] = w1; RSL[p1] = rs_; LIST[p2] = row * 2 + 1; WL[p2] = w2; RSL[p2] = rs_; }
            __syncthreads();
        }
        }
        if (BOTH(8)) GRID_BAR();
    }

    if (IN(9)) {
        PHASE_PTRS
        LAS int* cntL = (LAS int*)(misc + MO_CNTL); LAS int* tbase = (LAS int*)(misc + MO_TBASE); LAS int* tileE = (LAS int*)(misc + MO_TILEE);
        const int ntile = moe_build_tables(cnt, cntL, tbase, tileE, tid);
        { OpGU op{(const bf16_t*)H28, (const bf16_t*)WGU8, DM / 2, DM / 2, DM / 2, HID, LIST, WL, RSL, MoeTab{tileE, tbase, cntL}}; MoeOrder<2> S{ntile * 2, G, vcu}; pg8::gemm_phase(lds, op, S, wave); }
        if (BOTH(9)) GRID_BAR();
    }

    if (IN(10)) {
        PHASE_PTRS
        LAS int* cntL = (LAS int*)(misc + MO_CNTL); LAS int* tbase = (LAS int*)(misc + MO_TBASE); LAS int* tileE = (LAS int*)(misc + MO_TILEE);
        const int ntile = moe_build_tables(cnt, cntL, tbase, tileE, tid);
        { OpDN op{(const bf16_t*)HID, (const bf16_t*)WD8, EFF / 2, EFF / 2, EFF / 2, (unsigned char*)Y, LIST, MoeTab{tileE, tbase, cntL}}; MoeOrder<4> S{ntile * 4, G, vcu}; pg8::gemm_phase(lds, op, S, wave); }
        if (BOTH(10)) GRID_BAR();
    }

    if (IN(11)) {
        PHASE_PTRS
        const f32x4 g00 = *(const f32x4*)(final_g + lane * 8), g01 = *(const f32x4*)(final_g + lane * 8 + 4), g10 = *(const f32x4*)(final_g + 512 + lane * 8), g11 = *(const f32x4*)(final_g + 512 + lane * 8 + 4);
        for (int m = gw * 2; m < NTOK; m += NGW * 2) {
            u32x4 w[2][2]; u32x2 y8[2][2][2]; const unsigned char* Y8 = (const unsigned char*)Y;
#pragma unroll
            for (int r = 0; r < 2; ++r)
#pragma unroll
                for (int hf = 0; hf < 2; ++hf) { const size_t o = (size_t)(m + r) * DM + hf * 512 + lane * 8; w[r][hf] = *(const u32x4*)(H2 + o); y8[r][hf][0] = *(const u32x2*)(Y8 + o); y8[r][hf][1] = *(const u32x2*)(Y8 + (size_t)NTOK * DM + o); }
#pragma unroll
            for (int r = 0; r < 2; ++r) { f32x4 v[2][2]; float s = 0.f;
#pragma unroll
                for (int hf = 0; hf < 2; ++hf) { f32x4 a0, a1, b0, b1, c0, c1; unpack8(w[r][hf], a0, a1); unpack8_fp8(y8[r][hf][0], b0, b1); unpack8_fp8(y8[r][hf][1], c0, c1);
                    a0 += (b0 + c0) * 0.0625f; a1 += (b1 + c1) * 0.0625f; v[hf][0] = a0; v[hf][1] = a1; s += ssq8(a0, a1); }
                const float rstd = 1.0f / sqrtf(wave_sum(s) * (1.f / DM) + EPS); float* op_ = outp + (size_t)(m + r) * DM + lane * 8;
                *(f32x4*)(op_) = v[0][0] * rstd * g00; *(f32x4*)(op_ + 4) = v[0][1] * rstd * g01; *(f32x4*)(op_ + 512) = v[1][0] * rstd * g10; *(f32x4*)(op_ + 516) = v[1][1] * rstd * g11; }
        }
    }
#undef IN
#undef BOTH
#undef GRID_BAR
}

extern "C" void kernel_launch(void* const* d_in, const int* in_sizes, int n_in, void* d_out, int out_size, void* d_ws, size_t ws_size, hipStream_t stream) {
    static int grid = 0;
    if (grid == 0) {
        if (n_in != 28 || in_sizes[0] != NTOK * DM || out_size != NTOK * DM || ws_size < WS_END) { fprintf(stderr, "kernel_launch: unexpected shapes (n_in %d, in0 %d, out %d, ws %zu); nothing launched\n", n_in, n_in > 0 ? in_sizes[0] : -1, out_size, ws_size); grid = -1; return; }
        int dev = 0, cus = 0, per_cu = 0;
        if (hipGetDevice(&dev) != hipSuccess || hipDeviceGetAttribute(&cus, hipDeviceAttributeMultiprocessorCount, dev) != hipSuccess) { fprintf(stderr, "kernel_launch: device query failed\n"); grid = -1; return; }
        if (hipFuncSetAttribute((const void*)fwd_kernel, hipFuncAttributeMaxDynamicSharedMemorySize, LDS_BYTES) != hipSuccess) { fprintf(stderr, "kernel_launch: hipFuncSetAttribute failed\n"); grid = -1; return; }
        if (hipOccupancyMaxActiveBlocksPerMultiprocessor(&per_cu, (const void*)fwd_kernel, 512, LDS_BYTES) != hipSuccess || per_cu < 1) { fprintf(stderr, "kernel_launch: occupancy query reports %d blocks per CU\n", per_cu); }
        (void)hipGetLastError();
        grid = cus;
        if (grid > 256) grid = 256;
    }
    if (grid < 0) return;
    (void)hipMemsetAsync((char*)d_ws + WS_CTL, 0, CTL_ZERO_BYTES, stream);
    Args a{};
    for (int i = 0; i < 28; ++i) a.in[i] = d_in[i];
    a.out = (float*)d_out; a.ws = (unsigned char*)d_ws;
    if (MK_N_LAUNCHES == 1) { a.ph_lo = 0; a.ph_hi = NPHASE; hipLaunchKernelGGL(fwd_kernel, dim3(grid), dim3(512), LDS_BYTES, stream, a); }
    else for (int p = 0; p < NPHASE; ++p) { a.ph_lo = p; a.ph_hi = p + 1; hipLaunchKernelGGL(fwd_kernel, dim3(grid), dim3(512), LDS_BYTES, stream, a); }
    const hipError_t le = hipPeekAtLastError();
    if (le != hipSuccess) fprintf(stderr, "kernel_launch: launch failed: %s\n", hipGetErrorName(le));
}
```

```cpp
#include <hip/hip_runtime.h>
#include <cstdio>
#include <cstdint>
#include <type_traits>
#include <utility>

#ifndef PG8_SP2
#define PG8_SP2 1
#endif
#ifndef PG8_ALIGN_EPI
#define PG8_ALIGN_EPI 1
#endif
#ifndef MK_N_LAUNCHES
#define MK_N_LAUNCHES 1
#endif

#define GAS __attribute__((address_space(1)))
#define LAS __attribute__((address_space(3)))
typedef unsigned short bf16_t;
typedef short bf16x8 __attribute__((ext_vector_type(8)));
typedef short s16x4 __attribute__((ext_vector_type(4)));
typedef float f32x2 __attribute__((ext_vector_type(2)));
typedef float f32x4 __attribute__((ext_vector_type(4)));
typedef float f32x16 __attribute__((ext_vector_type(16)));
typedef unsigned u32x4 __attribute__((ext_vector_type(4)));
typedef unsigned u32x2 __attribute__((ext_vector_type(2)));
typedef int v4i_t __attribute__((ext_vector_type(4)));
typedef int v8i_t __attribute__((ext_vector_type(8)));
typedef GAS unsigned gu32;
#define RLX_AGENT __ATOMIC_RELAXED, __HIP_MEMORY_SCOPE_AGENT
#define LDS_WAIT() asm volatile("s_waitcnt lgkmcnt(0)" ::: "memory")
#define VM_WAIT() asm volatile("s_waitcnt vmcnt(0)" ::: "memory")

constexpr int DM = 1024, NBATCH = 16, SEQ = 4096, NTOK = NBATCH * SEQ;
constexpr int QLORA = 384, KVLORA = 256, ROPE = 32, POOLW = 512, NHEAD = 8, QKD = 96, VD = 64;
constexpr int MEMLEN = 256, NMEM = NBATCH * MEMLEN;
constexpr int NEXP = 32, EFF = 256;
constexpr int IN_COLS = 3232, IN_PAD = 3328;
constexpr float EPS = 1e-6f;
constexpr float C2Q = 0.10206207261596577f * 1.4426950408889634f;
constexpr float C2X = 0.0625f * 1.4426950408889634f;

constexpr size_t MiB = 1u << 20;
constexpr size_t WS_CTL = 0, CTL_ZERO_BYTES = 64 * 1024;
constexpr size_t WS_SMALL = 1 * MiB;
constexpr size_t OFF_SSQQ = WS_SMALL, OFF_SSQKV = OFF_SSQQ + 524288, OFF_SSQ1 = OFF_SSQKV + 524288, OFF_SSQ2 = OFF_SSQ1 + 524288, OFF_CNT = OFF_SSQ2 + 524288;
constexpr size_t SMALL_ZERO_BYTES = 4 * 524288 + 4096;
constexpr size_t WS_COS = 4 * MiB, WS_SIN = 8 * MiB;
constexpr size_t WS_WIN = 12 * MiB;
constexpr size_t WS_WQ = 19 * MiB;
constexpr size_t WS_WKVU = 20 * MiB;
constexpr size_t WS_WA = 21 * MiB, WS_WPB = 22 * MiB;
constexpr size_t WS_WMO = 23 * MiB, WS_WXKV = 27 * MiB, WS_WXO = 31 * MiB;
constexpr size_t WS_WR = 33 * MiB;
constexpr size_t WS_WGU = 34 * MiB;
constexpr size_t WS_WD = 66 * MiB;
constexpr size_t WS_MEMN = 82 * MiB, WS_KVM = 90 * MiB;
constexpr size_t WS_WIN8 = 122 * MiB;
constexpr size_t WS_WXQN = 120 * MiB;
constexpr size_t WS_BQK = 960 * MiB, WS_BVO = 992 * MiB;
constexpr size_t WS_LG = 106 * MiB;
constexpr size_t WS_S0 = 128 * MiB;
constexpr size_t WS_S1 = 256 * MiB;
constexpr size_t WS_S2 = 384 * MiB;
constexpr size_t WS_S3 = 512 * MiB;
constexpr size_t WS_S4 = 640 * MiB;
constexpr size_t WS_S5 = 768 * MiB;
constexpr size_t WS_S6 = 896 * MiB;
constexpr size_t WS_END = 1024 * MiB;
constexpr size_t WS_QLB = WS_S3, WS_KVLB = WS_S3 + 48 * MiB, WS_KRB = WS_S3 + 80 * MiB;
constexpr size_t WS_U = WS_S4, WS_DP = WS_S4 + 64 * MiB;
constexpr size_t WS_HID = WS_S4, WS_LIST = WS_S4 + 80 * MiB, WS_WL = WS_S4 + 88 * MiB, WS_RSL = WS_S4 + 96 * MiB;
constexpr size_t WS_KN = WS_S5, WS_V = WS_S5 + 64 * MiB;
constexpr size_t WS_ATT = WS_S6;

constexpr int RING_BYTES = 131072;
constexpr int MISC_OFF = RING_BYTES;
constexpr int LDS_BYTES = RING_BYTES + 24576;
constexpr int MO_BAR = 0;
constexpr int MO_HIST = 64, MO_BASE = 64 + 128;
constexpr int MO_CNTL = 1024, MO_TBASE = 1024 + 128, MO_TILEE = 2048;
constexpr int MAX_TILES = 544;
constexpr int MO_PS = 8192;

typedef __bf16 bf16x2_t __attribute__((ext_vector_type(2)));
__device__ __forceinline__ unsigned cvt_pk_bf16(float lo, float hi) { const f32x2 v = {lo, hi}; const bf16x2_t b = __builtin_convertvector(v, bf16x2_t); return __builtin_bit_cast(unsigned, b); }
__device__ __forceinline__ float bf_lo(unsigned w) { return __uint_as_float(w << 16); }
__device__ __forceinline__ float bf_hi(unsigned w) { return __uint_as_float(w & 0xffff0000u); }
__device__ __forceinline__ int lane_mb() { int l; asm volatile("v_mbcnt_lo_u32_b32 %0, -1, 0\n\tv_mbcnt_hi_u32_b32 %0, -1, %0" : "=v"(l)); return l; }
#define RELANE int tidq_ = wave * 64 + lane_mb(); asm volatile("" : "+v"(tidq_)); const int tid = tidq_, lane = tid & 63; (void)lane;
__device__ __forceinline__ void store8(bf16_t* p, const f32x4 v0, const f32x4 v1) {
    u32x4 w; w.x = cvt_pk_bf16(v0[0], v0[1]); w.y = cvt_pk_bf16(v0[2], v0[3]); w.z = cvt_pk_bf16(v1[0], v1[1]); w.w = cvt_pk_bf16(v1[2], v1[3]);
    *(u32x4*)p = w; }
__device__ __forceinline__ unsigned cvt4_fp8(float a, float b, float c, float d) { unsigned w = __float_as_uint(a);      w = __builtin_amdgcn_cvt_pk_fp8_f32(a, b, w, false); w = __builtin_amdgcn_cvt_pk_fp8_f32(c, d, w, true); return w; }
__device__ __forceinline__ void store8_fp8(unsigned char* p, const f32x4 v0, const f32x4 v1) { u32x2 w; w.x = cvt4_fp8(v0[0], v0[1], v0[2], v0[3]); w.y = cvt4_fp8(v1[0], v1[1], v1[2], v1[3]); *(u32x2*)p = w; }
__device__ __forceinline__ void unpack8_fp8(const u32x2 w, f32x4& v0, f32x4& v1) { const f32x2 a = __builtin_amdgcn_cvt_pk_f32_fp8((int)w.x, false), b = __builtin_amdgcn_cvt_pk_f32_fp8((int)w.x, true), c = __builtin_amdgcn_cvt_pk_f32_fp8((int)w.y, false), d = __builtin_amdgcn_cvt_pk_f32_fp8((int)w.y, true);
    v0 = (f32x4){a.x, a.y, b.x, b.y}; v1 = (f32x4){c.x, c.y, d.x, d.y}; }
__device__ __forceinline__ void load8(const bf16_t* p, f32x4& v0, f32x4& v1) {
    const u32x4 w = *(const u32x4*)p; v0 = (f32x4){bf_lo(w.x), bf_hi(w.x), bf_lo(w.y), bf_hi(w.y)}; v1 = (f32x4){bf_lo(w.z), bf_hi(w.z), bf_lo(w.w), bf_hi(w.w)}; }
__device__ __forceinline__ float fast_exp2(float x) { return __builtin_amdgcn_exp2f(x); }
__device__ __forceinline__ float sigmoidf_(float x) { return __builtin_amdgcn_rcpf(1.0f + fast_exp2(-1.4426950408889634f * x)); }
__device__ __forceinline__ float wave_sum(float v) {
#pragma unroll
    for (int o = 1; o < 64; o <<= 1) v += __shfl_xor(v, o);
    return v;
}

namespace pg8 {
#ifndef PG8_WGM
#define PG8_WGM 8
#endif
constexpr int BM = 256, BK = 64, HALF = 128, HTB = HALF * BK * 2, NXCD = 8, WGM = PG8_WGM;
__host__ __device__ __forceinline__ int lds_byte(int r, int c) { const int st = (r >> 4) * 2 + (c >> 5), rr = r & 15, cc = c & 31, ob = rr * 64 + cc * 2; return st * 1024 + (ob ^ (((ob >> 9) & 1) << 5)); }
__host__ __device__ __forceinline__ void stage_rc(int b, int& R, int& C) { const int st = b / 1024, sb = b % 1024, swz = sb ^ (((sb >> 9) & 1) << 5); R = (st >> 1) * 16 + swz / 64; C = (st & 1) * 32 + (swz % 64) / 2; }
__host__ __device__ __forceinline__ int perm32(int rho) { const int n = rho >> 4, i = rho & 15; return 8 * (i >> 2) + 4 * n + (i & 3); }
struct Unit { int pm, pn; };
struct StaticOrder {
    int nM, nN, nwg, G, c;
    __host__ __device__ __forceinline__ void init(int M, int N, int G_, int c_) { nM = M / BM; nN = N / BM; nwg = nM * nN; G = G_; c = c_; }
    __host__ __device__ __forceinline__ bool next(int i, Unit& u) const { return at((long)i * G + c, u); }
    __host__ __device__ __forceinline__ bool at(const long L, Unit& u) const {
        if (L >= nwg) return false;
        int wgid = (int)L; { const int q = nwg / NXCD, r = nwg % NXCD, xcd = wgid % NXCD, off = wgid / NXCD; wgid = (xcd < r ? xcd * (q + 1) : r * (q + 1) + (xcd - r) * q) + off; }
        const int nig = WGM * nN, gid = wgid / nig, fm = gid * WGM, gsz = (nM - fm) < WGM ? (nM - fm) : WGM, w = wgid - gid * nig;
        if (gsz == WGM) { u.pm = fm + (w % WGM); u.pn = w / WGM; }
        else { u.pm = fm + (w % gsz); u.pn = w / gsz; }
        return true;
    }
};
struct ListOrder {
    int pm, n;
    __device__ __forceinline__ bool next(int i, Unit& u) const { if (i >= n) return false; u.pm = pm; u.pn = i; return true; }
};
template <class T, class = void> struct HasPack : std::false_type {};
template <class T> struct HasPack<T, std::void_t<decltype(T::PACK8)>> : std::integral_constant<bool, T::PACK8> {};
template <class T, class = void> struct HasBrow : std::false_type {};
template <class T> struct HasBrow<T, std::void_t<decltype(std::declval<const T&>().brow(0))>> : std::true_type {};
template <class Op, class Sched>
__device__ __forceinline__ void gemm_phase(LAS unsigned char* lds, const Op& op, const Sched& S, const int wv_) {
    int tid_ = wv_ * 64 + lane_mb(); asm volatile("" : "+v"(tid_));
    const int tid = tid_, wid = __builtin_amdgcn_readfirstlane(tid >> 6), lane = tid & 63, wr = wid >> 2, wc = wid & 3, fr = lane & 15, fq = lane >> 4;
    const int K = op.K, nt = K / BK;
    unsigned voffA0[2], voffA1[2], voffB[2];
#pragma unroll
    for (int i = 0; i < 2; ++i) { int R, C; stage_rc(tid * 16 + i * 8192, R, C); int Rb = Op::PERM ? ((R & ~31) + perm32(R & 31)) : R; if constexpr (HasBrow<Op>::value) Rb = op.brow(Rb);
        if constexpr (!Op::GATHER) { voffA0[i] = op.a_off(R, C); voffA1[i] = 0u; } voffB[i] = (unsigned)(Rb * op.ldb + C) * 2u; }
    const size_t kstep = (size_t)(BK * 2);
    const size_t hstepB = (size_t)HALF * op.ldb * 2;
    size_t hstepA = 0; if constexpr (!Op::GATHER) hstepA = (size_t)op.a_off(HALF, 0);
    const unsigned ldsw = (unsigned)wid * 1024u;
    const int aoff = lds_byte(wr * 64 + fr, fq * 8), boff = lds_byte(wc * 32 + fr, fq * 8);
#define PG8_SA(b, h) (((b) * 2 + (h)) * HTB)
#define PG8_SB(b, h) ((4 + (b) * 2 + (h)) * HTB)
#define PG8_STAGE(bufoff, gbase, voff) do { _Pragma("unroll") for (int _i = 0; _i < 2; ++_i) \
        __builtin_amdgcn_global_load_lds((const unsigned*)((const char*)(gbase) + (voff)[_i]), (LAS unsigned*)(lds + (bufoff) + ldsw + _i * 8192), 16, 0, 0); } while (0)
#define PG8_STAGE_A1(bufoff, gbase, vg) do { if constexpr (Op::GATHER) PG8_STAGE(bufoff, gbase, vg); else PG8_STAGE(bufoff, (gbase) + hstepA, voffA0); } while (0)
#define PG8_LDA(dst, b, h) do { if constexpr (Op::FP8) { _Pragma("unroll") for (int m = 0; m < 4; ++m) dst##8[m] = __builtin_shufflevector(*(const LAS v4i_t*)(lds + PG8_SA(b, h) + aoff + m * 2048), *(const LAS v4i_t*)(lds + PG8_SA(b, h) + aoff + m * 2048 + 1024), 0, 1, 2, 3, 4, 5, 6, 7); } \
        else { _Pragma("unroll") for (int m = 0; m < 4; ++m) _Pragma("unroll") for (int k = 0; k < 2; ++k) dst[m][k] = *(const LAS bf16x8*)(lds + PG8_SA(b, h) + aoff + m * 2048 + k * 1024); } } while (0)
#define PG8_LDB(dst, b, h) do { if constexpr (Op::FP8) { _Pragma("unroll") for (int n = 0; n < 2; ++n) dst##8[n] = __builtin_shufflevector(*(const LAS v4i_t*)(lds + PG8_SB(b, h) + boff + n * 2048), *(const LAS v4i_t*)(lds + PG8_SB(b, h) + boff + n * 2048 + 1024), 0, 1, 2, 3, 4, 5, 6, 7); } \
        else { _Pragma("unroll") for (int n = 0; n < 2; ++n) _Pragma("unroll") for (int k = 0; k < 2; ++k) dst[n][k] = *(const LAS bf16x8*)(lds + PG8_SB(b, h) + boff + n * 2048 + k * 1024); } } while (0)
#define PG8_MMA(ai, bj, At, Bt) do { __builtin_amdgcn_s_setprio(1); _Pragma("unroll") for (int m = 0; m < 4; ++m) _Pragma("unroll") for (int n = 0; n < 2; ++n) _Pragma("unroll") for (int k = 0; k < 2; ++k) \
        acc[ai][bj][m][n] = __builtin_amdgcn_mfma_f32_16x16x32_bf16(Bt[n][k], At[m][k], acc[ai][bj][m][n], 0, 0, 0); __builtin_amdgcn_s_setprio(0); } while (0)
#define PG8_MMA8(ai, bj, At, Bt) do { __builtin_amdgcn_s_setprio(1); _Pragma("unroll") for (int m = 0; m < 4; ++m) _Pragma("unroll") for (int n = 0; n < 2; ++n) \
        asm volatile("v_mfma_scale_f32_16x16x128_f8f6f4 %0, %1, %2, %0, %3, %4 op_sel_hi:[0,0,0]" : "+v"(acc[ai][bj][m][n]) : "v"(Bt##8[n]), "v"(At##8[m]), "v"(sclW), "v"(sclA)); \
        __builtin_amdgcn_s_setprio(0); } while (0)
#define PG8_MMAX(ai, bj, At, Bt) do { if constexpr (Op::FP8) PG8_MMA8(ai, bj, At, Bt); else PG8_MMA(ai, bj, At, Bt); } while (0)
#define PG8_MMAZ(ai, bj, At, Bt) do { __builtin_amdgcn_s_setprio(1); _Pragma("unroll") for (int m = 0; m < 4; ++m) _Pragma("unroll") for (int n = 0; n < 2; ++n) { \
        acc[ai][bj][m][n] = __builtin_amdgcn_mfma_f32_16x16x32_bf16(Bt[n][0], At[m][0], (f32x4){0.f, 0.f, 0.f, 0.f}, 0, 0, 0); \
        acc[ai][bj][m][n] = __builtin_amdgcn_mfma_f32_16x16x32_bf16(Bt[n][1], At[m][1], acc[ai][bj][m][n], 0, 0, 0); } __builtin_amdgcn_s_setprio(0); } while (0)
#define PG8_MMA8Z(ai, bj, At, Bt) do { __builtin_amdgcn_s_setprio(1); _Pragma("unroll") for (int m = 0; m < 4; ++m) _Pragma("unroll") for (int n = 0; n < 2; ++n) \
        asm volatile("v_mfma_scale_f32_16x16x128_f8f6f4 %0, %1, %2, 0, %3, %4 op_sel_hi:[0,0,0]" : "=&v"(acc[ai][bj][m][n]) : "v"(Bt##8[n]), "v"(At##8[m]), "v"(sclW), "v"(sclA)); \
        __builtin_amdgcn_s_setprio(0); } while (0)
#define PG8_MMAXZ(ai, bj, At, Bt) do { if constexpr (Op::FP8) PG8_MMA8Z(ai, bj, At, Bt); else PG8_MMAZ(ai, bj, At, Bt); } while (0)
#define PG8_MMAX1(ai, bj, At, Bt) do { if (t == 0) PG8_MMAXZ(ai, bj, At, Bt); else PG8_MMAX(ai, bj, At, Bt); } while (0)
#define PG8_WAIT_V(n) asm volatile("s_waitcnt vmcnt(" #n ")" ::: "memory")
#define PG8_WAIT_L(n) asm volatile("s_waitcnt lgkmcnt(" #n ")" ::: "memory")
#define PG8_BAR __builtin_amdgcn_s_barrier()
#define PG8_SCHED __builtin_amdgcn_sched_barrier(0)
    Unit cur, nxt; int ui = 0;
    if (!S.next(0, cur)) return;
    unsigned nvA0[2], nvA1[2];
    if constexpr (Op::GATHER) {
#pragma unroll
        for (int i = 0; i < 2; ++i) { int R, C; stage_rc(tid * 16 + i * 8192, R, C); voffA0[i] = op.a_off_u(cur, R, C); voffA1[i] = op.a_off_u(cur, R + HALF, C); nvA0[i] = voffA0[i]; nvA1[i] = voffA1[i]; } }
    static_assert(PG8_SP2 == 1, "the C = 0 first products are wired into the SP2 loop only");
    f32x4 acc[2][2][4][2];
    int sclW = 0x7A7A7A7A, sclA = 0x7F7F7F7F; (void)sclW; (void)sclA;
    bf16x8 At[4][2], B0[2][2], B1[2][2]; v8i_t At8[4], B08[2], B18[2];
    const char* cA = op.a_base(cur); const char* cB = op.b_base(cur);
    if (PG8_SP2) {
        PG8_STAGE(PG8_SB(0, 0), cB, voffB); PG8_STAGE(PG8_SB(0, 1), cB + hstepB, voffB); PG8_STAGE(PG8_SA(0, 0), cA, voffA0); PG8_STAGE_A1(PG8_SA(0, 1), cA, voffA1);
        if (wr == 1) PG8_BAR;
        PG8_WAIT_V(2); PG8_BAR;
        PG8_STAGE(PG8_SB(1, 0), cB + kstep, voffB); PG8_STAGE(PG8_SA(1, 0), cA + kstep, voffA0); PG8_STAGE(PG8_SB(1, 1), cB + hstepB + kstep, voffB);
        PG8_WAIT_V(6); PG8_BAR;
    } else {
    PG8_STAGE(PG8_SB(0, 0), cB, voffB); PG8_STAGE(PG8_SA(0, 0), cA, voffA0); PG8_STAGE(PG8_SB(0, 1), cB + hstepB, voffB); PG8_STAGE_A1(PG8_SA(0, 1), cA, voffA1);
    if (wr == 1) PG8_BAR;
    PG8_WAIT_V(4); PG8_BAR;
    PG8_STAGE(PG8_SB(1, 0), cB + kstep, voffB); PG8_STAGE(PG8_SA(1, 0), cA + kstep, voffA0); PG8_STAGE(PG8_SB(1, 1), cB + hstepB + kstep, voffB);
    PG8_WAIT_V(6); PG8_BAR;
    }
    for (;;) {
        const bool has_next = S.next(ui + 1, nxt);
        const char* nA = has_next ? op.a_base(nxt) : cA; const char* nB = has_next ? op.b_base(nxt) : cB;
        if constexpr (Op::GATHER) { if (has_next) {
#pragma unroll
            for (int i = 0; i < 2; ++i) { int R, C; stage_rc(tid * 16 + i * 8192, R, C); nvA0[i] = op.a_off_u(nxt, R, C); nvA1[i] = op.a_off_u(nxt, R + HALF, C); } } }
        for (int t = 0; t < nt; t += 2) {
            const bool last = (t == nt - 2);
            if constexpr (Op::GATHER) asm volatile("" : "+v"(voffA1[0]), "+v"(voffA1[1]));
            asm volatile("" : "+v"(voffA0[0]), "+v"(voffA0[1]), "+v"(voffB[0]), "+v"(voffB[1]));
            const char* a1 = cA + (size_t)(t + 1) * kstep;
            const char* a2 = last ? nA : cA + (size_t)(t + 2) * kstep; const char* b2 = last ? nB : cB + (size_t)(t + 2) * kstep;
            const char* a3 = a2 + kstep; const char* b3 = b2 + kstep;
            unsigned sA0[2], sA1[2];
#pragma unroll
            for (int i = 0; i < 2; ++i) { if constexpr (Op::GATHER) { sA0[i] = last ? nvA0[i] : voffA0[i]; sA1[i] = last ? nvA1[i] : voffA1[i]; } else { sA0[i] = voffA0[i]; sA1[i] = voffA1[i]; } }
            if (PG8_SP2) {
            const bool fresh = (t == 0) && (ui > 0);
            PG8_LDB(B0, 0, 0); PG8_LDB(B1, 0, 1); PG8_SCHED; PG8_LDA(At, 0, 0); if (!fresh) PG8_STAGE_A1(PG8_SA(1, 1), a1, voffA1);
            if (!fresh) PG8_WAIT_V(8); PG8_WAIT_L(0); PG8_BAR; PG8_MMAX1(0, 0, At, B0); PG8_MMAX1(0, 1, At, B1); PG8_BAR; PG8_SCHED;
            PG8_LDA(At, 0, 1); PG8_STAGE(PG8_SB(0, 0), b2, voffB); PG8_STAGE(PG8_SB(0, 1), b2 + hstepB, voffB); PG8_STAGE(PG8_SA(0, 0), a2, sA0);
            if (!fresh) PG8_WAIT_V(8); PG8_WAIT_L(0); PG8_BAR; PG8_MMAX1(1, 0, At, B0); PG8_MMAX1(1, 1, At, B1); PG8_BAR; PG8_SCHED;
            PG8_LDB(B0, 1, 0); PG8_LDB(B1, 1, 1); PG8_SCHED; PG8_LDA(At, 1, 0); PG8_STAGE_A1(PG8_SA(0, 1), a2, sA1);
            if (!fresh) PG8_WAIT_V(8); PG8_WAIT_L(0); PG8_BAR; PG8_MMAX(0, 0, At, B0); PG8_MMAX(0, 1, At, B1); PG8_BAR; PG8_SCHED;
            PG8_LDA(At, 1, 1); PG8_STAGE(PG8_SB(1, 0), b3, voffB); PG8_STAGE(PG8_SB(1, 1), b3 + hstepB, voffB); PG8_STAGE(PG8_SA(1, 0), a3, sA0);
            if (!fresh) PG8_WAIT_V(8); PG8_WAIT_L(0); PG8_BAR; PG8_MMAX(1, 0, At, B0); PG8_MMAX(1, 1, At, B1); PG8_BAR; PG8_SCHED;
            } else {
            PG8_LDB(B0, 0, 0); PG8_SCHED; PG8_LDA(At, 0, 0); PG8_STAGE_A1(PG8_SA(1, 1), a1, voffA1);
            PG8_WAIT_L(8); PG8_BAR; PG8_WAIT_L(0); PG8_MMAX(0, 0, At, B0); PG8_BAR; PG8_SCHED;
            PG8_LDB(B1, 0, 1); PG8_STAGE(PG8_SB(0, 0), b2, voffB);
            PG8_BAR; PG8_WAIT_L(0); PG8_MMAX(0, 1, At, B1); PG8_BAR;
            PG8_LDA(At, 0, 1); PG8_STAGE(PG8_SA(0, 0), a2, sA0);
            PG8_BAR; PG8_WAIT_L(0); PG8_MMAX(1, 0, At, B0); PG8_BAR; PG8_SCHED;
            PG8_STAGE(PG8_SB(0, 1), b2 + hstepB, voffB);
            PG8_WAIT_V(6); PG8_BAR; PG8_MMAX(1, 1, At, B1); PG8_BAR;
            PG8_LDB(B0, 1, 0); PG8_SCHED; PG8_LDA(At, 1, 0); PG8_STAGE_A1(PG8_SA(0, 1), a2, sA1);
            PG8_WAIT_L(8); PG8_BAR; PG8_WAIT_L(0); PG8_MMAX(0, 0, At, B0); PG8_BAR; PG8_SCHED;
            PG8_LDB(B1, 1, 1); PG8_STAGE(PG8_SB(1, 0), b3, voffB);
            PG8_BAR; PG8_WAIT_L(0); PG8_MMAX(0, 1, At, B1); PG8_BAR;
            PG8_LDA(At, 1, 1); PG8_STAGE(PG8_SA(1, 0), a3, sA0);
            PG8_BAR; PG8_WAIT_L(0); PG8_MMAX(1, 0, At, B0); PG8_BAR; PG8_SCHED;
            PG8_STAGE(PG8_SB(1, 1), b3 + hstepB, voffB);
            PG8_WAIT_V(6); PG8_BAR; PG8_MMAX(1, 1, At, B1); PG8_BAR;
            }
        }
        if constexpr (Op::FP8) asm volatile("s_nop 15\n\ts_nop 15" ::: "memory");
        if (PG8_ALIGN_EPI) { if (wr == 0) PG8_BAR; }
        if (PG8_SP2 && PG8_ALIGN_EPI && has_next) {
            if constexpr (Op::GATHER) { PG8_STAGE_A1(PG8_SA(1, 1), nA + kstep, nvA1); } else { PG8_STAGE_A1(PG8_SA(1, 1), nA + kstep, voffA1); } }
        {
          int lane_e = (int)__builtin_amdgcn_mbcnt_hi(~0u, __builtin_amdgcn_mbcnt_lo(~0u, 0u)); asm volatile("" : "+v"(lane_e));
          const int src_ = ((((lane_e & 3) << 4) | (lane_e >> 2)) << 2);
          bool packed_ = false;
          if constexpr (HasPack<Op>::value) { if (op.use_pack(cur)) { packed_ = true;
              u32x2 pk[2][2][4]; op.pack(acc, cur, wr, wc, lane_e & 15, lane_e >> 4, pk);
#pragma unroll
              for (int a = 0; a < 2; ++a)
#pragma unroll
                  for (int b = 0; b < 2; ++b)
#pragma unroll
                      for (int m = 0; m < 4; ++m) { pk[a][b][m].x = (unsigned)__builtin_amdgcn_ds_bpermute(src_, (int)pk[a][b][m].x); pk[a][b][m].y = (unsigned)__builtin_amdgcn_ds_bpermute(src_, (int)pk[a][b][m].y); }
              if (PG8_SP2 && PG8_ALIGN_EPI) PG8_WAIT_V(0);
              op.epi_packed(pk, cur, wr, wc, lane_e >> 2, lane_e & 3); } }
          if (!packed_) {
#pragma unroll
          for (int a = 0; a < 2; ++a)
#pragma unroll
              for (int b = 0; b < 2; ++b)
#pragma unroll
                  for (int m = 0; m < 4; ++m)
#pragma unroll
                      for (int n = 0; n < 2; ++n)
#pragma unroll
                          for (int j = 0; j < 4; ++j) acc[a][b][m][n][j] = __int_as_float(__builtin_amdgcn_ds_bpermute(src_, __float_as_int(acc[a][b][m][n][j])));
          if (PG8_SP2 && PG8_ALIGN_EPI) PG8_WAIT_V(0);
          op.epi(acc, cur, wr, wc, lane_e >> 2, lane_e & 3); } }
        if (!has_next) break;
        cur = nxt; cA = nA; cB = nB; ++ui;
        if constexpr (Op::GATHER) {
#pragma unroll
            for (int i = 0; i < 2; ++i) { voffA0[i] = nvA0[i]; voffA1[i] = nvA1[i]; } }
        if (PG8_ALIGN_EPI) { if (wr == 1) PG8_BAR; }
    }
    PG8_WAIT_V(0);
    if (!PG8_ALIGN_EPI) { if (wr == 0) PG8_BAR; }
    PG8_BAR;
#undef PG8_SA
#undef PG8_SB
#undef PG8_STAGE
#undef PG8_LDA
#undef PG8_STAGE_A1
#undef PG8_LDB
#undef PG8_MMA
#undef PG8_MMA8
#undef PG8_MMAX
#undef PG8_MMAZ
#undef PG8_MMA8Z
#undef PG8_MMAXZ
#undef PG8_MMAX1
#undef PG8_WAIT_V
#undef PG8_WAIT_L
#undef PG8_BAR
#undef PG8_SCHED
}
}
using pg8::Unit;
typedef f32x4 Acc[2][2][4][2];

struct RopeCS { f32x4 c0, c1, s0, s1; };
__device__ __forceinline__ RopeCS rope_load(const float* cosT, const float* sinT, int row, int fq) { const int i0 = 8 * (fq & 1); RopeCS r;
    r.c0 = *(const f32x4*)(cosT + (size_t)row * 16 + i0); r.c1 = *(const f32x4*)(cosT + (size_t)row * 16 + i0 + 4); r.s0 = *(const f32x4*)(sinT + (size_t)row * 16 + i0); r.s1 = *(const f32x4*)(sinT + (size_t)row * 16 + i0 + 4); return r; }
__device__ __forceinline__ void rope_apply(f32x4& v0, f32x4& v1, const RopeCS& r, int fq) {
    f32x4 p0, p1;
#pragma unroll
    for (int j = 0; j < 4; ++j) { p0[j] = __shfl_xor(v0[j], 2); p1[j] = __shfl_xor(v1[j], 2); }
    if (fq < 2) { v0 = v0 * r.c0 - p0 * r.s0; v1 = v1 * r.c1 - p1 * r.s1; } else { v0 = v0 * r.c0 + p0 * r.s0; v1 = v1 * r.c1 + p1 * r.s1; }
}
__device__ __forceinline__ void rope_apply_pre(f32x4& v0, f32x4& v1, const RopeCS& r, int fq) {
    f32x4 p0, p1;
#pragma unroll
    for (int j = 0; j < 4; ++j) { p0[j] = __shfl_xor(v0[j], 32); p1[j] = __shfl_xor(v1[j], 32); }
    if (fq < 2) { v0 = v0 * r.c0 - p0 * r.s0; v1 = v1 * r.c1 - p1 * r.s1; } else { v0 = v0 * r.c0 + p0 * r.s0; v1 = v1 * r.c1 + p1 * r.s1; }
}
__device__ __forceinline__ void rope8(f32x4& v0, f32x4& v1, const float* cosT, const float* sinT, int row, int fq) {
    f32x4 p0, p1;
#pragma unroll
    for (int j = 0; j < 4; ++j) { p0[j] = __shfl_xor(v0[j], 2); p1[j] = __shfl_xor(v1[j], 2); }
    const int i0 = 8 * (fq & 1);
    const f32x4 c0 = *(const f32x4*)(cosT + (size_t)row * 16 + i0), c1 = *(const f32x4*)(cosT + (size_t)row * 16 + i0 + 4);
    const f32x4 s0 = *(const f32x4*)(sinT + (size_t)row * 16 + i0), s1 = *(const f32x4*)(sinT + (size_t)row * 16 + i0 + 4);
    if (fq < 2) { v0 = v0 * c0 - p0 * s0; v1 = v1 * c1 - p1 * s1; }
    else        { v0 = v0 * c0 + p0 * s0; v1 = v1 * c1 + p1 * s1; }
}
__device__ __forceinline__ float ssq8(const f32x4 v0, const f32x4 v1) { return (v0[0] * v0[0] + v0[1] * v0[1]) + (v0[2] * v0[2] + v0[3] * v0[3]) + (v1[0] * v1[0] + v1[1] * v1[1]) + (v1[2] * v1[2] + v1[3] * v1[3]); }
typedef unsigned long long u64;
constexpr float FX_SCALE = 16777216.0f, FX_INV = 1.0f / 16777216.0f;
__device__ __forceinline__ void row_atomic_add(u64* p, float s, int fq) { s += __shfl_xor(s, 1); s += __shfl_xor(s, 2); if (fq == 0) __hip_atomic_fetch_add(p, (u64)(s * FX_SCALE + 0.5f), RLX_AGENT); }
__device__ __forceinline__ float fx_load(const u64* p) { return (float)(*p) * FX_INV; }

#ifndef EPI_FENCE
#define EPI_FENCE
#endif
#define RT_(ai, m) ((ai) * 128 + wr * 64 + (m) * 16 + fr)
#define FOR_AI _Pragma("unroll") for (int ai = 0; ai < 2; ++ai)
#define FOR_M _Pragma("unroll") for (int m = 0; m < 4; ++m)
#define FOR_BJ _Pragma("unroll") for (int bj = 0; bj < 2; ++bj)
__device__ __forceinline__ void unpack8(const u32x4 w, f32x4& v0, f32x4& v1) { v0 = (f32x4){bf_lo(w.x), bf_hi(w.x), bf_lo(w.y), bf_hi(w.y)}; v1 = (f32x4){bf_lo(w.z), bf_hi(w.z), bf_lo(w.w), bf_hi(w.w)}; }
#define EPI_ROWS(...) _Pragma("unroll") for (int ai = 0; ai < 2; ++ai) _Pragma("unroll") for (int m = 0; m < 4; ++m) { const int rt = ai * 128 + wr * 64 + m * 16 + fr; __VA_ARGS__ EPI_FENCE }

template <bool F8> struct OpInT {
    static constexpr bool PERM = true, GATHER = false, FP8 = F8;
    const bf16_t* A; const bf16_t* Bt; int K, lda, ldb;
    bf16_t *QLb, *KVLb, *KRb, *U, *GA, *GB; u64 *ssq_q, *ssq_kv; const float *cosT, *sinT;
    const float* rs0;
    __device__ __forceinline__ unsigned a_off(int r, int c) const { return (unsigned)(r * lda + c) * 2u; }
    __device__ __forceinline__ const char* a_base(const Unit& u) const { return (const char*)(A + (size_t)u.pm * 256 * lda); }
    __device__ __forceinline__ const char* b_base(const Unit& u) const { return (const char*)(Bt + (size_t)u.pn * 256 * ldb); }
    __device__ __forceinline__ void epi(const Acc& acc, const Unit& u, int wr, int wc, int fr, int fq) const {
        const int row0 = u.pm * 256, col = 32 * wc + 8 * fq;
#pragma unroll
        for (int bj = 0; bj < 2; ++bj) {
            const int hc = u.pn * 2 + bj;
            if (hc < 5) {
                u64* ssq = hc < 3 ? ssq_q : ssq_kv;
                if constexpr (F8) {
                    unsigned char* dst = hc < 3 ? (unsigned char*)QLb + hc * 128 : (unsigned char*)KVLb + (hc - 3) * 128; const int pitch = hc < 3 ? 512 : 256;
                    EPI_ROWS( const int row = row0 + rt; const f32x4 v0 = acc[ai][bj][m][0], v1 = acc[ai][bj][m][1];
                        row_atomic_add(ssq + row, ssq8(v0, v1), fq); store8_fp8(dst + (size_t)row * pitch + col, v0, v1);
                        if (hc == 2) *(u32x2*)(dst + (size_t)row * pitch + col + 128) = (u32x2){0u, 0u}; )
                } else {
                bf16_t* dst = hc < 3 ? QLb + hc * 128 : KVLb + (hc - 3) * 128; const int pitch = hc < 3 ? QLORA : KVLORA;
                EPI_ROWS( const int row = row0 + rt; const f32x4 v0 = acc[ai][bj][m][0], v1 = acc[ai][bj][m][1];
                    row_atomic_add(ssq + row, ssq8(v0, v1), fq); store8(dst + (size_t)row * pitch + col, v0, v1); )
                }
            } else if (hc == 5) {
                if (wc == 0) { FOR_AI { RopeCS cs[4]; FOR_M cs[m] = rope_load(cosT, sinT, row0 + RT_(ai, m), fq);
                    FOR_M { const int row = row0 + RT_(ai, m); f32x4 v0 = acc[ai][bj][m][0], v1 = acc[ai][bj][m][1]; rope_apply(v0, v1, cs[m], fq);
                        if constexpr (F8) store8_fp8((unsigned char*)KRb + (size_t)row * ROPE + col, v0, v1);
                        else store8(KRb + (size_t)row * ROPE + col, v0, v1); } } }
            } else if (hc < 10) {
                bf16_t* dst = U + (hc - 6) * 128;
                EPI_ROWS( const int row = row0 + rt; const float r_ = rs0 ? rs0[row] : 1.f; store8(dst + (size_t)row * POOLW + col, acc[ai][bj][m][0] * r_, acc[ai][bj][m][1] * r_); )
            } else {
                bf16_t* dst = hc < 18 ? GA + (hc - 10) * 128 : GB + (hc - 18) * 128;
                EPI_ROWS( const int row = row0 + rt; f32x4 v0 = acc[ai][bj][m][0], v1 = acc[ai][bj][m][1];
                    _Pragma("unroll") for (int j = 0; j < 4; ++j) { v0[j] = sigmoidf_(v0[j]); v1[j] = sigmoidf_(v1[j]); }
                    store8(dst + (size_t)row * DM + col, v0, v1); )
            }
        }
    }
};
typedef OpInT<false> OpIn; typedef OpInT<true> OpIn8;
struct OpGate8 {
    static constexpr bool PERM = true, GATHER = false, FP8 = true, PACK8 = false;
    __device__ __forceinline__ bool use_pack(const Unit& u) const { return u.pn < 9; }
    __device__ __forceinline__ void pack(const Acc& acc, const Unit&, int, int, int, int, u32x2 (&pk)[2][2][4]) const {
        FOR_AI FOR_BJ FOR_M { f32x4 v0 = acc[ai][bj][m][0], v1 = acc[ai][bj][m][1];
            _Pragma("unroll") for (int j = 0; j < 4; ++j) { v0[j] = sigmoidf_(v0[j]) * 256.f; v1[j] = sigmoidf_(v1[j]) * 256.f; }
            pk[ai][bj][m].x = cvt4_fp8(v0[0], v0[1], v0[2], v0[3]); pk[ai][bj][m].y = cvt4_fp8(v1[0], v1[1], v1[2], v1[3]); } }
    __device__ __forceinline__ void epi_packed(const u32x2 (&pk)[2][2][4], const Unit& u, int wr, int wc, int fr, int fq) const {
        const size_t off = (size_t)u.pm * 256 * DM + ((u.pn - 5) & 3) * 256 + 32 * wc + 8 * fq;
        FOR_AI FOR_M FOR_BJ *(u32x2*)((unsigned char*)GA + off + (size_t)RT_(ai, m) * DM + bj * 128) = pk[ai][bj][m]; }
    const bf16_t* A; const bf16_t* Bt; int K, lda, ldb;
    bf16_t *GA, *GB;
    __device__ __forceinline__ unsigned a_off(int r, int c) const { return (unsigned)(r * lda + c) * 2u; }
    __device__ __forceinline__ const char* a_base(const Unit& u) const { return (const char*)(A + (size_t)u.pm * 256 * lda); }
    __device__ __forceinline__ const char* b_base(const Unit& u) const { return (const char*)(Bt + (size_t)u.pn * 256 * ldb); }
    __device__ __forceinline__ void epi(const Acc& acc, const Unit& u, int wr, int wc, int fr, int fq) const {
        const size_t off = (size_t)u.pm * 256 * DM + ((u.pn - 5) & 3) * 256 + 32 * wc + 8 * fq;
        FOR_AI FOR_M FOR_BJ { f32x4 v0 = acc[ai][bj][m][0], v1 = acc[ai][bj][m][1];
            _Pragma("unroll") for (int j = 0; j < 4; ++j) { v0[j] = sigmoidf_(v0[j]); v1[j] = sigmoidf_(v1[j]); }
            if (u.pn < 9) store8_fp8((unsigned char*)GA + off + (size_t)RT_(ai, m) * DM + bj * 128, v0 * 256.f, v1 * 256.f);
            else store8(GB + off + (size_t)RT_(ai, m) * DM + bj * 128, v0, v1); }
    }
};
struct OffsetOrder { pg8::StaticOrder s; int off; __device__ __forceinline__ bool next(int i, Unit& u) const { if (!s.next(i, u)) return false; u.pn += off; return true; } };
struct GateOrder { pg8::StaticOrder s; int off, light;
    __device__ __forceinline__ bool next(int i, Unit& u) const { long L;
        if (2 * light != s.G || s.nwg != 8 * s.G) L = (long)i * s.G + s.c;
        else if (i < 7) L = (long)i * s.G + s.c;
        else if (s.c >= light && i < 9) L = 7L * s.G + (long)(i - 7) * light + (s.c - light);
        else return false;
        if (!s.at(L, u)) return false; u.pn += off; return true; } };
struct OpPlain {
    static constexpr bool PERM = true, GATHER = false, FP8 = false;
    const bf16_t* A; const bf16_t* Bt; int K, lda, ldb;
    bf16_t* O; int ldo;
    __device__ __forceinline__ unsigned a_off(int r, int c) const { return (unsigned)(r * lda + c) * 2u; }
    __device__ __forceinline__ const char* a_base(const Unit& u) const { return (const char*)(A + (size_t)u.pm * 256 * lda); }
    __device__ __forceinline__ const char* b_base(const Unit& u) const { return (const char*)(Bt + (size_t)u.pn * 256 * ldb); }
    __device__ __forceinline__ void epi(const Acc& acc, const Unit& u, int wr, int wc, int fr, int fq) const {
        bf16_t* base = O + (size_t)u.pm * 256 * ldo + u.pn * 256 + 32 * wc + 8 * fq;
        EPI_ROWS( _Pragma("unroll") for (int bj = 0; bj < 2; ++bj) store8(base + (size_t)rt * ldo + bj * 128, acc[ai][bj][m][0], acc[ai][bj][m][1]); )
    }
};
__device__ __forceinline__ int key_of_slot(int sl) { const int hi = sl >> 5, j = sl & 31, jj = j & 15; return ((j >> 4) << 5) + (jj & 3) + 8 * (jj >> 2) + 4 * hi; }
struct OpQ {
    static constexpr bool PERM = true, GATHER = false, FP8 = true, PACK8 = false;
    __device__ __forceinline__ bool use_pack(const Unit&) const { return true; }
    __device__ __forceinline__ void pack(const Acc& acc, const Unit& u, int wr, int wc, int fr, int fq, u32x2 (&pk)[2][2][4]) const {
        float rs[2][4]; FOR_AI FOR_M rs[ai][m] = fx_load(ssq_q + u.pm * 256 + RT_(ai, m));
        FOR_AI FOR_M rs[ai][m] = 16.f * C2Q * __builtin_amdgcn_rsqf(rs[ai][m] * (1.0f / QLORA) + EPS);
        const int g0 = u.pn * 8 + wc; const bool rp0 = (g0 % 3 == 2), rp1 = ((g0 + 4) % 3 == 2);
        FOR_AI _Pragma("unroll") for (int m0 = 0; m0 < 4; m0 += 2) { RopeCS cs[2]; if (rp0 || rp1) { _Pragma("unroll") for (int mi = 0; mi < 2; ++mi) cs[mi] = rope_load(cosT, sinT, u.pm * 256 + RT_(ai, m0 + mi), fq); }
            _Pragma("unroll") for (int mi = 0; mi < 2; ++mi) { const int m = m0 + mi;
                FOR_BJ { f32x4 v0 = acc[ai][bj][m][0] * rs[ai][m], v1 = acc[ai][bj][m][1] * rs[ai][m];
                    if (bj == 0 ? rp0 : rp1) rope_apply_pre(v0, v1, cs[mi], fq);
                    pk[ai][bj][m].x = cvt4_fp8(v0[0], v0[1], v0[2], v0[3]); pk[ai][bj][m].y = cvt4_fp8(v1[0], v1[1], v1[2], v1[3]); } } } }
    __device__ __forceinline__ void epi_packed(const u32x2 (&pk)[2][2][4], const Unit& u, int wr, int wc, int fr, int fq) const {
        const int g0 = u.pn * 8 + wc; const bool rp0 = (g0 % 3 == 2), rp1 = ((g0 + 4) % 3 == 2);
        FOR_AI FOR_M { const int row = u.pm * 256 + RT_(ai, m);
            FOR_BJ { const int g32 = g0 + bj * 4; unsigned char* qd = Q + (size_t)row * 1024 + (g32 / 3) * 128 + (g32 % 3) * 32 + 8 * fq; *(u32x2*)qd = pk[ai][bj][m]; if (bj == 0 ? rp0 : rp1) *(u32x2*)(qd + 32) = (u32x2){0u, 0u}; } } }
    const bf16_t* A; const bf16_t* Bt; int K, lda, ldb;
    unsigned char* Q  ; const u64* ssq_q; const float *cosT, *sinT;
    __device__ __forceinline__ unsigned a_off(int r, int c) const { return (unsigned)(r * lda + c) * 2u; }
    __device__ __forceinline__ const char* a_base(const Unit& u) const { return (const char*)(A + (size_t)u.pm * 256 * lda); }
    __device__ __forceinline__ const char* b_base(const Unit& u) const { return (const char*)(Bt + (size_t)u.pn * 256 * ldb); }
    __device__ __forceinline__ void epi(const Acc& acc, const Unit& u, int wr, int wc, int fr, int fq) const {
        float rs[2][4]; FOR_AI FOR_M rs[ai][m] = fx_load(ssq_q + u.pm * 256 + RT_(ai, m));
        FOR_AI FOR_M rs[ai][m] = 16.f * C2Q * __builtin_amdgcn_rsqf(rs[ai][m] * (1.0f / QLORA) + EPS);
        const int g0 = u.pn * 8 + wc; const bool rp0 = (g0 % 3 == 2), rp1 = ((g0 + 4) % 3 == 2);
        FOR_AI _Pragma("unroll") for (int m0 = 0; m0 < 4; m0 += 2) { RopeCS cs[2]; if (rp0 || rp1) { _Pragma("unroll") for (int mi = 0; mi < 2; ++mi) cs[mi] = rope_load(cosT, sinT, u.pm * 256 + RT_(ai, m0 + mi), fq); }
            _Pragma("unroll") for (int mi = 0; mi < 2; ++mi) { const int m = m0 + mi; const int row = u.pm * 256 + RT_(ai, m);
                FOR_BJ { const int g32 = g0 + bj * 4; f32x4 v0 = acc[ai][bj][m][0] * rs[ai][m], v1 = acc[ai][bj][m][1] * rs[ai][m];
                    if (bj == 0 ? rp0 : rp1) rope_apply(v0, v1, cs[mi], fq);
                    unsigned char* qd = Q + (size_t)row * 1024 + (g32 / 3) * 128 + (g32 % 3) * 32 + 8 * fq; store8_fp8(qd, v0, v1); if (bj == 0 ? rp0 : rp1) *(u32x2*)(qd + 32) = (u32x2){0u, 0u}; } } }
    }
};
struct OpK8 {
    static constexpr bool PERM = true, GATHER = false, FP8 = true, PACK8 = true;
    __device__ __forceinline__ bool use_pack(const Unit&) const { return true; }
    __device__ __forceinline__ void pack(const Acc& acc, const Unit& u, int wr, int wc, int fr, int fq, u32x2 (&pk)[2][2][4]) const {
        float rs[2][4]; FOR_AI FOR_M rs[ai][m] = fx_load(ssq_kv + u.pm * 256 + RT_(ai, m));
        FOR_AI FOR_M { const float r_ = __builtin_amdgcn_rsqf(rs[ai][m] * (1.0f / KVLORA) + EPS);
            FOR_BJ { const f32x4 a0 = acc[ai][bj][m][0] * r_, a1 = acc[ai][bj][m][1] * r_; pk[ai][bj][m].x = cvt4_fp8(a0[0], a0[1], a0[2], a0[3]); pk[ai][bj][m].y = cvt4_fp8(a1[0], a1[1], a1[2], a1[3]); } } }
    __device__ __forceinline__ void epi_packed(const u32x2 (&pk)[2][2][4], const Unit& u, int wr, int wc, int fr, int fq) const {
        FOR_AI FOR_M { const int row = u.pm * 256 + RT_(ai, m);
            FOR_BJ { const int col = u.pn * 256 + bj * 128 + 32 * wc + 8 * fq; *(u32x2*)(K8 + (size_t)row * 512 + col) = pk[ai][bj][m]; } } }
    const bf16_t* A; const bf16_t* Bt; int K, lda, ldb;
    unsigned char* K8; const u64* ssq_kv;
    __device__ __forceinline__ unsigned a_off(int r, int c) const { return (unsigned)(r * lda + c) * 2u; }
    __device__ __forceinline__ const char* a_base(const Unit& u) const { return (const char*)(A + (size_t)u.pm * 256 * lda); }
    __device__ __forceinline__ const char* b_base(const Unit& u) const { return (const char*)(Bt + (size_t)u.pn * 256 * ldb); }
    __device__ __forceinline__ void epi(const Acc& acc, const Unit& u, int wr, int wc, int fr, int fq) const {
        float rs[2][4]; FOR_AI FOR_M rs[ai][m] = fx_load(ssq_kv + u.pm * 256 + RT_(ai, m));
        FOR_AI FOR_M { const int row = u.pm * 256 + RT_(ai, m); const float r_ = __builtin_amdgcn_rsqf(rs[ai][m] * (1.0f / KVLORA) + EPS);
            FOR_BJ { const int col = u.pn * 256 + bj * 128 + 32 * wc + 8 * fq; store8_fp8(K8 + (size_t)row * 512 + col, acc[ai][bj][m][0] * r_, acc[ai][bj][m][1] * r_); } }
    }
};
struct OpVT {
    static constexpr bool PERM = true, GATHER = false, FP8 = true, PACK8 = true;
    __device__ __forceinline__ bool use_pack(const Unit&) const { return true; }
    __device__ __forceinline__ void pack(const Acc& acc, const Unit& u, int wr, int wc, int fr, int fq, u32x2 (&pk)[2][2][4]) const {
        float rs[2][2][4];
        FOR_BJ _Pragma("unroll") for (int n = 0; n < 2; ++n) _Pragma("unroll") for (int j = 0; j < 4; ++j) { const int c = bj * 128 + 32 * wc + 8 * fq + 4 * n + j; rs[bj][n][j] = fx_load(ssq_kv + u.pn * 256 + (c & ~63) + key_of_slot(c & 63)); }
        FOR_BJ _Pragma("unroll") for (int n = 0; n < 2; ++n) _Pragma("unroll") for (int j = 0; j < 4; ++j) rs[bj][n][j] = __builtin_amdgcn_rsqf(rs[bj][n][j] * (1.0f / KVLORA) + EPS);
        FOR_AI FOR_M FOR_BJ { f32x4 v0 = acc[ai][bj][m][0], v1 = acc[ai][bj][m][1];
            _Pragma("unroll") for (int j = 0; j < 4; ++j) { v0[j] *= rs[bj][0][j]; v1[j] *= rs[bj][1][j]; }
            pk[ai][bj][m].x = cvt4_fp8(v0[0], v0[1], v0[2], v0[3]); pk[ai][bj][m].y = cvt4_fp8(v1[0], v1[1], v1[2], v1[3]); } }
    __device__ __forceinline__ void epi_packed(const u32x2 (&pk)[2][2][4], const Unit& u, int wr, int wc, int fr, int fq) const {
        FOR_AI FOR_M FOR_BJ { const size_t grp = (size_t)u.pn * 4 + 2 * bj + (wc >> 1);
            *(u32x2*)(VT8 + (grp * 512 + u.pm * 256 + RT_(ai, m)) * 64 + (wc & 1) * 32 + 8 * fq) = pk[ai][bj][m]; } }
    const bf16_t* A; const bf16_t* Bt; int K, lda, ldb;
    unsigned char* VT8; const u64* ssq_kv;
    __device__ __forceinline__ int brow(int c) const { return (c & ~63) + key_of_slot(c & 63); }
    __device__ __forceinline__ unsigned a_off(int r, int c) const { return (unsigned)(r * lda + c) * 2u; }
    __device__ __forceinline__ const char* a_base(const Unit& u) const { return (const char*)(A + (size_t)u.pm * 256 * lda); }
    __device__ __forceinline__ const char* b_base(const Unit& u) const { return (const char*)(Bt + (size_t)u.pn * 256 * ldb); }
    __device__ __forceinline__ void epi(const Acc& acc, const Unit& u, int wr, int wc, int fr, int fq) const {
        float rs[2][2][4];
        FOR_BJ _Pragma("unroll") for (int n = 0; n < 2; ++n) _Pragma("unroll") for (int j = 0; j < 4; ++j) { const int c = bj * 128 + 32 * wc + 8 * fq + 4 * n + j; rs[bj][n][j] = fx_load(ssq_kv + u.pn * 256 + (c & ~63) + key_of_slot(c & 63)); }
        FOR_BJ _Pragma("unroll") for (int n = 0; n < 2; ++n) _Pragma("unroll") for (int j = 0; j < 4; ++j) rs[bj][n][j] = __builtin_amdgcn_rsqf(rs[bj][n][j] * (1.0f / KVLORA) + EPS);
        FOR_AI FOR_M FOR_BJ { f32x4 v0 = acc[ai][bj][m][0], v1 = acc[ai][bj][m][1];
            _Pragma("unroll") for (int j = 0; j < 4; ++j) { v0[j] *= rs[bj][0][j]; v1[j] *= rs[bj][1][j]; }
            const size_t grp = (size_t)u.pn * 4 + 2 * bj + (wc >> 1);
            store8_fp8(VT8 + (grp * 512 + u.pm * 256 + RT_(ai, m)) * 64 + (wc & 1) * 32 + 8 * fq, v0, v1); }
    }
};
struct OpYB {
    static constexpr bool PERM = true, GATHER = false, FP8 = false;
    const bf16_t* A; const bf16_t* Bt; int K, lda, ldb;
    bf16_t* GBM;
    __device__ __forceinline__ unsigned a_off(int r, int c) const { return (unsigned)(r * lda + c) * 2u; }
    __device__ __forceinline__ const char* a_base(const Unit& u) const { return (const char*)(A + (size_t)u.pm * 256 * lda); }
    __device__ __forceinline__ const char* b_base(const Unit& u) const { return (const char*)(Bt + (size_t)u.pn * 256 * ldb); }
    __device__ __forceinline__ void epi(const Acc& acc, const Unit& u, int wr, int wc, int fr, int fq) const {
        bf16_t* base = GBM + (size_t)u.pm * 256 * DM + u.pn * 256 + 32 * wc + 8 * fq;
        FOR_AI { u32x4 gb[4][2]; FOR_M FOR_BJ gb[m][bj] = *(const u32x4*)(base + (size_t)RT_(ai, m) * DM + bj * 128);
            FOR_M FOR_BJ { f32x4 g0, g1; unpack8(gb[m][bj], g0, g1); store8(base + (size_t)RT_(ai, m) * DM + bj * 128, g0 * acc[ai][bj][m][0], g1 * acc[ai][bj][m][1]); }
            asm volatile("" ::: "memory"); }
    }
};
struct OpYA {
    static constexpr bool PERM = true, GATHER = false, FP8 = true;
    const bf16_t* A; const bf16_t* Bt; int K, lda, ldb;
    const bf16_t* GA; bf16_t* MB; unsigned char* M8;
    __device__ __forceinline__ unsigned a_off(int r, int c) const { return (unsigned)(r * lda + c) * 2u; }
    __device__ __forceinline__ const char* a_base(const Unit& u) const { return (const char*)(A + (size_t)u.pm * 256 * lda); }
    __device__ __forceinline__ const char* b_base(const Unit& u) const { return (const char*)(Bt + (size_t)u.pn * 256 * ldb); }
    __device__ __forceinline__ void epi(const Acc& acc, const Unit& u, int wr, int wc, int fr, int fq) const {
        const size_t off0 = (size_t)u.pm * 256 * DM + u.pn * 256 + 32 * wc + 8 * fq;
        FOR_AI { u32x2 ga[4][2]; u32x4 mb[4][2]; FOR_M FOR_BJ { const size_t off = off0 + (size_t)RT_(ai, m) * DM + bj * 128; ga[m][bj] = *(const u32x2*)((const unsigned char*)GA + off); mb[m][bj] = *(const u32x4*)(MB + off); }
            FOR_M FOR_BJ { const size_t off = off0 + (size_t)RT_(ai, m) * DM + bj * 128; f32x4 g0, g1, b0, b1; unpack8_fp8(ga[m][bj], g0, g1); unpack8(mb[m][bj], b0, b1);
                store8_fp8(M8 + off, (g0 * (acc[ai][bj][m][0] * (0.0625f / 256.f)) + b0) * 4.f, (g1 * (acc[ai][bj][m][1] * (0.0625f / 256.f)) + b1) * 4.f); } }
    }
};
template <bool BASE_F32, bool F8 = false> struct OpRes {
    static constexpr bool PERM = true, GATHER = false, FP8 = F8;
    const bf16_t* A; const bf16_t* Bt; int K, lda, ldb;
    const void* base; bf16_t* Hout; u64* ssq; size_t bbatch;
    unsigned char* H8; float ascale;
    __device__ __forceinline__ unsigned a_off(int r, int c) const { return (unsigned)(r * lda + c) * 2u; }
    __device__ __forceinline__ const char* a_base(const Unit& u) const { return (const char*)(A + (size_t)u.pm * 256 * lda); }
    __device__ __forceinline__ const char* b_base(const Unit& u) const { return (const char*)(Bt + (size_t)(u.pm >> 4) * bbatch + (size_t)u.pn * 256 * ldb); }
    __device__ __forceinline__ void epi(const Acc& acc, const Unit& u, int wr, int wc, int fr, int fq) const {
        const size_t off0 = (size_t)u.pm * 256 * DM + u.pn * 256 + 32 * wc + 8 * fq;
        constexpr int MB_ = 4;
        FOR_AI _Pragma("unroll") for (int m0 = 0; m0 < 4; m0 += MB_) { f32x4 bv[MB_][2][2];
            _Pragma("unroll") for (int mi = 0; mi < MB_; ++mi) FOR_BJ { const size_t off = off0 + (size_t)RT_(ai, m0 + mi) * DM + bj * 128;
                if (BASE_F32) { bv[mi][bj][0] = *(const f32x4*)((const float*)base + off); bv[mi][bj][1] = *(const f32x4*)((const float*)base + off + 4); } else load8((const bf16_t*)base + off, bv[mi][bj][0], bv[mi][bj][1]); }
            _Pragma("unroll") for (int mi = 0; mi < MB_; ++mi) { const int m = m0 + mi; float s = 0.f;
                FOR_BJ { const size_t off = off0 + (size_t)RT_(ai, m) * DM + bj * 128; const f32x4 h0 = bv[mi][bj][0] + acc[ai][bj][m][0] * ascale, h1 = bv[mi][bj][1] + acc[ai][bj][m][1] * ascale; s += ssq8(h0, h1); store8(Hout + off, h0, h1); if (H8) store8_fp8(H8 + off, h0, h1); }
                row_atomic_add(ssq + u.pm * 256 + RT_(ai, m), s, fq); }
            asm volatile("" ::: "memory"); }
    }
};
struct OpPre {
    static constexpr bool PERM = true, GATHER = false, FP8 = false, PACK8 = true;
    __device__ __forceinline__ bool use_pack(const Unit&) const { return true; }
    __device__ __forceinline__ void pack(const Acc& acc, const Unit&, int, int, int, int, u32x2 (&pk)[2][2][4]) const {
        FOR_AI FOR_BJ FOR_M { const f32x4 a0 = acc[ai][bj][m][0] * 32.f, a1 = acc[ai][bj][m][1] * 32.f; pk[ai][bj][m].x = cvt4_fp8(a0[0], a0[1], a0[2], a0[3]); pk[ai][bj][m].y = cvt4_fp8(a1[0], a1[1], a1[2], a1[3]); } }
    __device__ __forceinline__ void epi_packed(const u32x2 (&pk)[2][2][4], const Unit& u, int wr, int wc, int fr, int fq) const {
        unsigned char* base = O + (size_t)u.pm * 256 * DM + u.pn * 256 + 32 * wc + 8 * fq;
        FOR_AI FOR_M FOR_BJ *(u32x2*)(base + (size_t)RT_(ai, m) * DM + bj * 128) = pk[ai][bj][m]; }
    const bf16_t* KVM; const bf16_t* W; int K, lda, ldb; unsigned char* O; int mode;
    __device__ __forceinline__ unsigned a_off(int r, int c) const { return (unsigned)(r * lda + c) * 2u; }
    __device__ __forceinline__ const char* a_base(const Unit& u) const { return mode == 0 ? (const char*)(KVM + (size_t)(u.pm >> 2) * 256 * 2048 + (u.pm & 3) * 256) : (const char*)(W + (size_t)(u.pm & 3) * 256 * DM + u.pn * 256); }
    __device__ __forceinline__ const char* b_base(const Unit& u) const { return mode == 0 ? (const char*)(W + (size_t)u.pn * 256 * DM + (u.pm & 3) * 256) : (const char*)(KVM + (size_t)(u.pm >> 2) * 256 * 2048 + DM + u.pn * 256); }
    __device__ __forceinline__ void epi(const Acc& acc, const Unit& u, int wr, int wc, int fr, int fq) const {
        unsigned char* base = O + (size_t)u.pm * 256 * DM + u.pn * 256 + 32 * wc + 8 * fq;
        FOR_AI FOR_M FOR_BJ store8_fp8(base + (size_t)RT_(ai, m) * DM + bj * 128, acc[ai][bj][m][0] * 32.f, acc[ai][bj][m][1] * 32.f);
    }
};
struct OpSX {
    static constexpr bool PERM = true, GATHER = false, FP8 = true, PACK8 = true;
    __device__ __forceinline__ bool use_pack(const Unit&) const { return true; }
    __device__ __forceinline__ void pack(Acc& acc, const Unit& u, int wr, int wc, int fr, int fq, u32x2 (&pk)[2][2][4]) const {
        float rs[2][4]; FOR_AI FOR_M rs[ai][m] = fx_load(ssq1 + u.pm * 256 + RT_(ai, m));
        FOR_AI FOR_M { const float r_ = C2X * __builtin_amdgcn_rsqf(rs[ai][m] * (1.0f / DM) + EPS); float s = 0.f;
            FOR_BJ { _Pragma("unroll") for (int n = 0; n < 2; ++n) _Pragma("unroll") for (int j = 0; j < 4; ++j) { const float e = fast_exp2(acc[ai][bj][m][n][j] * r_); acc[ai][bj][m][n][j] = e; s += e; } }
            s += __shfl_xor(s, 16); s += __shfl_xor(s, 32);
            if (fq == 0) ((LAS float*)(ps + RT_(ai, m)))[wc] = s; }
        asm volatile("s_waitcnt lgkmcnt(0)\n\ts_barrier" ::: "memory");
        FOR_AI FOR_M { const f32x4 q = ps[RT_(ai, m)]; const float inv = 256.f * __builtin_amdgcn_rcpf((q[0] + q[1]) + (q[2] + q[3]));
            FOR_BJ { const f32x4 a0 = acc[ai][bj][m][0] * inv, a1 = acc[ai][bj][m][1] * inv; pk[ai][bj][m].x = cvt4_fp8(a0[0], a0[1], a0[2], a0[3]); pk[ai][bj][m].y = cvt4_fp8(a1[0], a1[1], a1[2], a1[3]); } } }
    __device__ __forceinline__ void epi_packed(const u32x2 (&pk)[2][2][4], const Unit& u, int wr, int wc, int fr, int fq) const {
        unsigned char* base = P + (size_t)u.pm * 256 * DM + u.pn * 256 + 32 * wc + 8 * fq;
        FOR_AI FOR_M FOR_BJ *(u32x2*)(base + (size_t)RT_(ai, m) * DM + bj * 128) = pk[ai][bj][m]; }
    const bf16_t* A; const bf16_t* BQK; int K, lda, ldb;
    unsigned char* P; const u64* ssq1; LAS f32x4* ps;
    __device__ __forceinline__ unsigned a_off(int r, int c) const { return (unsigned)(r * lda + c) * 2u; }
    __device__ __forceinline__ const char* a_base(const Unit& u) const { return (const char*)(A + (size_t)u.pm * 256 * lda); }
    __device__ __forceinline__ const char* b_base(const Unit& u) const { return (const char*)(BQK + ((size_t)(u.pm >> 4) * DM + u.pn * 256) * ldb); }
    __device__ __forceinline__ void epi(Acc& acc, const Unit& u, int wr, int wc, int fr, int fq) const {
        float rs[2][4]; FOR_AI FOR_M rs[ai][m] = fx_load(ssq1 + u.pm * 256 + RT_(ai, m));
        FOR_AI FOR_M { const float r_ = C2X * __builtin_amdgcn_rsqf(rs[ai][m] * (1.0f / DM) + EPS); float s = 0.f;
            FOR_BJ { _Pragma("unroll") for (int n = 0; n < 2; ++n) _Pragma("unroll") for (int j = 0; j < 4; ++j) { const float e = fast_exp2(acc[ai][bj][m][n][j] * r_); acc[ai][bj][m][n][j] = e; s += e; } }
            s += __shfl_xor(s, 1); s += __shfl_xor(s, 2);
            if (fq == 0) ((LAS float*)(ps + RT_(ai, m)))[wc] = s; }
        asm volatile("s_waitcnt lgkmcnt(0)\n\ts_barrier" ::: "memory");
        unsigned char* base = P + (size_t)u.pm * 256 * DM + u.pn * 256 + 32 * wc + 8 * fq;
        FOR_AI FOR_M { const f32x4 q = ps[RT_(ai, m)]; const float inv = 256.f * __builtin_amdgcn_rcpf((q[0] + q[1]) + (q[2] + q[3]));
            FOR_BJ store8_fp8(base + (size_t)RT_(ai, m) * DM + bj * 128, acc[ai][bj][m][0] * inv, acc[ai][bj][m][1] * inv); }
    }
};
struct OpR {
    static constexpr bool PERM = false, GATHER = false, FP8 = false;
    const bf16_t* A; const bf16_t* Bt; int K, lda, ldb;
    float* LG; const u64* ssq2;
    __device__ __forceinline__ unsigned a_off(int r, int c) const { return (unsigned)(r * lda + c) * 2u; }
    __device__ __forceinline__ const char* a_base(const Unit& u) const { return (const char*)(A + (size_t)u.pm * 256 * lda); }
    __device__ __forceinline__ const char* b_base(const Unit& u) const { return (const char*)(Bt + (size_t)u.pn * 256 * ldb); }
    __device__ __forceinline__ void epi(const Acc& acc, const Unit& u, int wr, int wc, int fr, int fq) const {
        if (wc > 1) return;
        float rs[2][4]; FOR_AI FOR_M rs[ai][m] = fx_load(ssq2 + u.pm * 256 + RT_(ai, m));
        FOR_AI FOR_M { const int row = u.pm * 256 + RT_(ai, m); const float r_ = __builtin_amdgcn_rsqf(rs[ai][m] * (1.0f / DM) + EPS); float* lg = LG + (size_t)row * 40;
            if (wc == 0) { *(f32x4*)(lg + 4 * fq) = acc[ai][0][m][0] * r_; *(f32x4*)(lg + 16 + 4 * fq) = acc[ai][0][m][1] * r_; }
            else if (fq == 0) { *(f32x4*)(lg + 32) = acc[ai][0][m][0] * r_; } }
    }
};
struct MoeTab { const LAS int* tileE; const LAS int* tbase; const LAS int* cntL; };
template <int NPN> struct MoeOrder {
    int nunits, G, c;
    __device__ __forceinline__ bool next(int i, Unit& u) const { const int L = i * G + c; if (L >= nunits) return false; u.pm = L / NPN; u.pn = L - u.pm * NPN; return true; }
};
struct OpGU {
    static constexpr bool PERM = true, GATHER = true, FP8 = true, PACK8 = true;
    __device__ __forceinline__ bool use_pack(const Unit&) const { return true; }
    __device__ __forceinline__ void pack(const Acc& acc, const Unit& u, int wr, int wc, int fr, int fq, u32x2 (&pk)[2][2][4]) const {
        const int e = tb.tileE[u.pm], row0 = (u.pm - tb.tbase[e]) * 256, ce = tb.cntL[e]; const size_t lb = (size_t)e * NTOK + row0;
        float cw[2][4], rs[2][4];
        FOR_AI FOR_M { const int r = RT_(ai, m); const bool v = row0 + r < ce; cw[ai][m] = v ? WL[lb + r] : 0.f; rs[ai][m] = v ? RSL[lb + r] : 0.f; }
        FOR_AI FOR_M { const float r_ = rs[ai][m], c_ = cw[ai][m]; f32x4 h0, h1;
#pragma unroll
            for (int j = 0; j < 4; ++j) { const float g0 = acc[ai][0][m][0][j] * r_, u0 = acc[ai][1][m][0][j] * r_, g1 = acc[ai][0][m][1][j] * r_, u1 = acc[ai][1][m][1][j] * r_;
                h0[j] = g0 * sigmoidf_(g0) * u0 * c_ * 16.f; h1[j] = g1 * sigmoidf_(g1) * u1 * c_ * 16.f; }
            pk[ai][0][m].x = cvt4_fp8(h0[0], h0[1], h0[2], h0[3]); pk[ai][0][m].y = cvt4_fp8(h1[0], h1[1], h1[2], h1[3]); pk[ai][1][m] = pk[ai][0][m]; } }
    __device__ __forceinline__ void epi_packed(const u32x2 (&pk)[2][2][4], const Unit& u, int wr, int wc, int fr, int fq) const {
        unsigned char* base = HID + (size_t)u.pm * 256 * EFF + u.pn * 128 + 32 * wc + 8 * fq;
        FOR_AI FOR_M *(u32x2*)(base + (size_t)RT_(ai, m) * EFF) = pk[ai][0][m]; }
    const bf16_t* A; const bf16_t* WGUp; int K, lda, ldb;
    unsigned char* HID  ; const int* LIST; const float* WL; const float* RSL; MoeTab tb;
    __device__ __forceinline__ unsigned a_off_u(const Unit& u, int r, int c) const { const int e = tb.tileE[u.pm]; const int p = (u.pm - tb.tbase[e]) * 256 + r;
        const int tok = p < tb.cntL[e] ? (LIST[(size_t)e * NTOK + p] >> 1) : 0; return (unsigned)(tok * lda + c) * 2u; }
    __device__ __forceinline__ const char* a_base(const Unit&) const { return (const char*)A; }
    __device__ __forceinline__ const char* b_base(const Unit& u) const { return (const char*)(WGUp + ((size_t)tb.tileE[u.pm] * 512 + u.pn * 256) * ldb); }
    __device__ __forceinline__ void epi(const Acc& acc, const Unit& u, int wr, int wc, int fr, int fq) const {
        const int e = tb.tileE[u.pm], row0 = (u.pm - tb.tbase[e]) * 256, ce = tb.cntL[e]; const size_t lb = (size_t)e * NTOK + row0;
        float cw[2][4], rs[2][4];
        FOR_AI FOR_M { const int r = RT_(ai, m); const bool v = row0 + r < ce; cw[ai][m] = v ? WL[lb + r] : 0.f; rs[ai][m] = v ? RSL[lb + r] : 0.f; }
        unsigned char* base = HID + (size_t)u.pm * 256 * EFF + u.pn * 128 + 32 * wc + 8 * fq;
        FOR_AI FOR_M { const float r_ = rs[ai][m], c_ = cw[ai][m]; f32x4 h0, h1;
#pragma unroll
            for (int j = 0; j < 4; ++j) { const float g0 = acc[ai][0][m][0][j] * r_, u0 = acc[ai][1][m][0][j] * r_, g1 = acc[ai][0][m][1][j] * r_, u1 = acc[ai][1][m][1][j] * r_;
                h0[j] = g0 * sigmoidf_(g0) * u0 * c_ * 16.f; h1[j] = g1 * sigmoidf_(g1) * u1 * c_ * 16.f; }
            store8_fp8(base + (size_t)RT_(ai, m) * EFF, h0, h1); }
    }
};
struct OpDN {
    static constexpr bool PERM = true, GATHER = false, FP8 = true, PACK8 = true;
    __device__ __forceinline__ bool use_pack(const Unit&) const { return true; }
    __device__ __forceinline__ void pack(const Acc& acc, const Unit&, int, int, int, int, u32x2 (&pk)[2][2][4]) const {
        FOR_AI FOR_BJ FOR_M { pk[ai][bj][m].x = cvt4_fp8(acc[ai][bj][m][0][0], acc[ai][bj][m][0][1], acc[ai][bj][m][0][2], acc[ai][bj][m][0][3]); pk[ai][bj][m].y = cvt4_fp8(acc[ai][bj][m][1][0], acc[ai][bj][m][1][1], acc[ai][bj][m][1][2], acc[ai][bj][m][1][3]); } }
    __device__ __forceinline__ void epi_packed(const u32x2 (&pk)[2][2][4], const Unit& u, int wr, int wc, int fr, int fq) const {
        const int e = tb.tileE[u.pm], row0 = (u.pm - tb.tbase[e]) * 256, ce = tb.cntL[e]; const size_t lb = (size_t)e * NTOK + row0;
        int ent[2][4];
        FOR_AI FOR_M { const int r = RT_(ai, m); ent[ai][m] = row0 + r < ce ? LIST[lb + r] : -1; }
        FOR_AI FOR_M { const int en = ent[ai][m];
            if (en >= 0) { unsigned char* p = Y + ((size_t)(en & 1) * NTOK + (size_t)(en >> 1)) * DM + u.pn * 256 + 32 * wc + 8 * fq;
                FOR_BJ *(u32x2*)(p + bj * 128) = pk[ai][bj][m]; } } }
    const bf16_t* HID; const bf16_t* WDp; int K, lda, ldb;
    unsigned char* Y  ; const int* LIST; MoeTab tb;
    __device__ __forceinline__ unsigned a_off(int r, int c) const { return (unsigned)(r * lda + c) * 2u; }
    __device__ __forceinline__ const char* a_base(const Unit& u) const { return (const char*)(HID + (size_t)u.pm * 256 * lda); }
    __device__ __forceinline__ const char* b_base(const Unit& u) const { return (const char*)(WDp + ((size_t)tb.tileE[u.pm] * DM + u.pn * 256) * ldb); }
    __device__ __forceinline__ void epi(const Acc& acc, const Unit& u, int wr, int wc, int fr, int fq) const {
        const int e = tb.tileE[u.pm], row0 = (u.pm - tb.tbase[e]) * 256, ce = tb.cntL[e]; const size_t lb = (size_t)e * NTOK + row0;
        int ent[2][4];
        FOR_AI FOR_M { const int r = RT_(ai, m); ent[ai][m] = row0 + r < ce ? LIST[lb + r] : -1; }
        FOR_AI FOR_M { const int en = ent[ai][m];
            if (en >= 0) { unsigned char* p = Y + ((size_t)(en & 1) * NTOK + (size_t)(en >> 1)) * DM + u.pn * 256 + 32 * wc + 8 * fq;
                FOR_BJ store8_fp8(p + bj * 128, acc[ai][bj][m][0], acc[ai][bj][m][1]); } }
    }
};
__device__ __forceinline__ int moe_build_tables(const unsigned* cnt, LAS int* cntL, LAS int* tbase, LAS int* tileE, int tid) {
    if (tid < NEXP) cntL[tid] = (int)__hip_atomic_load(cnt + tid, RLX_AGENT);
    __syncthreads();
    if (tid == 0) { int acc_ = 0; for (int e = 0; e < NEXP; ++e) { tbase[e] = acc_; acc_ += (cntL[e] + 255) >> 8; } tbase[NEXP] = acc_; }
    __syncthreads();
    const int nt = tbase[NEXP];
    for (int t = tid; t < nt; t += 512) { int e = 0; for (int k = 1; k < NEXP; ++k) e += (tbase[k] <= t) ? 1 : 0; tileE[t] = e; }
    __syncthreads();
    return __builtin_amdgcn_readfirstlane(nt);
}

namespace mla {
constexpr int KSLOT = 4096, RSLOT = 2048, VSLOT = 4096, NSLOT = 8;
constexpr int L_K = 0, L_R = NSLOT * KSLOT, L_V = L_R + NSLOT * RSLOT, L_WS = L_V + NSLOT * VSLOT, L_OST = L_WS + 8 * 256, L_DUM = L_OST + 8 * 4096, L_END = L_DUM + 8 * 1024;
static_assert(L_END <= RING_BYTES, "attention LDS");
constexpr float THR = 6.0f;
__device__ __forceinline__ int crow(int r, int hi) { return (r & 3) + 8 * (r >> 2) + 4 * hi; }
__device__ __forceinline__ void glds16(const void* gsrc, unsigned lds_dst) { unsigned keep;
    asm volatile("s_mov_b32 %0, m0\n\ts_mov_b32 m0, %2\n\ts_nop 0\n\tglobal_load_lds_dwordx4 %1, off\n\ts_mov_b32 m0, %0" : "=&s"(keep) : "v"(gsrc), "s"(lds_dst) : "memory"); }
#define MX3(a, b, c) __builtin_fmaxf(__builtin_fmaxf((a), (b)), (c))
__device__ __forceinline__ float rowmax(const f32x16& p0, const f32x16& p1) {
    float a = MX3(p0[0], p0[1], p1[0]), b = MX3(p0[2], p0[3], p1[1]); a = MX3(a, p1[2], p1[3]);
#pragma unroll
    for (int r = 4; r < 16; r += 4) { a = MX3(a, p0[r], p0[r + 1]); b = MX3(b, p0[r + 2], p0[r + 3]); a = MX3(a, p1[r], p1[r + 1]); b = MX3(b, p1[r + 2], p1[r + 3]); }
    a = __builtin_fmaxf(a, b);
    auto rr = __builtin_amdgcn_permlane32_swap(__float_as_uint(a), __float_as_uint(a), false, false);
    return __builtin_fmaxf(__uint_as_float(rr[0]), __uint_as_float(rr[1]));
}
#define MLA_SC1 0x7F7F7F7F
#define MLA_SCQ 0x7B7B7B7B
template <bool GA> __device__ __forceinline__ void attn_unit(int b, int h, int qb, const unsigned char* Q8, const unsigned char* K8, const unsigned char* KR8, const unsigned char* VT8, bf16_t* O, LAS unsigned char* shm, const int wv_, const int sb, const bool first, const int qb_next) {
    int tid = wv_ * 64 + lane_mb(); asm volatile("" : "+v"(tid));
    const int lane = tid & 63, r32 = lane & 31, hi = lane >> 5; const int wid = __builtin_amdgcn_readfirstlane(tid >> 6);
    const long rowbase = (long)b * SEQ; const int q0 = qb * 256;
    const unsigned lds0 = (unsigned)(uintptr_t)shm;
    LAS float* wsf = (LAS float*)(shm + L_WS) + wid * 64;
    const int sw1 = (lane & 3) ^ ((lane >> 4) & 3);
    const unsigned char* src1 = wid < 4 ? K8 + (rowbase + wid * 16 + (lane >> 2)) * 512 + h * 64 + sw1 * 16
                                        : VT8 + ((size_t)(rowbase >> 6) * 512 + h * 64 + (wid - 4) * 16 + (lane >> 2)) * 64 + sw1 * 16;
    const long step1 = wid < 4 ? 64 * 512 : 512 * 64;
    const unsigned dst1 = wid < 4 ? lds0 + L_K + wid * 1024 : lds0 + L_V + (wid - 4) * 1024; const unsigned slot1 = wid < 4 ? KSLOT : VSLOT;
    const unsigned char* src2 = wid < 2 ? KR8 + (rowbase + wid * 32 + (lane >> 1)) * ROPE + ((lane & 1) ^ ((lane >> 4) & 1)) * 16 : src1;
    const long step2 = wid < 2 ? 64 * ROPE : step1;
    const unsigned dst2 = wid < 2 ? lds0 + L_R + wid * 1024 : lds0 + L_DUM + wid * 1024; const unsigned slot2 = wid < 2 ? RSLOT : 0;
    const bool two = wid < 2;
#define MLA_DMA(t, s) do { glds16(src1 + (long)(t) * step1, (unsigned)__builtin_amdgcn_readfirstlane(dst1 + (s) * slot1)); \
        if (two) glds16(src2 + (long)(t) * step2, (unsigned)__builtin_amdgcn_readfirstlane(dst2 + (s) * slot2)); } while (0)
    const int NT = 4 * qb + 4, nvis = 4 * qb + (wid >> 1) + 1; const bool has_next = qb_next >= 0;
    v8i_t qf[2];
    { const unsigned char* qp = Q8 + (rowbase + q0 + wid * 32 + r32) * 1024 + h * 128 + hi * 32;
#pragma unroll
      for (int st = 0; st < 2; ++st) qf[st] = __builtin_shufflevector(*(const v4i_t*)(qp + st * 64), *(const v4i_t*)(qp + st * 64 + 16), 0, 1, 2, 3, 4, 5, 6, 7); }
    asm volatile("" ::: "memory");
    if (first) { MLA_DMA(0, sb & 7); MLA_DMA(1, (sb + 1) & 7); MLA_DMA(2, (sb + 2) & 7); MLA_DMA(3, (sb + 3) & 7); }
    float mrun = 0.f; f32x16 o[2], lacc;
#pragma unroll
    for (int r = 0; r < 16; ++r) { float z0, z1, z2; asm volatile("v_mov_b32 %0, 0\n\tv_mov_b32 %1, 0\n\tv_mov_b32 %2, 0" : "=v"(z0), "=v"(z1), "=v"(z2)); o[0][r] = z0; o[1][r] = z1; lacc[r] = z2; }
    f32x16 negm;
#pragma unroll
    for (int r = 0; r < 16; ++r) { float z_; asm volatile("v_mov_b32 %0, 0" : "=v"(z_)); negm[r] = z_; }
    v8i_t onesB;
    if constexpr (!GA) {
#pragma unroll
        for (int i = 0; i < 8; ++i) { int w_; asm volatile("v_mov_b32 %0, 0x38383838" : "=v"(w_)); onesB[i] = w_; } }
    v8i_t kn0, kn1, kr0, kr1, p8;
    const int swr = (r32 >> 2) & 3, k64a = ((2 * hi) ^ swr) * 16, k64b = ((2 * hi + 1) ^ swr) * 16, k32a = ((r32 >> 3) & 1) * 16;
#define MLA_KLD(sl_) do { const LAS unsigned char* kp = shm + L_K + (sl_) * KSLOT + r32 * 64; const LAS unsigned char* rp = shm + L_R + (sl_) * RSLOT + r32 * 32; \
        kn0 = __builtin_shufflevector(*(const LAS v4i_t*)(kp + k64a), *(const LAS v4i_t*)(kp + k64b), 0, 1, 2, 3, 4, 5, 6, 7); \
        kn1 = __builtin_shufflevector(*(const LAS v4i_t*)(kp + 2048 + k64a), *(const LAS v4i_t*)(kp + 2048 + k64b), 0, 1, 2, 3, 4, 5, 6, 7); \
        kr0 = __builtin_shufflevector(*(const LAS v4i_t*)(rp + k32a), *(const LAS v4i_t*)(rp + (k32a ^ 16)), 0, 1, 2, 3, 4, 5, 6, 7);      \
        kr1 = __builtin_shufflevector(*(const LAS v4i_t*)(rp + 1024 + k32a), *(const LAS v4i_t*)(rp + 1024 + (k32a ^ 16)), 0, 1, 2, 3, 4, 5, 6, 7); } while (0)
#define MLA_VLD(sl_) do { const LAS unsigned char* vp = shm + L_V + (sl_) * VSLOT + r32 * 64; \
        vf0 = __builtin_shufflevector(*(const LAS v4i_t*)(vp + k64a), *(const LAS v4i_t*)(vp + k64b), 0, 1, 2, 3, 4, 5, 6, 7); \
        vf1 = __builtin_shufflevector(*(const LAS v4i_t*)(vp + 2048 + k64a), *(const LAS v4i_t*)(vp + 2048 + k64b), 0, 1, 2, 3, 4, 5, 6, 7); } while (0)
#define MLA_MF(a_, b_, c_, sa_, sb_) __builtin_amdgcn_mfma_scale_f32_32x32x64_f8f6f4(a_, b_, c_, 0, 0, 0, sa_, 0, sb_)
#define MLA_QK(P0, P1) do { \
        P0 = MLA_MF(kn0, qf[0], negm, MLA_SC1, MLA_SCQ); P1 = MLA_MF(kn1, qf[0], negm, MLA_SC1, MLA_SCQ); \
        P0 = MLA_MF(kr0, qf[1], P0, MLA_SC1, MLA_SCQ); P1 = MLA_MF(kr1, qf[1], P1, MLA_SC1, MLA_SCQ); } while (0)
#define MLA_PV() do { o[0] = MLA_MF(p8, vf0, o[0], MLA_SC1, MLA_SC1); o[1] = MLA_MF(p8, vf1, o[1], MLA_SC1, MLA_SC1); { v8i_t ones; if constexpr (GA) { _Pragma("unroll") for (int i = 0; i < 8; ++i) { int w_; asm volatile("v_mov_b32 %0, 0x38383838" : "=v"(w_)); ones[i] = w_; } } else ones = onesB;        \
          lacc = MLA_MF(p8, ones, lacc, MLA_SC1, MLA_SC1); } } while (0)
#define MLA_SM(PA0, PA1, PB0, PB1, t, ADJB) do { \
            const float rm = rowmax(PA0, PA1); \
            if (__any(rm > THR)) { const float dl = __builtin_fmaxf(rm, 0.f); mrun += dl; \
                _Pragma("unroll") for (int r = 0; r < 16; ++r) { PA0[r] -= dl; PA1[r] -= dl; } \
                if (ADJB && (t) + 1 < nvis) { _Pragma("unroll") for (int r = 0; r < 16; ++r) { PB0[r] -= dl; PB1[r] -= dl; } } \
                _Pragma("unroll") for (int r = 0; r < 16; ++r) negm[r] = -mrun; \
                asm volatile("" : "+v"(negm)); \
                const float f = fast_exp2(-dl); if (hi == 0) wsf[r32] = f; LDS_WAIT(); \
                _Pragma("unroll") for (int r = 0; r < 16; ++r) { const float fr_ = wsf[crow(r, hi)]; o[0][r] *= fr_; o[1][r] *= fr_; lacc[r] *= fr_; } \
                LDS_WAIT(); } \
            _Pragma("unroll") for (int r = 0; r < 16; ++r) { PA0[r] = fast_exp2(PA0[r]); PA1[r] = fast_exp2(PA1[r]); } \
            _Pragma("unroll") for (int i = 0; i < 4; ++i) { p8[i] = (int)cvt4_fp8(PA0[4 * i], PA0[4 * i + 1], PA0[4 * i + 2], PA0[4 * i + 3]); p8[4 + i] = (int)cvt4_fp8(PA1[4 * i], PA1[4 * i + 1], PA1[4 * i + 2], PA1[4 * i + 3]); } \
        } while (0)
#define MLA_STEP(PA0, PA1, PB0, PB1, t) do { \
        if ((t) + 2 < NT) { if ((t) + 3 < NT || has_next) { if (two) asm volatile("s_waitcnt vmcnt(2) lgkmcnt(0)\n\ts_barrier" ::: "memory"); else asm volatile("s_waitcnt vmcnt(1) lgkmcnt(0)\n\ts_barrier" ::: "memory"); } \
                            else asm volatile("s_waitcnt vmcnt(0) lgkmcnt(0)\n\ts_barrier" ::: "memory"); } \
        if ((t) + 4 < NT) MLA_DMA((t) + 4, (sb + (t) + 4) & 7); else if (has_next) MLA_DMA((t) + 4 - NT, (sb + (t) + 4) & 7);       \
        v8i_t vf0, vf1;                                                       \
        if constexpr (GA) { \
            const bool pv_ = (t) >= 1 && (t) - 1 < nvis; \
            if (pv_) MLA_VLD((sb + (t) - 1) & 7); \
            if ((t) + 1 < nvis) MLA_QK(PB0, PB1); \
            if (pv_) MLA_PV(); \
            __builtin_amdgcn_s_setprio(1);                                    \
            if ((t) < nvis) MLA_SM(PA0, PA1, PB0, PB1, t, true); \
            __builtin_amdgcn_sched_barrier(0); \
            if ((t) + 2 < nvis) MLA_KLD((sb + (t) + 2) & 7); \
            __builtin_amdgcn_s_setprio(0); \
        } else { \
            if ((t) < nvis) { \
                __builtin_amdgcn_s_setprio(1); \
                MLA_VLD((sb + (t)) & 7); \
                if ((t) + 1 < nvis) MLA_KLD((sb + (t) + 1) & 7); \
                MLA_SM(PA0, PA1, PB0, PB1, t, false); \
                __builtin_amdgcn_s_setprio(0); \
                __builtin_amdgcn_sched_barrier(0); \
                if ((t) + 1 < nvis) MLA_QK(PB0, PB1); \
                MLA_PV(); } \
        } \
    } while (0)
    if (!first) asm volatile("s_waitcnt vmcnt(0) lgkmcnt(0)\n\ts_barrier" ::: "memory");
    else if (two) asm volatile("s_waitcnt vmcnt(4) lgkmcnt(0)\n\ts_barrier" ::: "memory"); else asm volatile("s_waitcnt vmcnt(2) lgkmcnt(0)\n\ts_barrier" ::: "memory");
    f32x16 pA0, pA1, pB0, pB1;
    MLA_KLD(sb & 7); MLA_QK(pA0, pA1);
    { const float rm = rowmax(pA0, pA1); mrun = rm;
#pragma unroll
        for (int r = 0; r < 16; ++r) { pA0[r] -= rm; pA1[r] -= rm; negm[r] = -rm; }
        asm volatile("" : "+v"(negm)); }
    if (GA && 1 < nvis) MLA_KLD((sb + 1) & 7);
    for (int t = 0; t < NT; t += 2) {
        MLA_STEP(pA0, pA1, pB0, pB1, t);
        MLA_STEP(pB0, pB1, pA0, pA1, t + 1);
    }
    if (has_next) {
        const unsigned char* qw = Q8 + (rowbase + qb_next * 256 + wid * 32 + (lane >> 3)) * 1024 + h * 128 + (lane & 7) * 16;
#pragma unroll
        for (int i = 0; i < 4; ++i) glds16(qw + (long)i * 8 * 1024, (unsigned)__builtin_amdgcn_readfirstlane(lds0 + L_DUM + wid * 1024)); }
    if (GA && nvis == NT) { v8i_t vf0, vf1; MLA_VLD((sb + NT - 1) & 7); MLA_PV(); }
#undef MLA_SM
#undef MLA_VLD
#undef MLA_MF
#undef MLA_PV
#undef MLA_KLD
#undef MLA_QK
#undef MLA_STEP
    float rli[16];
#pragma unroll
    for (int r = 0; r < 16; ++r) rli[r] = __builtin_amdgcn_rcpf(lacc[r]);
    unsigned char* Ow = (unsigned char*)O + (rowbase + q0 + wid * 32) * 512 + h * 64;
    { LAS unsigned char* stg = (LAS unsigned char*)(shm + L_OST) + wid * 4096;
#pragma unroll
        for (int r = 0; r < 16; ++r) { const int orow = crow(r, hi); const unsigned w = cvt4_fp8(o[0][r] * rli[r] * 16.f, o[1][r] * rli[r] * 16.f, 0.f, 0.f);
            stg[orow * 64 + r32] = (unsigned char)(w & 0xffu); stg[orow * 64 + 32 + r32] = (unsigned char)((w >> 8) & 0xffu); }
        LDS_WAIT();
#pragma unroll
        for (int i = 0; i < 2; ++i) { const int row = i * 16 + (lane >> 2), ch = lane & 3; const u32x4 v = *(const LAS u32x4*)(stg + row * 64 + ch * 16); *(u32x4*)(Ow + (long)row * 512 + ch * 16) = v; } }
    asm volatile("s_waitcnt lgkmcnt(0)\n\ts_barrier" ::: "memory");
#undef MLA_DMA
#undef MX3
}
}

#define XB_TMO      128
#define XB_XCNT(j)  (256  + 64 * (j))
#define XB_XSUB(j)  (1280 + 64 * (j))
#define XB_XGEN(j)  (2304 + 64 * (j))
#define XB_TOP      3328
#define XB_TOPGEN   3392
#define XCD_BAR_WORDS 3456
#define XB_SPIN_CAP (1u << 18)
__device__ __forceinline__ unsigned xb_ld(unsigned* p)              { return __hip_atomic_load(p, __ATOMIC_RELAXED, __HIP_MEMORY_SCOPE_AGENT); }
__device__ __forceinline__ unsigned xb_add(unsigned* p, unsigned v) { return __hip_atomic_fetch_add(p, v, __ATOMIC_RELAXED, __HIP_MEMORY_SCOPE_AGENT); }
__device__ __forceinline__ unsigned xb_xcc_id() { return (unsigned)__builtin_amdgcn_s_getreg((3 << 11) | 20) & 0xFu; }
#define XB_SPIN(cond, bar) do { unsigned _sp = 0; while (cond) { __builtin_amdgcn_s_sleep(1); \
    if ((++_sp & 255u) == 0u) { if (xb_ld(&(bar)[XB_TMO])) break; if (_sp > XB_SPIN_CAP) { atomicAdd(&(bar)[XB_TMO], 1u); break; } } } } while (0)
struct XcdBarrier { unsigned* bar; unsigned x; volatile LAS unsigned* st; int w; };
__device__ __forceinline__ XcdBarrier xcd_barrier_post(unsigned* bar, volatile LAS unsigned* st) {
    XcdBarrier b; b.bar = bar; b.x = xb_xcc_id(); b.st = st;
    if (threadIdx.x == 0) (void)xb_add(&bar[XB_XCNT(b.x)], 1u);
    return b;
}
__device__ __forceinline__ void xcd_barrier_complete(unsigned* bar, unsigned x, unsigned& nloc, unsigned& nx) {
    const unsigned G = gridDim.x * gridDim.y * gridDim.z;
    unsigned sum, cnt, mine, sp = 0u;
    for (;;) {
        sum = 0u; cnt = 0u; mine = 0u;
#pragma unroll
        for (unsigned j = 0; j < 16; ++j) { const unsigned c = xb_ld(&bar[XB_XCNT(j)]); sum += c; cnt += (c > 0u) ? 1u : 0u; mine = (j == x) ? c : mine; }
        if (sum == G) break;
        __builtin_amdgcn_s_sleep(1);
        if ((++sp & 255u) == 0u) { if (xb_ld(&bar[XB_TMO])) break; if (sp > XB_SPIN_CAP) { atomicAdd(&bar[XB_TMO], 1u); break; } }
    }
    nloc = mine > 0u ? mine : 1u; nx = cnt > 0u ? cnt : 1u;
}
__device__ __forceinline__ void xcd_barrier(const XcdBarrier& b) {
    asm volatile("s_waitcnt vmcnt(0)" ::: "memory");
    __syncthreads();
    if (b.w == 0 && lane_mb() == 0) {
        unsigned* bar = b.bar;
        __builtin_amdgcn_s_waitcnt(0);
        unsigned nloc = b.st[0], nx = b.st[1];
        if (nloc == 0u) { xcd_barrier_complete(bar, b.x, nloc, nx); b.st[0] = nloc; b.st[1] = nx; }
        const unsigned old = xb_add(&bar[XB_XSUB(b.x)], 1u);
        const unsigned gen = old / nloc;
        if (old + 1u == (gen + 1u) * nloc) {
            __builtin_amdgcn_fence(__ATOMIC_RELEASE, "agent");
            asm volatile("s_waitcnt vmcnt(0)" ::: "memory");
            const unsigned og = xb_add(&bar[XB_TOP], 1u);
            const unsigned tg = og / nx;
            if (og + 1u == (tg + 1u) * nx) xb_add(&bar[XB_TOPGEN], 1u);
            else XB_SPIN(xb_ld(&bar[XB_TOPGEN]) == tg, bar);
            __builtin_amdgcn_fence(__ATOMIC_ACQUIRE, "agent");
            xb_add(&bar[XB_XGEN(b.x)], 1u);
            asm volatile("s_waitcnt vmcnt(0)" ::: "memory");
        } else {
            XB_SPIN(xb_ld(&bar[XB_XGEN(b.x)]) == gen, bar);
            __builtin_amdgcn_fence(__ATOMIC_ACQUIRE, "agent");
            asm volatile("s_waitcnt vmcnt(0)" ::: "memory");
        }
    }
    __syncthreads();
}

__device__ __forceinline__ void transpose_block(const float* src, int ldw, const float* gain, bf16_t* dst  , int ldt, LAS float* scr, int lane, unsigned char* dst8 = nullptr, int ldt8 = 0, float sc8 = 1.f) {
    float tv[32];
#pragma unroll
    for (int i = 0; i < 32; ++i) { const int kk = 2 * i + (lane >> 5); tv[i] = src ? src[(size_t)kk * ldw + (lane & 31)] : 0.f; }
#pragma unroll
    for (int i = 0; i < 32; ++i) { const int kk = 2 * i + (lane >> 5); float v = tv[i]; if (gain) v *= gain[kk]; scr[kk * 33 + (lane & 31)] = v; }
    LDS_WAIT(); asm volatile("" ::: "memory");
    const int c = lane & 7;
#pragma unroll
    for (int j = 0; j < 4; ++j) { const int n = (lane >> 3) + 8 * j; const LAS float* s = scr + (8 * c) * 33 + n;
        u32x4 o; o.x = cvt_pk_bf16(s[0 * 33], s[1 * 33]); o.y = cvt_pk_bf16(s[2 * 33], s[3 * 33]); o.z = cvt_pk_bf16(s[4 * 33], s[5 * 33]); o.w = cvt_pk_bf16(s[6 * 33], s[7 * 33]);
        if (dst) *(u32x4*)(dst + (size_t)n * ldt + 8 * c) = o;
        if (dst8) { u32x2 o8; o8.x = cvt4_fp8(s[0 * 33] * sc8, s[1 * 33] * sc8, s[2 * 33] * sc8, s[3 * 33] * sc8); o8.y = cvt4_fp8(s[4 * 33] * sc8, s[5 * 33] * sc8, s[6 * 33] * sc8, s[7 * 33] * sc8);
            *(u32x2*)(dst8 + (size_t)n * ldt8 + 8 * c) = o8; } }
    LDS_WAIT(); asm volatile("" ::: "memory");
}
__device__ __forceinline__ void rms_row_to_bf16(const float* xrow, const float* g, bf16_t* orow, int lane) {
    const f32x4* xr = (const f32x4*)xrow + lane; const f32x4* gr = (const f32x4*)g + lane;
    f32x4 v[4]; float s = 0.f;
#pragma unroll
    for (int j = 0; j < 4; ++j) { v[j] = xr[64 * j]; s += (v[j].x * v[j].x + v[j].y * v[j].y) + (v[j].z * v[j].z + v[j].w * v[j].w); }
    const float rstd = 1.0f / sqrtf(wave_sum(s) * (1.f / DM) + EPS);
    u32x2* o8 = (u32x2*)orow + lane;
#pragma unroll
    for (int j = 0; j < 4; ++j) { const f32x4 gg = gr[64 * j]; u32x2 w; w.x = cvt_pk_bf16(v[j].x * rstd * gg.x, v[j].y * rstd * gg.y); w.y = cvt_pk_bf16(v[j].z * rstd * gg.z, v[j].w * rstd * gg.w); o8[64 * j] = w; }
}

__device__ __forceinline__ void rms_row2_to_bf16(const float* xrow, const float* g, bf16_t* orow, int lane, unsigned char* orow8, float* rs_out) {
    const f32x4* xr = (const f32x4*)xrow + lane; const f32x4* gr = (const f32x4*)g + lane;
    f32x4 v[2][4]; float s[2] = {0.f, 0.f};
#pragma unroll
    for (int r = 0; r < 2; ++r)
#pragma unroll
        for (int j = 0; j < 4; ++j) v[r][j] = xr[r * 256 + 64 * j];
#pragma unroll
    for (int r = 0; r < 2; ++r)
#pragma unroll
        for (int j = 0; j < 4; ++j) s[r] += (v[r][j].x * v[r][j].x + v[r][j].y * v[r][j].y) + (v[r][j].z * v[r][j].z + v[r][j].w * v[r][j].w);
#pragma unroll
    for (int r = 0; r < 2; ++r) { const float rstd = 1.0f / sqrtf(wave_sum(s[r]) * (1.f / DM) + EPS); u32x2* o8 = (u32x2*)(orow + (size_t)r * DM) + lane;
        if (lane == 0) rs_out[r] = rstd;
#pragma unroll
        for (int j = 0; j < 4; ++j) { const f32x4 gg = gr[64 * j]; u32x2 w; w.x = cvt_pk_bf16(v[r][j].x, v[r][j].y); w.y = cvt_pk_bf16(v[r][j].z, v[r][j].w); o8[64 * j] = w;
            ((unsigned*)(orow8 + (size_t)r * DM))[lane + 64 * j] = cvt4_fp8(v[r][j].x * rstd * gg.x, v[r][j].y * rstd * gg.y, v[r][j].z * rstd * gg.z, v[r][j].w * rstd * gg.w); } }
}
struct Args { const void* in[28]; float* out; unsigned char* ws; int ph_lo, ph_hi; };
constexpr int NPHASE = 12;

#define CAS __attribute__((address_space(4)))
#define PHASE_PTRS const CAS char* ka_ = (const CAS char*)__builtin_amdgcn_kernarg_segment_ptr(); asm volatile("" : "+s"(ka_)); unsigned char* ws = *(unsigned char* const CAS*)(ka_ + 232); float* outp = *(float* const CAS*)(ka_ + 224); const float* x = *(const float* const CAS*)(ka_ + 0); const float* mem = *(const float* const CAS*)(ka_ + 8); const int* positions = *(const int* const CAS*)(ka_ + 16); const float* mix_norm_g = *(const float* const CAS*)(ka_ + 24); const float* w_in = *(const float* const CAS*)(ka_ + 32); const float* q_norm_g = *(const float* const CAS*)(ka_ + 40); const float* w_q_up = *(const float* const CAS*)(ka_ + 48); const float* kv_norm_g = *(const float* const CAS*)(ka_ + 56); const float* w_kv_up = *(const float* const CAS*)(ka_ + 64); const float* w_attn_branch = *(const float* const CAS*)(ka_ + 72); const float* pool_w = *(const float* const CAS*)(ka_ + 80); const float* pool_scale = *(const float* const CAS*)(ka_ + 88); const float* w_pool_branch = *(const float* const CAS*)(ka_ + 96); const float* w_mix_out = *(const float* const CAS*)(ka_ + 104); const float* xattn_norm_g = *(const float* const CAS*)(ka_ + 112); const float* mem_norm_g = *(const float* const CAS*)(ka_ + 120); const float* w_xq = *(const float* const CAS*)(ka_ + 128); const float* w_xkv = *(const float* const CAS*)(ka_ + 136); const float* w_xo = *(const float* const CAS*)(ka_ + 144); const float* ffn_norm_g = *(const float* const CAS*)(ka_ + 152); const float* w_rg = *(const float* const CAS*)(ka_ + 160); const float* b_rg = *(const float* const CAS*)(ka_ + 168); const float* w_re = *(const float* const CAS*)(ka_ + 176); const float* b_re = *(const float* const CAS*)(ka_ + 184); const float* w_eg = *(const float* const CAS*)(ka_ + 192); const float* w_eu = *(const float* const CAS*)(ka_ + 200); const float* w_ed = *(const float* const CAS*)(ka_ + 208); const float* final_g = *(const float* const CAS*)(ka_ + 216); u64* ssq_q = (u64*)(ws + OFF_SSQQ); u64* ssq_kv = (u64*)(ws + OFF_SSQKV); u64* ssq1 = (u64*)(ws + OFF_SSQ1); u64* ssq2 = (u64*)(ws + OFF_SSQ2); unsigned* cnt = (unsigned*)(ws + OFF_CNT); float* cosT = (float*)(ws + WS_COS); float* sinT = (float*)(ws + WS_SIN); unsigned char* WIN8 = ws + WS_WIN8; unsigned char* HN8 = ws + WS_S6;     bf16_t* WIN = (bf16_t*)(ws + WS_WIN); unsigned char* WQ8 = ws + WS_WQ; unsigned char* WKVU8 = ws + WS_WKVU; unsigned char* WA8 = ws + WS_WA; bf16_t* WPB = (bf16_t*)(ws + WS_WPB); unsigned char* WMO8 = ws + WS_WMO; unsigned char* M8 = ws + WS_S1; bf16_t* WXKV = (bf16_t*)(ws + WS_WXKV); bf16_t* WXO = (bf16_t*)(ws + WS_WXO); bf16_t* WR = (bf16_t*)(ws + WS_WR); unsigned char* WGU8 = ws + WS_WGU; unsigned char* H28 = ws + WS_S5; unsigned char* WD8 = ws + WS_WD; bf16_t* MEMN = (bf16_t*)(ws + WS_MEMN); bf16_t* KVM = (bf16_t*)(ws + WS_KVM); bf16_t* WXQN = (bf16_t*)(ws + WS_WXQN); unsigned char* BQK = ws + WS_BQK; unsigned char* BVO = ws + WS_BVO; unsigned char* H18 = ws + WS_S5; unsigned char* P8 = ws + WS_S1; float* LG = (float*)(ws + WS_LG); bf16_t* HN = (bf16_t*)(ws + WS_S0); bf16_t* Qb = (bf16_t*)(ws + WS_S0); bf16_t* H1 = (bf16_t*)(ws + WS_S0); bf16_t* GA = (bf16_t*)(ws + WS_S1); bf16_t* XQ = (bf16_t*)(ws + WS_S1); bf16_t* Y = (bf16_t*)(ws + WS_S1); bf16_t* GBM = (bf16_t*)(ws + WS_S2); bf16_t* QLb = (bf16_t*)(ws + WS_QLB); bf16_t* KVLb = (bf16_t*)(ws + WS_KVLB); bf16_t* KRb = (bf16_t*)(ws + WS_KRB); bf16_t* H2 = (bf16_t*)(ws + WS_S3); bf16_t* U = (bf16_t*)(ws + WS_U); bf16_t* DP = (bf16_t*)(ws + WS_DP); unsigned char* HID = ws + WS_HID; int* LIST = (int*)(ws + WS_LIST); float* WL = (float*)(ws + WS_WL); float* RSL = (float*)(ws + WS_RSL); unsigned char* K8 = ws + WS_S5; unsigned char* VT8 = ws + WS_S5 + 64 * MiB; unsigned char* Q8 = ws + WS_S1 + 64 * MiB;     float* RS0 = (float*)(ws + 3584 * 1024);     bf16_t* ATT = (bf16_t*)(ws + WS_ATT); (void)outp; int tidp_ = wave * 64 + lane_mb(); asm volatile("" : "+v"(tidp_)); const int tid = tidp_, lane = tid & 63, gt = bx * 512 + tid; (void)lane; (void)gt;
__global__ void __launch_bounds__(512, 2) fwd_kernel(Args args) {
    extern __shared__ __attribute__((aligned(16))) unsigned char lds_raw[];
    LAS unsigned char* lds = (LAS unsigned char*)lds_raw;
    LAS unsigned char* misc = lds + MISC_OFF;
    const int tid = threadIdx.x, lane = tid & 63, wave = __builtin_amdgcn_readfirstlane(tid >> 6);
    const int G = gridDim.x, bx = blockIdx.x;
    const int vcu = (G % 8 == 0) ? (bx % 8) * (G / 8) + bx / 8 : bx;
    for (int u = tid; u < (LDS_BYTES - MISC_OFF) / 4; u += 512) ((LAS unsigned*)misc)[u] = 0u;
    __syncthreads();
    unsigned* barw = (unsigned*)(args.ws + WS_CTL);
    XcdBarrier bar; bar.bar = barw; bar.x = 0; bar.st = nullptr; bar.w = wave;
    if (MK_N_LAUNCHES == 1) { bar = xcd_barrier_post(barw, (volatile LAS unsigned*)(misc + MO_BAR)); bar.w = wave; }
#define GRID_BAR() do { if (MK_N_LAUNCHES == 1) xcd_barrier(bar); } while (0)
    const int lo = args.ph_lo, hi = args.ph_hi;
#ifndef PH_MASK
#define PH_MASK 0xfff
#endif
#define IN(k) ((((PH_MASK) >> (k)) & 1) && lo <= (k) && (k) < hi)
#define BOTH(k) (IN(k) && IN((k) + 1))
    const int gw = vcu * 8 + wave, NGW = G * 8;
    const int gt = bx * 512 + tid, NGT = G * 512;

    if (IN(0)) {
        PHASE_PTRS
        for (int i = gt; i < (int)(SMALL_ZERO_BYTES / 4); i += NGT) ((unsigned*)(ws + WS_SMALL))[i] = 0u;
        for (int i = gt; i < NTOK * 16; i += NGT) { const int row = i >> 4, k = i & 15;
            const float inv = (float)exp2(-(double)k * (13.287712379549449 / 16.0)); const float ang = (float)positions[row] * inv;
            const double rev = (double)ang * 0.15915494309189535; const float fr_ = (float)(rev - rint(rev));
            cosT[i] = __builtin_amdgcn_cosf(fr_); sinT[i] = __builtin_amdgcn_sinf(fr_); }
        for (int i = gt; i < (POOLW / 8) * DM; i += NGT) { const int n = i & (DM - 1), kb = __builtin_amdgcn_readfirstlane(i >> 10), k0 = kb * 8, g = k0 >> 7;
            const float* pw = pool_w + (size_t)k0 * 128; const float* sc = pool_scale + g * 128; const float* wb = w_pool_branch + (size_t)g * 128 * DM + n;
            float s8[8] = {0.f, 0.f, 0.f, 0.f, 0.f, 0.f, 0.f, 0.f};
            for (int e = 0; e < 128; ++e) { const float v = sc[e] * wb[(size_t)e * DM];
#pragma unroll
                for (int j = 0; j < 8; ++j) s8[j] += pw[j * 128 + e] * v; }
            u32x4 o; o.x = cvt_pk_bf16(s8[0], s8[1]); o.y = cvt_pk_bf16(s8[2], s8[3]); o.z = cvt_pk_bf16(s8[4], s8[5]); o.w = cvt_pk_bf16(s8[6], s8[7]);
            *(u32x4*)(WPB + (size_t)n * POOLW + k0) = o; }
        for (int i = gt; i < DM * DM / 8; i += NGT) { const int k = i >> 7; const float g_ = xattn_norm_g[k]; const f32x4 a0 = *(const f32x4*)(w_xq + (size_t)i * 8), a1 = *(const f32x4*)(w_xq + (size_t)i * 8 + 4); store8(WXQN + (size_t)i * 8, a0 * g_, a1 * g_); }
        for (int i = gt; i < 256 * DM; i += NGT) { const int n = i >> 10, k = i & (DM - 1); float v = 0.f;
            if (n < 32) v = w_re[k * 32 + n] * ffn_norm_g[k]; else if (n < 36) v = w_rg[k * 4 + (n - 32)] * ffn_norm_g[k];
            WR[i] = (bf16_t)(cvt_pk_bf16(v, 0.f) & 0xffffu); }
        {
            LAS float* scr = (LAS float*)(lds + wave * 16384);
            constexpr int I_IN = 16 * 104, I_Q = 8 * 24, I_KV = 4 * 32, I_A = 8 * 32, I_SQ = 16 * 32, I_XKV = 16 * 64, I_GU = 32 * 16 * 16, I_D = 32 * 4 * 32;
            constexpr int NITEMS = I_IN + I_Q + I_KV + I_A + 2 * I_SQ + I_XKV + I_GU + I_D;
            for (int it = gw; it < NITEMS; it += NGW) {
                int r = it;
                if (r < I_IN) { const int kb = r / 104, nb = r % 104, n0 = nb * 32; const int sn = n0 < 672 ? n0 : (n0 < 768 ? -1 : n0 - 96);
                    transpose_block(sn >= 0 ? w_in + (size_t)kb * 64 * IN_COLS + sn : nullptr, IN_COLS, (n0 >= 768 && n0 < 1280) ? mix_norm_g + kb * 64 : nullptr  , WIN + (size_t)n0 * DM + kb * 64, DM, scr, lane, (n0 >= 1280 || n0 < 768) ? WIN8 + (size_t)n0 * DM + kb * 64 : nullptr, DM, 32.f); continue; } r -= I_IN;
                if (r < I_Q) { const int kb = r / 24, nb = r % 24; transpose_block(kb < 6 ? w_q_up + (size_t)kb * 64 * 768 + nb * 32 : nullptr, 768, kb < 6 ? q_norm_g + kb * 64 : nullptr, nullptr, 512, scr, lane, WQ8 + (size_t)nb * 32 * 512 + kb * 64, 512, 32.f); continue; } r -= I_Q;
                if (r < I_KV) { const int kb = r / 32, nb = r % 32, n0 = nb * 32; const int nn = n0 & 511, sn = (nn >> 6) * 128 + (n0 >= 512 ? 64 : 0) + (nn & 63);
                    transpose_block(w_kv_up + (size_t)kb * 64 * 1024 + sn, 1024, kv_norm_g + kb * 64, nullptr, KVLORA, scr, lane, WKVU8 + (size_t)n0 * KVLORA + kb * 64, KVLORA, 32.f); continue; } r -= I_KV;
                if (r < I_A) { const int kb = r / 32, nb = r % 32; transpose_block(w_attn_branch + (size_t)kb * 64 * DM + nb * 32, DM, nullptr, nullptr, 512, scr, lane, WA8 + (size_t)nb * 32 * 512 + kb * 64, 512, 32.f); continue; } r -= I_A;
                if (r < I_SQ) { const int kb = r / 32, nb = r % 32; transpose_block(w_mix_out + (size_t)kb * 64 * DM + nb * 32, DM, nullptr, nullptr, DM, scr, lane, WMO8 + (size_t)nb * 32 * DM + kb * 64, DM, 32.f); continue; } r -= I_SQ;
                if (r < I_SQ) { const int kb = r / 32, nb = r % 32; transpose_block(w_xo + (size_t)kb * 64 * DM + nb * 32, DM, nullptr, WXO + (size_t)nb * 32 * DM + kb * 64, DM, scr, lane); continue; } r -= I_SQ;
                if (r < I_XKV) { const int kb = r / 64, nb = r % 64; transpose_block(w_xkv + (size_t)kb * 64 * 2048 + nb * 32, 2048, nullptr, WXKV + (size_t)nb * 32 * DM + kb * 64, DM, scr, lane); continue; } r -= I_XKV;
                if (r < I_GU) { const int e = r / 256, q = r % 256, kb = q / 16, nb = q % 16, n0 = nb * 32;
                    const int pn = n0 >> 8, j = n0 & 255; const float* srcm = (j < 128 ? w_eg : w_eu) + (size_t)e * DM * EFF; const int sc = pn * 128 + (j & 127);
                    transpose_block(srcm + (size_t)kb * 64 * EFF + sc, EFF, ffn_norm_g + kb * 64, nullptr, DM, scr, lane, WGU8 + ((size_t)e * 512 + n0) * DM + kb * 64, DM, 32.f); continue; } r -= I_GU;
                { const int e = r / 128, q = r % 128, kb = q / 32, nb = q % 32;
                    transpose_block(w_ed + (size_t)e * EFF * DM + (size_t)kb * 64 * DM + nb * 32, DM, nullptr, nullptr, EFF, scr, lane, WD8 + ((size_t)e * DM + nb * 32) * EFF + kb * 64, EFF, 32.f); }
            }
        }
        for (int m = gw * 2; m < NTOK; m += NGW * 2) rms_row2_to_bf16(x + (size_t)m * DM, mix_norm_g, HN + (size_t)m * DM, lane, HN8 + (size_t)m * DM, RS0 + m);
        for (int m = gw; m < NMEM; m += NGW) rms_row_to_bf16(mem + (size_t)m * DM, mem_norm_g, MEMN + (size_t)m * DM, lane);
        if (BOTH(0)) GRID_BAR();
    }

    if (IN(1)) {
        PHASE_PTRS
        { OpIn op{HN, WIN, DM, DM, DM, QLb, KVLb, KRb, U, GA, GBM, ssq_q, ssq_kv, cosT, sinT, RS0}; OffsetOrder S; S.s.init(NTOK, 512, G, bx); S.off = 3; pg8::gemm_phase(lds, op, S, wave); }
        { OpPlain op{MEMN, WXKV, DM, DM, DM, KVM, 2 * DM}; pg8::StaticOrder S; S.init(NMEM, 2 * DM, G, bx); pg8::gemm_phase(lds, op, S, wave); }
    }
    if (IN(1)) {
        PHASE_PTRS
        { OpIn8 op{(const bf16_t*)HN8, (const bf16_t*)WIN8, DM / 2, DM / 2, DM / 2, QLb, KVLb, KRb, U, GA, GBM, ssq_q, ssq_kv, cosT, sinT}; pg8::StaticOrder S; S.init(NTOK, 768, G, bx); pg8::gemm_phase(lds, op, S, wave); }
        { OpGate8 op{(const bf16_t*)HN8, (const bf16_t*)WIN8, DM / 2, DM / 2, DM / 2, GA, GBM};
          GateOrder S; S.s.init(NTOK, 2048, G, bx); S.off = 5; S.light = (NMEM / 256) * (2 * DM / 256); pg8::gemm_phase(lds, op, S, wave); }
        if (BOTH(1)) GRID_BAR();
    }

    if (IN(2)) {
        PHASE_PTRS
        { OpPre op{KVM, WXQN, 256, 2 * DM, DM, BQK, 0}; pg8::StaticOrder S; S.init(16 * DM, DM, G, bx); pg8::gemm_phase(lds, op, S, wave); }
        { OpPre op{KVM, WXO, 256, DM, 2 * DM, BVO, 1}; pg8::StaticOrder S; S.init(16 * DM, DM, G, bx); pg8::gemm_phase(lds, op, S, wave); }
        { OpQ op{QLb, (const bf16_t*)WQ8, 256, 256, 256, Q8, ssq_q, cosT, sinT}; pg8::StaticOrder S; S.init(NTOK, NHEAD * QKD, G, bx); pg8::gemm_phase(lds, op, S, wave); }
        { OpK8 op{KVLb, (const bf16_t*)WKVU8, KVLORA / 2, KVLORA / 2, KVLORA / 2, K8, ssq_kv}; pg8::StaticOrder S; S.init(NTOK, 512, G, bx); pg8::gemm_phase(lds, op, S, wave); }
        { OpVT op{(const bf16_t*)(WKVU8 + 512 * KVLORA), KVLb, KVLORA / 2, KVLORA / 2, KVLORA / 2, VT8, ssq_kv}; pg8::StaticOrder S; S.init(512, NTOK, G, bx); pg8::gemm_phase(lds, op, S, wave); }
        { RELANE
        static_assert((4 * (NTOK / 4)) % 2 == 0, "item pairs");
        for (int it = gw; it < 4 * (NTOK / 4); it += 2 * NGW) { const int g = it & 3, ch = g * 16 + (lane & 15); const bool two_ = it + NGW < 4 * (NTOK / 4);
            const int rowA = (it >> 2) * 4 + (lane >> 4), rowB = two_ ? ((it + NGW) >> 2) * 4 + (lane >> 4) : rowA, tA = rowA & (SEQ - 1), tB = rowB & (SEQ - 1);
            const bf16_t* pA = U + (size_t)rowA * POOLW + ch * 8; const bf16_t* pB = U + (size_t)rowB * POOLW + ch * 8;
            f32x4 a0, a1, ua0, ua1, b0, b1, ub0, ub1; load8(pA, ua0, ua1); load8(pB, ub0, ub1); a0 = ua0; a1 = ua1; b0 = ub0; b1 = ub1;
#define DP_WIN(W) { u32x4 wa_[W - 1], wb_[W - 1]; \
                    _Pragma("unroll") for (int j = 1; j < W; ++j) { wa_[j - 1] = *(const u32x4*)(pA - (size_t)(j <= tA ? j : 0) * POOLW); wb_[j - 1] = *(const u32x4*)(pB - (size_t)(j <= tB ? j : 0) * POOLW); } \
                    _Pragma("unroll") for (int j = 1; j < W; ++j) { const u32x4 w = wa_[j - 1]; const float k_ = (j <= tA) ? 1.f : 0.f; a0 += (f32x4){bf_lo(w.x), bf_hi(w.x), bf_lo(w.y), bf_hi(w.y)} * k_; a1 += (f32x4){bf_lo(w.z), bf_hi(w.z), bf_lo(w.w), bf_hi(w.w)} * k_; } \
                    _Pragma("unroll") for (int j = 1; j < W; ++j) { const u32x4 w = wb_[j - 1]; const float k_ = (j <= tB) ? 1.f : 0.f; b0 += (f32x4){bf_lo(w.x), bf_hi(w.x), bf_lo(w.y), bf_hi(w.y)} * k_; b1 += (f32x4){bf_lo(w.z), bf_hi(w.z), bf_lo(w.w), bf_hi(w.w)} * k_; } }
            if (g == 0) DP_WIN(2) else if (g == 1) DP_WIN(4) else if (g == 2) DP_WIN(8) else DP_WIN(16)
#undef DP_WIN
            const int w = 2 << g, nA = (tA + 1 < w) ? tA + 1 : w, nB = (tB + 1 < w) ? tB + 1 : w; const float invA = 1.0f / (float)nA, invB = 1.0f / (float)nB;
            store8(DP + (size_t)rowA * POOLW + ch * 8, a0 * invA - ua0, a1 * invA - ua1);
            if (two_) store8(DP + (size_t)rowB * POOLW + ch * 8, b0 * invB - ub0, b1 * invB - ub1); }
        }
        if (BOTH(2)) GRID_BAR();
    }

    if (IN(3)) {
        PHASE_PTRS
        { OpYB op{DP, WPB, POOLW, POOLW, POOLW, GBM}; pg8::StaticOrder S; S.init(NTOK, DM, G, bx); pg8::gemm_phase(lds, op, S, wave); }
        { const int bh = vcu >> 1, half = vcu & 1;
          int sb_ = 0;
#define ATT_QB(i_) (4 * ((i_) >> 1) + (((i_) & 1) ? (half ? 2 : 3) : (half ? 1 : 0)))
          if (bh < NBATCH * NHEAD) for (int i = 0; i < 8; ++i) { const int qb = ATT_QB(i), qbn = i < 7 ? ATT_QB(i + 1) : -1;
              if (wave < 4) mla::attn_unit<true>(bh >> 3, bh & 7, qb, Q8, K8, (const unsigned char*)KRb, VT8, ATT, lds, wave, sb_, i == 0, qbn); else mla::attn_unit<false>(bh >> 3, bh & 7, qb, Q8, K8, (const unsigned char*)KRb, VT8, ATT, lds, wave, sb_, i == 0, qbn);
              sb_ = (sb_ + 4 * qb + 4) & 7; } }
#undef ATT_QB
        if (BOTH(3)) GRID_BAR();
    }

    if (IN(4)) {
        PHASE_PTRS
        { OpYA op{ATT, (const bf16_t*)WA8, 256, 256, 256, GA, GBM, M8}; pg8::StaticOrder S; S.init(NTOK, DM, G, bx); pg8::gemm_phase(lds, op, S, wave); }
        if (BOTH(4)) GRID_BAR();
    }

    if (IN(5)) {
        PHASE_PTRS
        { OpRes<false, true> op{(const bf16_t*)M8, (const bf16_t*)WMO8, DM / 2, DM / 2, DM / 2, HN  , H1, ssq1, 0, H18, 0.25f}; pg8::StaticOrder S; S.init(NTOK, DM, G, bx); pg8::gemm_phase(lds, op, S, wave); }
        if (BOTH(5)) GRID_BAR();
    }

    if (IN(6)) {
        PHASE_PTRS
        { OpSX op{(const bf16_t*)H18, (const bf16_t*)BQK, DM / 2, DM / 2, DM / 2, P8, ssq1, (LAS f32x4*)(misc + MO_PS)}; pg8::StaticOrder S; S.init(NTOK, DM, G, bx); pg8::gemm_phase(lds, op, S, wave); }
        if (BOTH(6)) GRID_BAR();
    }

    if (IN(7)) {
        PHASE_PTRS
        { OpRes<false, true> op{(const bf16_t*)P8, (const bf16_t*)BVO, DM / 2, DM / 2, DM / 2, H1, H2, ssq2, (size_t)DM * DM / 2, H28, 1.0f / 256.f}; pg8::StaticOrder S; S.init(NTOK, DM, G, bx); pg8::gemm_phase(lds, op, S, wave); }
        if (BOTH(7)) GRID_BAR();
    }

    if (IN(8)) {
        PHASE_PTRS
        pg8::StaticOrder S; S.init(NTOK, 256, G, bx);
        { OpR op{H2, WR, DM, DM, DM, LG, ssq2}; pg8::gemm_phase(lds, op, S, wave); }
        { RELANE
        VM_WAIT(); __syncthreads(); __builtin_amdgcn_fence(__ATOMIC_ACQUIRE, "agent"); VM_WAIT(); __syncthreads();
        LAS unsigned* hist = (LAS unsigned*)(misc + MO_HIST); LAS unsigned* basee = (LAS unsigned*)(misc + MO_BASE);
        pg8::StaticOrder S2; S2.init(NTOK, 256, G, bx);
        for (int i = 0; i < (256 + G - 1) / G; ++i) { Unit u; if (!S2.next(i, u)) break;
            if (tid < 32) hist[tid] = 0u;
            __syncthreads();
            int e1 = 0, e2 = 0; float w1 = 0.f, w2 = 0.f; unsigned r1 = 0, r2 = 0; const int row = u.pm * 256 + tid;
            if (tid < 256) {
                const float* lg = LG + (size_t)row * 40;
                float gl[4]; int gi = 0;
#pragma unroll
                for (int j = 0; j < 4; ++j) gl[j] = lg[32 + j] + b_rg[j];
                float gm = gl[0];
#pragma unroll
                for (int j = 1; j < 4; ++j) if (gl[j] > gm) { gm = gl[j]; gi = j; }
                float gs = 0.f;
#pragma unroll
                for (int j = 0; j < 4; ++j) gs += __expf(gl[j] - gm);
                const float gwt = 1.0f / gs;
                float el[8];
#pragma unroll
                for (int j = 0; j < 8; ++j) el[j] = lg[gi * 8 + j] + b_re[gi * 8 + j];
                int i1 = 0; float m1 = el[0];
#pragma unroll
                for (int j = 1; j < 8; ++j) if (el[j] > m1) { m1 = el[j]; i1 = j; }
                int i2 = -1; float m2 = -3.0e38f;
#pragma unroll
                for (int j = 0; j < 8; ++j) if (j != i1 && el[j] > m2) { m2 = el[j]; i2 = j; }
                const float p2 = __expf(m2 - m1);
                w1 = gwt / (1.0f + p2); w2 = gwt * p2 / (1.0f + p2);
                e1 = gi * 8 + i1; e2 = gi * 8 + i2;
                r1 = __hip_atomic_fetch_add(&hist[e1], 1u, __ATOMIC_RELAXED, __HIP_MEMORY_SCOPE_WORKGROUP); r2 = __hip_atomic_fetch_add(&hist[e2], 1u, __ATOMIC_RELAXED, __HIP_MEMORY_SCOPE_WORKGROUP);
            }
            __syncthreads();
            if (tid < 32) basee[tid] = hist[tid] ? __hip_atomic_fetch_add(cnt + tid, hist[tid], RLX_AGENT) : 0u;
            __syncthreads();
            if (tid < 256) { const size_t p1 = (size_t)e1 * NTOK + basee[e1] + r1, p2 = (size_t)e2 * NTOK + basee[e2] + r2;
                const float rs_ = __builtin_amdgcn_rsqf(fx_load(ssq2 + row) * (1.0f / DM) + EPS);
                LIST[p1] = row * 2; WL[p1] = w1; RSL[p1] = rs_; LIST[p2] = row * 2 + 1; WL[p2] = w2; RSL[p2] = rs_; }
            __syncthreads();
        }
        }
        if (BOTH(8)) GRID_BAR();
    }

    if (IN(9)) {
        PHASE_PTRS
        LAS int* cntL = (LAS int*)(misc + MO_CNTL); LAS int* tbase = (LAS int*)(misc + MO_TBASE); LAS int* tileE = (LAS int*)(misc + MO_TILEE);
        const int ntile = moe_build_tables(cnt, cntL, tbase, tileE, tid);
        { OpGU op{(const bf16_t*)H28, (const bf16_t*)WGU8, DM / 2, DM / 2, DM / 2, HID, LIST, WL, RSL, MoeTab{tileE, tbase, cntL}}; MoeOrder<2> S{ntile * 2, G, vcu}; pg8::gemm_phase(lds, op, S, wave); }
        if (BOTH(9)) GRID_BAR();
    }

    if (IN(10)) {
        PHASE_PTRS
        LAS int* cntL = (LAS int*)(misc + MO_CNTL); LAS int* tbase = (LAS int*)(misc + MO_TBASE); LAS int* tileE = (LAS int*)(misc + MO_TILEE);
        const int ntile = moe_build_tables(cnt, cntL, tbase, tileE, tid);
        { OpDN op{(const bf16_t*)HID, (const bf16_t*)WD8, EFF / 2, EFF / 2, EFF / 2, (unsigned char*)Y, LIST, MoeTab{tileE, tbase, cntL}}; MoeOrder<4> S{ntile * 4, G, vcu}; pg8::gemm_phase(lds, op, S, wave); }
        if (BOTH(10)) GRID_BAR();
    }

    if (IN(11)) {
        PHASE_PTRS
        const f32x4 g00 = *(const f32x4*)(final_g + lane * 8), g01 = *(const f32x4*)(final_g + lane * 8 + 4), g10 = *(const f32x4*)(final_g + 512 + lane * 8), g11 = *(const f32x4*)(final_g + 512 + lane * 8 + 4);
        for (int m = gw * 2; m < NTOK; m += NGW * 2) {
            u32x4 w[2][2]; u32x2 y8[2][2][2]; const unsigned char* Y8 = (const unsigned char*)Y;
#pragma unroll
            for (int r = 0; r < 2; ++r)
#pragma unroll
                for (int hf = 0; hf < 2; ++hf) { const size_t o = (size_t)(m + r) * DM + hf * 512 + lane * 8; w[r][hf] = *(const u32x4*)(H2 + o); y8[r][hf][0] = *(const u32x2*)(Y8 + o); y8[r][hf][1] = *(const u32x2*)(Y8 + (size_t)NTOK * DM + o); }
#pragma unroll
            for (int r = 0; r < 2; ++r) { f32x4 v[2][2]; float s = 0.f;
#pragma unroll
                for (int hf = 0; hf < 2; ++hf) { f32x4 a0, a1, b0, b1, c0, c1; unpack8(w[r][hf], a0, a1); unpack8_fp8(y8[r][hf][0], b0, b1); unpack8_fp8(y8[r][hf][1], c0, c1);
                    a0 += (b0 + c0) * 0.0625f; a1 += (b1 + c1) * 0.0625f; v[hf][0] = a0; v[hf][1] = a1; s += ssq8(a0, a1); }
                const float rstd = 1.0f / sqrtf(wave_sum(s) * (1.f / DM) + EPS); float* op_ = outp + (size_t)(m + r) * DM + lane * 8;
                *(f32x4*)(op_) = v[0][0] * rstd * g00; *(f32x4*)(op_ + 4) = v[0][1] * rstd * g01; *(f32x4*)(op_ + 512) = v[1][0] * rstd * g10; *(f32x4*)(op_ + 516) = v[1][1] * rstd * g11; }
        }
    }
#undef IN
#undef BOTH
#undef GRID_BAR
}

extern "C" void kernel_launch(void* const* d_in, const int* in_sizes, int n_in, void* d_out, int out_size, void* d_ws, size_t ws_size, hipStream_t stream) {
    static int grid = 0;
    if (grid == 0) {
        if (n_in != 28 || in_sizes[0] != NTOK * DM || out_size != NTOK * DM || ws_size < WS_END) { fprintf(stderr, "kernel_launch: unexpected shapes (n_in %d, in0 %d, out %d, ws %zu); nothing launched\n", n_in, n_in > 0 ? in_sizes[0] : -1, out_size, ws_size); grid = -1; return; }
        int dev = 0, cus = 0, per_cu = 0;
        if (hipGetDevice(&dev) != hipSuccess || hipDeviceGetAttribute(&cus, hipDeviceAttributeMultiprocessorCount, dev) != hipSuccess) { fprintf(stderr, "kernel_launch: device query failed\n"); grid = -1; return; }
        if (hipFuncSetAttribute((const void*)fwd_kernel, hipFuncAttributeMaxDynamicSharedMemorySize, LDS_BYTES) != hipSuccess) { fprintf(stderr, "kernel_launch: hipFuncSetAttribute failed\n"); grid = -1; return; }
        if (hipOccupancyMaxActiveBlocksPerMultiprocessor(&per_cu, (const void*)fwd_kernel, 512, LDS_BYTES) != hipSuccess || per_cu < 1) { fprintf(stderr, "kernel_launch: occupancy query reports %d blocks per CU\n", per_cu); }
        (void)hipGetLastError();
        grid = cus;
        if (grid > 256) grid = 256;
    }
    if (grid < 0) return;
    (void)hipMemsetAsync((char*)d_ws + WS_CTL, 0, CTL_ZERO_BYTES, stream);
    Args a{};
    for (int i = 0; i < 28; ++i) a.in[i] = d_in[i];
    a.out = (float*)d_out; a.ws = (unsigned char*)d_ws;
    if (MK_N_LAUNCHES == 1) { a.ph_lo = 0; a.ph_hi = NPHASE; hipLaunchKernelGGL(fwd_kernel, dim3(grid), dim3(512), LDS_BYTES, stream, a); }
    else for (int p = 0; p < NPHASE; ++p) { a.ph_lo = p; a.ph_hi = p + 1; hipLaunchKernelGGL(fwd_kernel, dim3(grid), dim3(512), LDS_BYTES, stream, a); }
    const hipError_t le = hipPeekAtLastError();
    if (le != hipSuccess) fprintf(stderr, "kernel_launch: launch failed: %s\n", hipGetErrorName(le));
}
```
